# Optimizing an MI355X kernel written in HIP

```python
import math
import jax, jax.numpy as jnp
from jax import lax
import numpy as np

D_MODEL = 1024
BATCH = 8
SEQ = 2048
DEPTH = 1

HEAD_DIM = 64
SWA_Q_HEADS = 8
SWA_KV_HEADS = 2
SWA_WINDOW = 128
MOBA_Q_HEADS = 8
MOBA_KV_HEADS = 2
MOBA_BLOCK = 256
MOBA_TOPK = 3
MOBA_Q_CHUNK = 32
N_HEADS = SWA_Q_HEADS + MOBA_Q_HEADS
REL_BUCKETS = 32
REL_MAX_DIST = 128
N_GROUPS = 4
EXPERTS_PER_GROUP = 8
N_EXPERTS = N_GROUPS * EXPERTS_PER_GROUP
EXPERT_TOPK = 2
D_EXPERT = 512
DISPATCH_BLOCK = 256
PLE_DIM = 256
EPS = 1e-6
NEG = -1e30

SWA_Q_W = SWA_Q_HEADS * HEAD_DIM
SWA_KV_W = SWA_KV_HEADS * HEAD_DIM
MOBA_Q_W = MOBA_Q_HEADS * HEAD_DIM
MOBA_KV_W = MOBA_KV_HEADS * HEAD_DIM
MIX_W = SWA_Q_W + MOBA_Q_W
IN_W = SWA_Q_W + 2 * SWA_KV_W + MOBA_Q_W + 2 * MOBA_KV_W
SPLITS = [SWA_Q_W, SWA_Q_W + SWA_KV_W, SWA_Q_W + 2 * SWA_KV_W,
          SWA_Q_W + 2 * SWA_KV_W + MOBA_Q_W, SWA_Q_W + 2 * SWA_KV_W + MOBA_Q_W + MOBA_KV_W]

kernel_name = 'hymba_swa_sink_moba_hiermoe_ple'


def rms_norm(x, g):
    xf = x.astype(jnp.float32)
    y = xf * lax.rsqrt(jnp.mean(xf * xf, axis=-1, keepdims=True) + EPS)
    return (y * g.astype(jnp.float32)).astype(x.dtype)


def rel_bucket(dist):
    n = jnp.maximum(dist, 0)
    exact = REL_BUCKETS // 2
    nf = jnp.maximum(n, 1).astype(jnp.float32)
    large = exact + (jnp.log(nf / exact) / math.log(REL_MAX_DIST / exact)
                     * (REL_BUCKETS - exact)).astype(jnp.int32)
    return jnp.where(n < exact, n, jnp.minimum(large, REL_BUCKETS - 1))


def swa_attention(q, k, v, sinks, rel_tbl):
    B, S = q.shape[0], q.shape[1]
    W = SWA_WINDOW
    NB = S // W
    G = SWA_KV_HEADS
    R = SWA_Q_HEADS // G
    qb = q.reshape(B, NB, W, G, R, HEAD_DIM)
    pad = ((0, 0), (W, 0), (0, 0), (0, 0))
    kp = jnp.pad(k, pad).reshape(B, NB + 1, W, G, HEAD_DIM)
    vp = jnp.pad(v, pad).reshape(B, NB + 1, W, G, HEAD_DIM)
    kband = jnp.concatenate([kp[:, :-1], kp[:, 1:]], axis=2)
    vband = jnp.concatenate([vp[:, :-1], vp[:, 1:]], axis=2)
    qi = jnp.arange(W)[:, None]
    kj = jnp.arange(2 * W)[None, :]
    dist = qi + W - kj
    band = (dist >= 0) & (dist < W)
    key_pos = (jnp.arange(NB)[:, None, None] - 1) * W + kj[None]
    mask = band[None] & (key_pos >= 0)
    bias = rel_tbl.astype(jnp.float32)[rel_bucket(dist)]
    bias = bias.transpose(2, 0, 1).reshape(G, R, W, 2 * W)
    s = jnp.einsum('bnqgrd,bnkgd->bngrqk', qb, kband).astype(jnp.float32) * HEAD_DIM ** -0.5 + bias
    s = jnp.where(mask[None, :, None, None], s, NEG)
    sink = sinks.astype(jnp.float32).reshape(G, R)[None, None, :, :, None, None]
    m = jnp.maximum(jnp.max(s, axis=-1, keepdims=True), sink)
    e = jnp.exp(s - m)
    prob = e / (jnp.sum(e, axis=-1, keepdims=True) + jnp.exp(sink - m))
    o = jnp.einsum('bngrqk,bnkgd->bnqgrd', prob.astype(v.dtype), vband)
    return o.reshape(B, S, SWA_Q_W)


def moba_attention(q, k, v, rel_tbl):
    B, S = q.shape[0], q.shape[1]
    G = MOBA_KV_HEADS
    R = MOBA_Q_HEADS // G
    BS = MOBA_BLOCK
    C = MOBA_Q_CHUNK
    NBK = -(-S // BS)
    S_pad = NBK * BS
    K = min(MOBA_TOPK, NBK)
    NC = S // C
    scale = HEAD_DIM ** -0.5
    qh = q.reshape(B, S, G, R, HEAD_DIM).transpose(0, 2, 3, 1, 4)
    pad = ((0, 0), (0, S_pad - S), (0, 0), (0, 0))
    kT = jnp.pad(k, pad).transpose(0, 2, 1, 3)
    vT = jnp.pad(v, pad).transpose(0, 2, 1, 3)
    kblk = kT.reshape(B, G, NBK, BS, HEAD_DIM)
    vblk = vT.reshape(B, G, NBK, BS, HEAD_DIM)
    kmean = jnp.mean(kblk.astype(jnp.float32), axis=3)
    gate = jnp.einsum('bgrsd,bgnd->bgrsn', qh.astype(jnp.float32), kmean)
    fully_past = jnp.arange(NBK)[None, :] < (jnp.arange(S) // BS)[:, None]
    gate = jnp.where(fully_past, gate, NEG)
    _, sel = lax.top_k(gate, K)
    tbl = rel_tbl.astype(jnp.float32).T.reshape(G, R, REL_BUCKETS)
    bi = jnp.arange(B)[:, None, None, None, None]
    gi = jnp.arange(G)[None, :, None, None, None]
    gi6 = jnp.arange(G)[None, :, None, None, None, None]
    ri6 = jnp.arange(R)[None, None, :, None, None, None]

    def chunk(args):
        c, qc, selc = args
        q0 = c * C
        own_blk = q0 // BS
        qpos = q0 + jnp.arange(C)
        kg = kblk[bi, gi, selc]
        vg = vblk[bi, gi, selc]
        s_past = jnp.einsum('bgrcd,bgrcksd->bgrcks', qc, kg).astype(jnp.float32) * scale
        kpos = selc[..., None] * BS + jnp.arange(BS)
        s_past = s_past + tbl[gi6, ri6, rel_bucket(qpos[:, None, None] - kpos)]
        valid = jnp.arange(K) < jnp.minimum(K, own_blk)
        s_past = jnp.where(valid[:, None], s_past, NEG)
        own_start = own_blk * BS
        k_own = lax.dynamic_slice_in_dim(kT, own_start, BS, axis=2)
        v_own = lax.dynamic_slice_in_dim(vT, own_start, BS, axis=2)
        s_own = jnp.einsum('bgrcd,bgsd->bgrcs', qc, k_own).astype(jnp.float32) * scale
        d_own = qpos[:, None] - (own_start + jnp.arange(BS))[None, :]
        s_own = s_own + tbl[:, :, rel_bucket(d_own)]
        s_own = jnp.where(d_own >= 0, s_own, NEG)
        s_all = jnp.concatenate([s_past.reshape(B, G, R, C, K * BS), s_own], axis=-1)
        prob = jax.nn.softmax(s_all, axis=-1).astype(v.dtype)
        p_past = prob[..., :K * BS].reshape(B, G, R, C, K, BS)
        return (jnp.einsum('bgrcks,bgrcksd->bgrcd', p_past, vg)
                + jnp.einsum('bgrcs,bgsd->bgrcd', prob[..., K * BS:], v_own))

    q_chunks = qh.reshape(B, G, R, NC, C, HEAD_DIM).transpose(3, 0, 1, 2, 4, 5)
    sel_chunks = sel.reshape(B, G, R, NC, C, K).transpose(3, 0, 1, 2, 4, 5)
    o = lax.map(chunk, (jnp.arange(NC), q_chunks, sel_chunks))
    return o.transpose(1, 0, 4, 2, 3, 5).reshape(B, S, MOBA_Q_W)


def hier_moe(h, w_rg, b_rg, w_re, b_re, w_g, w_u, w_d):
    T, D = h.shape
    A = T * EXPERT_TOPK
    M = DISPATCH_BLOCK
    NBLK = -(-A // M) + N_EXPERTS
    P = NBLK * M
    glog = (h @ w_rg).astype(jnp.float32) + b_rg.astype(jnp.float32)
    gprob = jax.nn.softmax(glog, axis=-1)
    gsel = jnp.argmax(glog, axis=-1)
    gw = jnp.take_along_axis(gprob, gsel[:, None], axis=1)
    elog = ((h @ w_re).astype(jnp.float32) + b_re.astype(jnp.float32)).reshape(T, N_GROUPS, EXPERTS_PER_GROUP)
    elog = jnp.take_along_axis(elog, gsel[:, None, None], axis=1)[:, 0]
    top_v, top_i = lax.top_k(elog, EXPERT_TOPK)
    w = gw * jax.nn.softmax(top_v, axis=-1)
    eid = (gsel[:, None] * EXPERTS_PER_GROUP + top_i).reshape(A)
    wflat = w.reshape(A)
    counts = jnp.bincount(eid, length=N_EXPERTS)
    start = jnp.cumsum(counts) - counts
    padded = (counts + M - 1) // M * M
    pad_end = jnp.cumsum(padded)
    pad_start = pad_end - padded
    order = jnp.argsort(eid)
    es = eid[order]
    tok = order // EXPERT_TOPK
    dest = pad_start[es] + (jnp.arange(A) - start[es])
    x_buf = jnp.zeros((P, D), h.dtype).at[dest].set(h[tok])
    block_expert = jnp.minimum(jnp.searchsorted(pad_end, jnp.arange(NBLK) * M, side='right'), N_EXPERTS - 1)

    def run_block(args):
        xb, e = args
        return (jax.nn.silu(xb @ w_g[e]) * (xb @ w_u[e])) @ w_d[e]

    out_buf = lax.map(run_block, (x_buf.reshape(NBLK, M, D), block_expert)).reshape(P, D)
    return jnp.zeros((T, D), h.dtype).at[tok].add(out_buf[dest] * wflat[order][:, None].astype(h.dtype))


def setup_inputs(seed: int = 0) -> dict:
    key = jax.random.key(seed)
    ks = jax.random.split(key, 26)
    f = jnp.float32
    def nrm(k, shape, scale):
        return jax.random.normal(k, shape, f) * scale
    def gain(k, shape):
        return 1.0 + 0.05 * jax.random.normal(k, shape, f)
    L = DEPTH
    return {
        'x': nrm(ks[0], (BATCH, SEQ, D_MODEL), 1.0),
        'p': nrm(ks[1], (DEPTH, BATCH, SEQ, PLE_DIM), 1.0),
        'rel_bias': nrm(ks[2], (REL_BUCKETS, N_HEADS), 0.2),
        'attn_norm': gain(ks[3], (L, D_MODEL)),
        'w_in': nrm(ks[4], (L, D_MODEL, IN_W), D_MODEL ** -0.5),
        'swa_q_norm': gain(ks[5], (L, HEAD_DIM)),
        'swa_k_norm': gain(ks[6], (L, HEAD_DIM)),
        'swa_sinks': nrm(ks[7], (L, SWA_Q_HEADS), 0.5),
        'moba_q_norm': gain(ks[8], (L, HEAD_DIM)),
        'moba_k_norm': gain(ks[9], (L, HEAD_DIM)),
        'swa_out_norm': gain(ks[10], (L, SWA_Q_W)),
        'moba_out_norm': gain(ks[11], (L, MOBA_Q_W)),
        'w_out': nrm(ks[12], (L, MIX_W, D_MODEL), MIX_W ** -0.5),
        'ffn_norm': gain(ks[13], (L, D_MODEL)),
        'w_router_group': nrm(ks[14], (L, D_MODEL, N_GROUPS), D_MODEL ** -0.5),
        'b_router_group': nrm(ks[15], (L, N_GROUPS), 0.01),
        'w_router_expert': nrm(ks[16], (L, D_MODEL, N_EXPERTS), D_MODEL ** -0.5),
        'b_router_expert': nrm(ks[17], (L, N_EXPERTS), 0.01),
        'w_exp_gate': nrm(ks[18], (L, N_EXPERTS, D_MODEL, D_EXPERT), D_MODEL ** -0.5),
        'w_exp_up': nrm(ks[19], (L, N_EXPERTS, D_MODEL, D_EXPERT), D_MODEL ** -0.5),
        'w_exp_down': nrm(ks[20], (L, N_EXPERTS, D_EXPERT, D_MODEL), D_EXPERT ** -0.5),
        'ple_norm': gain(ks[21], (L, D_MODEL)),
        'w_ple_gate': nrm(ks[22], (L, D_MODEL, D_MODEL), D_MODEL ** -0.5),
        'w_ple_proj': nrm(ks[23], (L, PLE_DIM, D_MODEL), PLE_DIM ** -0.5),
        'ple_out_norm': gain(ks[24], (L, D_MODEL)),
    }


def reference(x, p, rel_bias, attn_norm, w_in, swa_q_norm, swa_k_norm, swa_sinks,
              moba_q_norm, moba_k_norm, swa_out_norm, moba_out_norm, w_out, ffn_norm,
              w_router_group, b_router_group, w_router_expert, b_router_expert,
              w_exp_gate, w_exp_up, w_exp_down, ple_norm, w_ple_gate, w_ple_proj, ple_out_norm):
    B, S, D = x.shape
    swa_tbl = rel_bias[:, :SWA_Q_HEADS]
    moba_tbl = rel_bias[:, SWA_Q_HEADS:]
    for i in range(DEPTH):
        h = rms_norm(x, attn_norm[i])
        qa, ka, va, qb, kb, vb = jnp.split(h @ w_in[i], SPLITS, axis=-1)
        qa = rms_norm(qa.reshape(B, S, SWA_Q_HEADS, HEAD_DIM), swa_q_norm[i])
        ka = rms_norm(ka.reshape(B, S, SWA_KV_HEADS, HEAD_DIM), swa_k_norm[i])
        va = va.reshape(B, S, SWA_KV_HEADS, HEAD_DIM)
        qb = rms_norm(qb.reshape(B, S, MOBA_Q_HEADS, HEAD_DIM), moba_q_norm[i])
        kb = rms_norm(kb.reshape(B, S, MOBA_KV_HEADS, HEAD_DIM), moba_k_norm[i])
        vb = vb.reshape(B, S, MOBA_KV_HEADS, HEAD_DIM)
        o_a = swa_attention(qa, ka, va, swa_sinks[i], swa_tbl)
        o_b = moba_attention(qb, kb, vb, moba_tbl)
        mix = jnp.concatenate([rms_norm(o_a, swa_out_norm[i]), rms_norm(o_b, moba_out_norm[i])], axis=-1)
        x = x + mix @ w_out[i]
        hf = rms_norm(x, ffn_norm[i]).reshape(B * S, D)
        x = x + hier_moe(hf, w_router_group[i], b_router_group[i], w_router_expert[i], b_router_expert[i],
                         w_exp_gate[i], w_exp_up[i], w_exp_down[i]).reshape(B, S, D)
        gate = jax.nn.sigmoid(rms_norm(x, ple_norm[i]) @ w_ple_gate[i])
        x = x + gate * rms_norm(p[i] @ w_ple_proj[i], ple_out_norm[i])
    return x
```

```cpp
#include <hip/hip_runtime.h>
#include <cstdio>
#include <cstdint>

#ifndef MK_N_LAUNCHES
#define MK_N_LAUNCHES 9
#endif

#define LAS __attribute__((address_space(3)))
#define GAS __attribute__((address_space(1)))
typedef unsigned short bf16_t;
typedef short bf16x8 __attribute__((ext_vector_type(8)));
typedef float f32x4 __attribute__((ext_vector_type(4)));
typedef float f32x2 __attribute__((ext_vector_type(2)));
typedef unsigned u32x4 __attribute__((ext_vector_type(4)));
typedef unsigned u32x2 __attribute__((ext_vector_type(2)));

constexpr int BATCH = 8, SEQ = 2048, DM = 1024, T = BATCH * SEQ;
constexpr int INW = 1536, NHQ = 16, HD = 64;
constexpr int NEXP = 32, DEXP = 512, PLE = 256;
constexpr int MAXTILES = 160;
constexpr float EPS = 1e-6f;
constexpr float LOG2E = 1.4426950408889634f;
constexpr float QSCALE = 0.125f * LOG2E;
constexpr int NWAVES = 8, NTHREADS = 512;

constexpr int C_QA = 0, C_KA = 512, C_VA = 640, C_QB = 768, C_KB = 1280, C_VB = 1408;

constexpr size_t KiB = 1024, MiB = 1u << 20;
constexpr size_t WS_CTL = 0, CTL_ZERO_BYTES = 1 * MiB;
constexpr size_t WS_RS1 = 1 * MiB, WS_R2 = WS_RS1 + 64 * KiB, WS_R3 = WS_R2 + 64 * KiB, WS_KMP = WS_R3 + 64 * KiB;
constexpr size_t WS_WR = WS_KMP + 64 * KiB;
constexpr size_t WS_BIAS = WS_WR + 192 * KiB;
constexpr size_t WS_TOK = 1 * MiB + 512 * KiB;
constexpr size_t WS_SSQ = 2 * MiB;
constexpr size_t WS_SSQP = 3 * MiB;
constexpr size_t WS_LIST = 4 * MiB;
constexpr size_t WS_WIN = 8 * MiB, WS_WOUT = 11 * MiB, WS_WPG = 13 * MiB, WS_WPP = 15 * MiB;
constexpr size_t WS_WGU = 16 * MiB;
constexpr size_t WS_WD = 80 * MiB;
constexpr size_t WS_QKV = 112 * MiB;
constexpr size_t WS_XB = 160 * MiB;
constexpr size_t WS_O = 192 * MiB;
constexpr size_t WS_Y = 160 * MiB;
constexpr size_t WS_PB = 224 * MiB;
constexpr size_t WS_PRAW = 232 * MiB;
constexpr size_t WS_END = 264 * MiB;
constexpr int CW_CNT = 64;
constexpr int CW_BAR = 4096;

constexpr int RING_BYTES = 131072;
constexpr int MISC_OFF = 147456;
constexpr int LDS_BYTES = 163840;

__device__ __forceinline__ unsigned f2bf(float f) { unsigned u = __builtin_bit_cast(unsigned, f); return (u + 0x7fffu + ((u >> 16) & 1u)) >> 16; }
__device__ __forceinline__ unsigned pk2(float lo, float hi) { return f2bf(lo) | (f2bf(hi) << 16); }
__device__ __forceinline__ float bf2f(unsigned short h) { return __builtin_bit_cast(float, (unsigned)h << 16); }
__device__ __forceinline__ float bflo(unsigned w) { return __builtin_bit_cast(float, w << 16); }
__device__ __forceinline__ float bfhi(unsigned w) { return __builtin_bit_cast(float, w & 0xffff0000u); }
__device__ __forceinline__ float wave_sum(float v) {
#pragma unroll
    for (int o = 1; o < 64; o <<= 1) v += __shfl_xor(v, o);
    return v;
}
__device__ __forceinline__ float wave_max(float v) {
#pragma unroll
    for (int o = 1; o < 64; o <<= 1) v = fmaxf(v, __shfl_xor(v, o));
    return v;
}
#define LDS_WAIT() asm volatile("s_waitcnt lgkmcnt(0)" ::: "memory")
#define VM_WAIT() asm volatile("s_waitcnt vmcnt(0)" ::: "memory")

namespace pg8 {
constexpr int BM = 256, BK = 64, HALF = 128, HTB = HALF * BK * 2, STAGE_BYTES = 8 * HTB, NXCD = 8, WGM = 8;
__host__ __device__ __forceinline__ int lds_byte(int r, int c) { const int st = (r >> 4) * 2 + (c >> 5), rr = r & 15, cc = c & 31, ob = rr * 64 + cc * 2; return st * 1024 + (ob ^ (((ob >> 9) & 1) << 5)); }
__host__ __device__ __forceinline__ void stage_rc(int b, int& R, int& C) { const int st = b / 1024, sb = b % 1024, swz = sb ^ (((sb >> 9) & 1) << 5); R = (st >> 1) * 16 + swz / 64; C = (st & 1) * 32 + (swz % 64) / 2; }
__host__ __device__ __forceinline__ int perm32(int rho) { const int n = rho >> 4, i = rho & 15; return 8 * (i >> 2) + 4 * n + (i & 3); }

struct Unit { const char* A; const char* B; int pm, pn, e, nvalid; };

__device__ __forceinline__ bool static_tile(int i, int G, int c, int nM, int nN, int& pm, int& pn) {
    const int nwg = nM * nN; const long L = (long)i * G + c; if (L >= nwg) return false;
    int wgid = (int)L; { const int q = nwg / NXCD, r = nwg % NXCD, xcd = wgid % NXCD, off = wgid / NXCD; wgid = (xcd < r ? xcd * (q + 1) : r * (q + 1) + (xcd - r) * q) + off; }
    const int nig = WGM * nN, gid = wgid / nig, fm = gid * WGM, gsz = (nM - fm) < WGM ? (nM - fm) : WGM;
    pm = fm + ((wgid % nig) % gsz); pn = (wgid % nig) / gsz; return true;
}
struct DenseOrder {
    const char* A; const char* Bt; int nM, nN, K, G, c;
    __device__ __forceinline__ bool next(int i, Unit& u) const {
        int pm, pn; if (!static_tile(i, G, c, nM, nN, pm, pn)) return false;
        u.pm = pm; u.pn = pn; u.e = 0; u.nvalid = 256; u.A = A + (size_t)pm * 256 * K * 2; u.B = Bt + (size_t)pn * 256 * K * 2; return true;
    }
    __device__ __forceinline__ unsigned row_off(const Unit&, int) const { return 0u; }
};

__device__ __forceinline__ unsigned cvt_pk_bf16(float lo, float hi) { unsigned r; asm volatile("v_cvt_pk_bf16_f32 %0, %1, %2" : "=v"(r) : "v"(lo), "v"(hi)); return r; }

template <class Epi, class Sched, bool ALIGN_EPI, bool GATHER, bool MID>
__device__ __forceinline__ void gemm_phase(LAS unsigned char* lds, const int K, const Sched& S, const Epi& E) {
    const int tid = threadIdx.x, wid = __builtin_amdgcn_readfirstlane(tid >> 6), lane = tid & 63, wr = wid >> 2, wc = wid & 3, fr = lane & 15, fq = lane >> 4;
    const int nt = K / BK;
    int Rst[2], Cst[2]; unsigned voffB[2];
#pragma unroll
    for (int i = 0; i < 2; ++i) { int R, C; stage_rc(tid * 16 + i * 8192, R, C); Rst[i] = R; Cst[i] = C; const int Rb = Epi::PERM ? ((R & ~31) + perm32(R & 31)) : R; voffB[i] = (unsigned)(Rb * K + C) * 2u; }
    const size_t kstep = (size_t)(BK * 2);
    const size_t hstep = (size_t)HALF * K * 2;
    const unsigned ldsw = (unsigned)wid * 1024u;
    const int aoff = lds_byte(wr * 64 + fr, fq * 8), boff = lds_byte(wc * 32 + fr, fq * 8);
#define PG8_SA(b, h) (((b) * 2 + (h)) * HTB)
#define PG8_SB(b, h) ((4 + (b) * 2 + (h)) * HTB)
#define PG8_STAGE(bufoff, gbase, voff) do { _Pragma("unroll") for (int _i = 0; _i < 2; ++_i) \
        __builtin_amdgcn_global_load_lds((const unsigned*)((const char*)(gbase) + (voff)[_i]), (LAS unsigned*)(lds + (bufoff) + ldsw + _i * 8192), 16, 0, 0); } while (0)
#define PG8_LDA(dst, b, h) do { _Pragma("unroll") for (int m = 0; m < 4; ++m) _Pragma("unroll") for (int k = 0; k < 2; ++k) dst[m][k] = *(const LAS bf16x8*)(lds + PG8_SA(b, h) + aoff + m * 2048 + k * 1024); } while (0)
#define PG8_LDB(dst, b, h) do { _Pragma("unroll") for (int n = 0; n < 2; ++n) _Pragma("unroll") for (int k = 0; k < 2; ++k) dst[n][k] = *(const LAS bf16x8*)(lds + PG8_SB(b, h) + boff + n * 2048 + k * 1024); } while (0)
#define PG8_MMA(ai, bj, At, Bt) do { __builtin_amdgcn_s_setprio(1); _Pragma("unroll") for (int m = 0; m < 4; ++m) _Pragma("unroll") for (int n = 0; n < 2; ++n) _Pragma("unroll") for (int k = 0; k < 2; ++k) \
        acc[ai][bj][m][n] = __builtin_amdgcn_mfma_f32_16x16x32_bf16(Bt[n][k], At[m][k], acc[ai][bj][m][n], 0, 0, 0); __builtin_amdgcn_s_setprio(0); } while (0)
#define PG8_WAIT_V(n) asm volatile("s_waitcnt vmcnt(" #n ")" ::: "memory")
#define PG8_WAIT_L(n) asm volatile("s_waitcnt lgkmcnt(" #n ")" ::: "memory")
#define PG8_BAR __builtin_amdgcn_s_barrier()
#define PG8_SCHED __builtin_amdgcn_sched_barrier(0)
#define PG8_AOFFS(dst, u) do { _Pragma("unroll") for (int _h = 0; _h < 2; ++_h) _Pragma("unroll") for (int _i = 0; _i < 2; ++_i) { \
        if constexpr (GATHER) dst[_h][_i] = S.row_off(u, _h * HALF + Rst[_i]) + (unsigned)Cst[_i] * 2u; \
        else dst[_h][_i] = (unsigned)((_h * HALF + Rst[_i]) * K + Cst[_i]) * 2u; } \
        if constexpr (GATHER) { asm volatile("" : "+v"(dst[0][0]), "+v"(dst[0][1]), "+v"(dst[1][0]), "+v"(dst[1][1]) :: "memory"); } } while (0)
    Unit cur, nxt; int ui = 0;
    if (!S.next(0, cur)) return;
    bool has_next = S.next(1, nxt);
    unsigned vA[2][2], vN[2][2];
    PG8_AOFFS(vA, cur);
    if (has_next) { PG8_AOFFS(vN, nxt); } else {
#pragma unroll
        for (int h = 0; h < 2; ++h) { vN[h][0] = vA[h][0]; vN[h][1] = vA[h][1]; } }
    f32x4 acc[2][2][4][2];
#pragma unroll
    for (int a = 0; a < 2; ++a)
#pragma unroll
        for (int b = 0; b < 2; ++b)
#pragma unroll
            for (int m = 0; m < 4; ++m)
#pragma unroll
                for (int n = 0; n < 2; ++n) acc[a][b][m][n] = (f32x4){0.f, 0.f, 0.f, 0.f};
    bf16x8 At[4][2], B0[2][2], B1[2][2];
    const char* cA = cur.A; const char* cB = cur.B;
    PG8_STAGE(PG8_SB(0, 0), cB, voffB); PG8_STAGE(PG8_SB(0, 1), cB + hstep, voffB); PG8_STAGE(PG8_SA(0, 0), cA, vA[0]); PG8_STAGE(PG8_SA(0, 1), cA, vA[1]);
    if (wr == 1) PG8_BAR;
    PG8_WAIT_V(2); PG8_BAR;
    PG8_STAGE(PG8_SB(1, 0), cB + kstep, voffB); PG8_STAGE(PG8_SA(1, 0), cA + kstep, vA[0]); PG8_STAGE(PG8_SB(1, 1), cB + hstep + kstep, voffB);
    PG8_WAIT_V(6); PG8_BAR;
    for (;;) {
        const char* nA = has_next ? nxt.A : cA; const char* nB = has_next ? nxt.B : cB;
#pragma unroll 1
        for (int t = 0; t < nt; t += 2) {
            const bool last = (t == nt - 2);
            if constexpr (MID) { if (t == nt / 2) E.mid(acc, cur, wr, wc, fr, fq); }
            const char* a1 = cA + (size_t)(t + 1) * kstep;
            const char* a2 = last ? nA : cA + (size_t)(t + 2) * kstep; const char* b2 = last ? nB : cB + (size_t)(t + 2) * kstep;
            const char* a3 = a2 + kstep; const char* b3 = b2 + kstep;
            unsigned v2[2][2];
#pragma unroll
            for (int h = 0; h < 2; ++h) { v2[h][0] = last ? vN[h][0] : vA[h][0]; v2[h][1] = last ? vN[h][1] : vA[h][1]; }
            PG8_LDB(B0, 0, 0); PG8_LDB(B1, 0, 1); PG8_SCHED; PG8_LDA(At, 0, 0); PG8_STAGE(PG8_SA(1, 1), a1, vA[1]);
            PG8_WAIT_V(8); PG8_WAIT_L(0); PG8_BAR; PG8_MMA(0, 0, At, B0); PG8_MMA(0, 1, At, B1); PG8_BAR; PG8_SCHED;
            PG8_LDA(At, 0, 1); PG8_STAGE(PG8_SB(0, 0), b2, voffB); PG8_STAGE(PG8_SB(0, 1), b2 + hstep, voffB); PG8_STAGE(PG8_SA(0, 0), a2, v2[0]);
            PG8_WAIT_V(8); PG8_WAIT_L(0); PG8_BAR; PG8_MMA(1, 0, At, B0); PG8_MMA(1, 1, At, B1); PG8_BAR; PG8_SCHED;
            PG8_LDB(B0, 1, 0); PG8_LDB(B1, 1, 1); PG8_SCHED; PG8_LDA(At, 1, 0); PG8_STAGE(PG8_SA(0, 1), a2, v2[1]);
            PG8_WAIT_V(8); PG8_WAIT_L(0); PG8_BAR; PG8_MMA(0, 0, At, B0); PG8_MMA(0, 1, At, B1); PG8_BAR; PG8_SCHED;
            PG8_LDA(At, 1, 1); PG8_STAGE(PG8_SB(1, 0), b3, voffB); PG8_STAGE(PG8_SB(1, 1), b3 + hstep, voffB); PG8_STAGE(PG8_SA(1, 0), a3, v2[0]);
            PG8_WAIT_V(8); PG8_WAIT_L(0); PG8_BAR; PG8_MMA(1, 0, At, B0); PG8_MMA(1, 1, At, B1); PG8_BAR; PG8_SCHED;
        }
        if constexpr (ALIGN_EPI) { if (wr == 0) PG8_BAR; }
        E(acc, cur, wr, wc, fr, fq);
        if (!has_next) break;
#pragma unroll
        for (int a = 0; a < 2; ++a)
#pragma unroll
            for (int b = 0; b < 2; ++b)
#pragma unroll
                for (int m = 0; m < 4; ++m)
#pragma unroll
                    for (int n = 0; n < 2; ++n) acc[a][b][m][n] = (f32x4){0.f, 0.f, 0.f, 0.f};
        cur = nxt; cA = nA; cB = nB; ++ui;
#pragma unroll
        for (int h = 0; h < 2; ++h) { vA[h][0] = vN[h][0]; vA[h][1] = vN[h][1]; }
        has_next = S.next(ui + 1, nxt);
        if (has_next) { PG8_AOFFS(vN, nxt); }
        if constexpr (ALIGN_EPI) { if (wr == 1) PG8_BAR; }
    }
    PG8_WAIT_V(0);
    if constexpr (!ALIGN_EPI) { if (wr == 0) PG8_BAR; }
    PG8_BAR;
#undef PG8_SA
#undef PG8_SB
#undef PG8_STAGE
#undef PG8_LDA
#undef PG8_LDB
#undef PG8_MMA
#undef PG8_WAIT_V
#undef PG8_WAIT_L
#undef PG8_BAR
#undef PG8_SCHED
#undef PG8_AOFFS
}
}

struct Args { const float* in[25]; float* out; unsigned char* ws; int ph_lo, ph_hi, li, pad; };
struct Frame {
    LAS unsigned char* lds; unsigned char* ws; GAS unsigned* ctl;
    int tid, lane, wave, vcu, G;
    const float* in[25]; float* out;
};
enum { I_X = 0, I_P, I_RELB, I_ATTN_NORM, I_W_IN, I_SWA_QN, I_SWA_KN, I_SINKS, I_MOBA_QN, I_MOBA_KN, I_SWA_ON, I_MOBA_ON, I_W_OUT, I_FFN_NORM,
       I_W_RG, I_B_RG, I_W_RE, I_B_RE, I_W_EG, I_W_EU, I_W_ED, I_PLE_NORM, I_W_PG, I_W_PP, I_PLE_ON };

template <class RowMap>
__device__ __forceinline__ void p0_transpose_item(const float* W, int K, int N, bf16_t* WT, const float* gk, LAS float* scr, int item, int lane, const RowMap& rowmap) {
    const int nblk = N / 32, kb = item / nblk, nb = item % nblk, k0 = 64 * kb, n0 = 32 * nb;
#pragma unroll 8
    for (int i = 0; i < 32; ++i) { const int kk = 2 * i + (lane >> 5); float v = W[(size_t)(k0 + kk) * N + n0 + (lane & 31)]; if (gk) v *= gk[k0 + kk]; scr[kk * 33 + (lane & 31)] = v; }
    LDS_WAIT(); asm volatile("" ::: "memory");
    const int c = lane & 7; const int drow0 = rowmap(n0);
#pragma unroll
    for (int j = 0; j < 4; ++j) { const int n = (lane >> 3) + 8 * j; const LAS float* s = scr + (8 * c) * 33 + n;
        u32x4 o; o.x = pk2(s[0 * 33], s[1 * 33]); o.y = pk2(s[2 * 33], s[3 * 33]); o.z = pk2(s[4 * 33], s[5 * 33]); o.w = pk2(s[6 * 33], s[7 * 33]);
        *(GAS u32x4*)(WT + (size_t)(drow0 + n) * K + k0 + 8 * c) = o; }
    LDS_WAIT(); asm volatile("" ::: "memory");
}
struct MapPlain { __device__ __forceinline__ int operator()(int n0) const { return n0; } };
struct MapIn {
    __device__ __forceinline__ int operator()(int n0) const { const int head = n0 >> 6, d = n0 & 63; return 256 * (head >> 2) + 128 * (d >> 5) + 32 * (head & 3) + (d & 31); } };
struct MapGU { int up;
    __device__ __forceinline__ int operator()(int n0) const { return 256 * (n0 >> 7) + 128 * up + (n0 & 127); } };

__constant__ unsigned char c_bucket[128] = {0,1,2,3,4,5,6,7,8,9,10,11,12,13,14,15,16,16,16,17,17,18,18,18,19,19,19,20,20,20,20,21,21,21,21,22,22,22,22,22,23,23,23,23,23,23,24,24,24,24,24,24,25,25,25,25,25,25,25,26,26,26,26,26,26,26,26,27,27,27,27,27,27,27,27,27,27,28,28,28,28,28,28,28,28,28,28,29,29,29,29,29,29,29,29,29,29,29,29,30,30,30,30,30,30,30,30,30,30,30,30,30,30,31,31,31,31,31,31,31,31,31,31,31,31,31,31,31};

__device__ __forceinline__ void p0_prologue(Frame& F) {
    LAS float* scr = (LAS float*)(F.lds + F.wave * 16384);
    const int gw = F.vcu * NWAVES + F.wave, NGW = F.G * NWAVES;
    bf16_t* Win = (bf16_t*)(F.ws + WS_WIN); bf16_t* Wout = (bf16_t*)(F.ws + WS_WOUT); bf16_t* Wpg = (bf16_t*)(F.ws + WS_WPG); bf16_t* Wpp = (bf16_t*)(F.ws + WS_WPP);
    bf16_t* Wgu = (bf16_t*)(F.ws + WS_WGU); bf16_t* Wd = (bf16_t*)(F.ws + WS_WD);
    constexpr int I_IN = (DM / 64) * (INW / 32), I_OUT = (DM / 64) * (DM / 32), I_PG = I_OUT, I_PP = (PLE / 64) * (DM / 32);
    constexpr int I_G1 = (DM / 64) * (DEXP / 32), I_D1 = (DEXP / 64) * (DM / 32);
    constexpr int NITEMS = I_IN + I_OUT + I_PG + I_PP + NEXP * (2 * I_G1 + I_D1);
    for (int it = gw; it < NITEMS; it += NGW) {
        int r = it;
        if (r < I_IN) { p0_transpose_item(F.in[I_W_IN], DM, INW, Win, F.in[I_ATTN_NORM], scr, r, F.lane, MapIn{}); continue; } r -= I_IN;
        if (r < I_OUT) {
            const int kb = r / (DM / 32); const float* g = (kb < 8) ? F.in[I_SWA_ON] : (F.in[I_MOBA_ON] - 512);
            p0_transpose_item(F.in[I_W_OUT], DM, DM, Wout, g, scr, r, F.lane, MapPlain{}); continue; } r -= I_OUT;
        if (r < I_PG) { p0_transpose_item(F.in[I_W_PG], DM, DM, Wpg, F.in[I_PLE_NORM], scr, r, F.lane, MapPlain{}); continue; } r -= I_PG;
        if (r < I_PP) { p0_transpose_item(F.in[I_W_PP], PLE, DM, Wpp, nullptr, scr, r, F.lane, MapPlain{}); continue; } r -= I_PP;
        const int e = r / (2 * I_G1 + I_D1); r -= e * (2 * I_G1 + I_D1);
        if (r < I_G1) { p0_transpose_item(F.in[I_W_EG] + (size_t)e * DM * DEXP, DM, DEXP, Wgu + (size_t)e * DM * DM, F.in[I_FFN_NORM], scr, r, F.lane, MapGU{0}); continue; } r -= I_G1;
        if (r < I_G1) { p0_transpose_item(F.in[I_W_EU] + (size_t)e * DM * DEXP, DM, DEXP, Wgu + (size_t)e * DM * DM, F.in[I_FFN_NORM], scr, r, F.lane, MapGU{1}); continue; } r -= I_G1;
        p0_transpose_item(F.in[I_W_ED] + (size_t)e * DEXP * DM, DEXP, DM, Wd + (size_t)e * DM * DEXP, nullptr, scr, r, F.lane, MapPlain{});
    }
    const float* x = F.in[I_X]; bf16_t* xb = (bf16_t*)(F.ws + WS_XB); float* rs1 = (float*)(F.ws + WS_RS1);
    for (int m = gw; m < T; m += NGW) {
        const GAS f32x4* xr = (const GAS f32x4*)(x + (size_t)m * DM) + F.lane; f32x4 v[4]; float s = 0.f;
#pragma unroll
        for (int j = 0; j < 4; ++j) { v[j] = xr[64 * j]; s += (v[j].x * v[j].x + v[j].y * v[j].y) + (v[j].z * v[j].z + v[j].w * v[j].w); }
        s = wave_sum(s);
        GAS u32x2* o8 = (GAS u32x2*)(xb + (size_t)m * DM) + F.lane;
#pragma unroll
        for (int j = 0; j < 4; ++j) { u32x2 w; w.x = pk2(v[j].x, v[j].y); w.y = pk2(v[j].z, v[j].w); o8[64 * j] = w; }
        if (F.lane == 0) rs1[m] = 1.0f / sqrtf(s * (1.0f / DM) + EPS);
    }
    { const GAS f32x4* p4 = (const GAS f32x4*)F.in[I_P]; GAS u32x2* o = (GAS u32x2*)(F.ws + WS_PB); const int n4 = T * PLE / 4;
      for (int i = (F.vcu * NTHREADS + F.tid); i < n4; i += F.G * NTHREADS) { const f32x4 v = p4[i]; u32x2 w; w.x = pk2(v.x, v.y); w.y = pk2(v.z, v.w); o[i] = w; } }
    { float* Wr = (float*)(F.ws + WS_WR); const float* g = F.in[I_FFN_NORM];
      for (int i = (F.vcu * NTHREADS + F.tid); i < 36 * DM; i += F.G * NTHREADS) { const int o = i / DM, c = i % DM;
          const float w = (o < 4) ? F.in[I_W_RG][c * 4 + o] : F.in[I_W_RE][c * 32 + (o - 4)]; Wr[i] = g[c] * w; } }
    { float* tab = (float*)(F.ws + WS_BIAS);
      for (int i = (F.vcu * NTHREADS + F.tid); i < 16 * 132; i += F.G * NTHREADS) { const int hh = i / 132, dd = i % 132; const int bk = dd < 128 ? (int)c_bucket[dd] : 31;
          tab[i] = F.in[I_RELB][bk * NHQ + hh] * LOG2E; } }
}

using pg8::Unit;
struct EpiQKV {
    static constexpr bool PERM = true;
    bf16_t* qkv; const float* rs1; const float* gq_a; const float* gk_a; const float* gq_b; const float* gk_b; float* kmp;
    __device__ __forceinline__ void operator()(const f32x4 (&acc)[2][2][4][2], const Unit& u, int wr, int wc, int fr, int fq) const {
        const int head = 4 * u.pn + wc;
        const float* gain = nullptr; float qs = 1.f; bool kmean = false;
        if (head < 8) { gain = gq_a; qs = QSCALE; } else if (head < 10) { gain = gk_a; } else if (head < 12) {} else if (head < 20) { gain = gq_b; qs = QSCALE; } else if (head < 22) { gain = gk_b; kmean = true; }
        f32x4 gv[2][2];
#pragma unroll
        for (int bj = 0; bj < 2; ++bj)
#pragma unroll
            for (int n = 0; n < 2; ++n) { if (gain) { gv[bj][n] = *(const f32x4*)(gain + 32 * bj + 8 * fq + 4 * n) * qs; } else gv[bj][n] = (f32x4){1.f, 1.f, 1.f, 1.f}; }
        f32x4 ks[2][2];
#pragma unroll
        for (int bj = 0; bj < 2; ++bj)
#pragma unroll
            for (int n = 0; n < 2; ++n) ks[bj][n] = (f32x4){0.f, 0.f, 0.f, 0.f};
#pragma unroll
        for (int ai = 0; ai < 2; ++ai)
#pragma unroll
            for (int m = 0; m < 4; ++m) {
                const int row = u.pm * 256 + ai * 128 + wr * 64 + m * 16 + fr; const float rs = rs1[row];
                f32x4 v[2][2]; float ss = 0.f;
#pragma unroll
                for (int bj = 0; bj < 2; ++bj)
#pragma unroll
                    for (int n = 0; n < 2; ++n) { v[bj][n] = acc[ai][bj][m][n] * rs; const f32x4 q = v[bj][n] * v[bj][n]; ss += (q[0] + q[1]) + (q[2] + q[3]); }
                float rn = 1.f;
                if (gain) { ss += __shfl_xor(ss, 16); ss += __shfl_xor(ss, 32); rn = 1.0f / sqrtf(ss * (1.0f / HD) + EPS); }
                bf16_t* rowp = qkv + (size_t)row * INW + 64 * head + 8 * fq;
#pragma unroll
                for (int bj = 0; bj < 2; ++bj) { const f32x4 v0 = v[bj][0] * rn * gv[bj][0], v1 = v[bj][1] * rn * gv[bj][1];
                    if (kmean) { ks[bj][0] += v0; ks[bj][1] += v1; }
                    u32x4 w; w.x = pg8::cvt_pk_bf16(v0[0], v0[1]); w.y = pg8::cvt_pk_bf16(v0[2], v0[3]); w.z = pg8::cvt_pk_bf16(v1[0], v1[1]); w.w = pg8::cvt_pk_bf16(v1[2], v1[3]);
                    *(u32x4*)(rowp + 32 * bj) = w; }
            }
        if (kmean) {
#pragma unroll
            for (int bj = 0; bj < 2; ++bj)
#pragma unroll
                for (int n = 0; n < 2; ++n)
#pragma unroll
                    for (int i = 0; i < 4; ++i) { float s = ks[bj][n][i]; s += __shfl_xor(s, 1); s += __shfl_xor(s, 2); s += __shfl_xor(s, 4); s += __shfl_xor(s, 8);
                        if (fr == 0) kmp[((u.pm * 2 + wr) * 2 + (head - 20)) * 64 + 32 * bj + 8 * fq + 4 * n + i] = s; }
        }
    }
};
struct EpiProj {
    static constexpr bool PERM = true;
    bf16_t* praw; float* ssqp;
    __device__ __forceinline__ void operator()(const f32x4 (&acc)[2][2][4][2], const Unit& u, int wr, int wc, int fr, int fq) const {
#pragma unroll
        for (int ai = 0; ai < 2; ++ai)
#pragma unroll
            for (int m = 0; m < 4; ++m) {
                const int row = u.pm * 256 + ai * 128 + wr * 64 + m * 16 + fr; float ss = 0.f;
                bf16_t* rowp = praw + (size_t)row * DM + u.pn * 256 + wc * 32 + 8 * fq;
#pragma unroll
                for (int bj = 0; bj < 2; ++bj) { const f32x4 v0 = acc[ai][bj][m][0], v1 = acc[ai][bj][m][1];
                    const f32x4 q = v0 * v0 + v1 * v1; ss += (q[0] + q[1]) + (q[2] + q[3]);
                    u32x4 w; w.x = pg8::cvt_pk_bf16(v0[0], v0[1]); w.y = pg8::cvt_pk_bf16(v0[2], v0[3]); w.z = pg8::cvt_pk_bf16(v1[0], v1[1]); w.w = pg8::cvt_pk_bf16(v1[2], v1[3]);
                    *(u32x4*)(rowp + 128 * bj) = w; }
                ss += __shfl_xor(ss, 16); ss += __shfl_xor(ss, 32);
                if (fq == 0) ssqp[(size_t)row * 16 + u.pn * 4 + wc] = ss;
            }
    }
};
struct EpiOut {
    static constexpr bool PERM = false;
    const float* x; float* x1; bf16_t* x1b; const float* ssq;
    __device__ __forceinline__ void scales(int row, float& sa, float& sb) const {
        const f32x4* p = (const f32x4*)(ssq + (size_t)row * 16); const f32x4 a0 = p[0], a1 = p[1], b0 = p[2], b1 = p[3];
        const float qa = ((a0[0] + a0[1]) + (a0[2] + a0[3])) + ((a1[0] + a1[1]) + (a1[2] + a1[3]));
        const float qb = ((b0[0] + b0[1]) + (b0[2] + b0[3])) + ((b1[0] + b1[1]) + (b1[2] + b1[3]));
        sa = 1.0f / sqrtf(qa * (1.0f / 512.f) + EPS); sb = 1.0f / sqrtf(qb * (1.0f / 512.f) + EPS);
    }
    __device__ __forceinline__ void mid(f32x4 (&acc)[2][2][4][2], const Unit& u, int wr, int wc, int fr, int fq) const {
#pragma unroll
        for (int ai = 0; ai < 2; ++ai)
#pragma unroll
            for (int m = 0; m < 4; ++m) { const int row = u.pm * 256 + ai * 128 + wr * 64 + m * 16 + fr; float sa, sb; scales(row, sa, sb); const float r = sa / sb;
#pragma unroll
                for (int bj = 0; bj < 2; ++bj)
#pragma unroll
                    for (int n = 0; n < 2; ++n) acc[ai][bj][m][n] *= r; }
    }
    __device__ __forceinline__ void operator()(const f32x4 (&acc)[2][2][4][2], const Unit& u, int wr, int wc, int fr, int fq) const {
        const int col0 = u.pn * 256 + wc * 32 + 4 * fq;
#pragma unroll
        for (int ai = 0; ai < 2; ++ai)
#pragma unroll
            for (int m = 0; m < 4; ++m) { const int row = u.pm * 256 + ai * 128 + wr * 64 + m * 16 + fr; float sa, sb; scales(row, sa, sb); const size_t off = (size_t)row * DM + col0;
#pragma unroll
                for (int bj = 0; bj < 2; ++bj)
#pragma unroll
                    for (int n = 0; n < 2; ++n) { const f32x4 xv = *(const f32x4*)(x + off + bj * 128 + n * 16); const f32x4 o = xv + acc[ai][bj][m][n] * sb;
                        *(f32x4*)(x1 + off + bj * 128 + n * 16) = o; u32x2 w; w.x = pg8::cvt_pk_bf16(o[0], o[1]); w.y = pg8::cvt_pk_bf16(o[2], o[3]); *(u32x2*)(x1b + off + bj * 128 + n * 16) = w; } }
    }
};
struct MoeOrder {
    const char* A; const char* Bt; const LAS int* tb; const unsigned* cnt; const unsigned* list; int K; size_t wstride; size_t arow_bytes; int G, c; bool gather;
    __device__ __forceinline__ bool next(int i, Unit& u) const {
        const int NT = tb[NEXP]; const int nwg = NT * 4; const long L = (long)i * G + c; if (L >= nwg) return false;
        int wgid = (int)L; { const int q = nwg / 8, r = nwg % 8, xcd = wgid % 8, off = wgid / 8; wgid = (xcd < r ? xcd * (q + 1) : r * (q + 1) + (xcd - r) * q) + off; }
        const int gt = wgid >> 2, pn = wgid & 3; int e = 0;
#pragma unroll 1
        while (e < NEXP - 1 && gt >= tb[e + 1]) ++e;
        const int lt = gt - tb[e]; const int nv = (int)cnt[e] - lt * 256;
        u.pm = gt; u.pn = pn; u.e = e * 16384 + lt * 256; u.nvalid = nv < 256 ? nv : 256;
        u.A = gather ? A : A + (size_t)gt * 256 * arow_bytes; u.B = Bt + (size_t)e * wstride + (size_t)pn * 256 * K * 2; return true;
    }
    __device__ __forceinline__ unsigned row_off(const Unit& u, int r) const {
        const unsigned ent = (r < u.nvalid) ? list[u.e + r] : 0u; return (ent >> 1) * (unsigned)arow_bytes;
    }
};
struct EpiG1 {
    static constexpr bool PERM = true;
    bf16_t* H; const float* r2; const unsigned* list;
    __device__ __forceinline__ void operator()(const f32x4 (&acc)[2][2][4][2], const Unit& u, int wr, int wc, int fr, int fq) const {
#pragma unroll
        for (int ai = 0; ai < 2; ++ai)
#pragma unroll
            for (int m = 0; m < 4; ++m) { const int r = ai * 128 + wr * 64 + m * 16 + fr; const unsigned ent = (r < u.nvalid) ? list[u.e + r] : 0u; const float rs = r2[ent >> 1];
                float h[8];
#pragma unroll
                for (int n = 0; n < 2; ++n)
#pragma unroll
                    for (int i = 0; i < 4; ++i) { const float g = acc[ai][0][m][n][i] * rs, up = acc[ai][1][m][n][i] * rs; h[4 * n + i] = g / (1.0f + __builtin_amdgcn_exp2f(-g * LOG2E)) * up; }
                u32x4 w; w.x = pg8::cvt_pk_bf16(h[0], h[1]); w.y = pg8::cvt_pk_bf16(h[2], h[3]); w.z = pg8::cvt_pk_bf16(h[4], h[5]); w.w = pg8::cvt_pk_bf16(h[6], h[7]);
                *(u32x4*)(H + (size_t)(u.pm * 256 + r) * DEXP + u.pn * 128 + wc * 32 + 8 * fq) = w; }
    }
};
struct EpiG2 {
    static constexpr bool PERM = true;
    bf16_t* Y; const unsigned* list;
    __device__ __forceinline__ void operator()(const f32x4 (&acc)[2][2][4][2], const Unit& u, int wr, int wc, int fr, int fq) const {
#pragma unroll
        for (int ai = 0; ai < 2; ++ai)
#pragma unroll
            for (int m = 0; m < 4; ++m) { const int r = ai * 128 + wr * 64 + m * 16 + fr;
                if (r < u.nvalid) { const unsigned ent = list[u.e + r]; bf16_t* rowp = Y + (size_t)ent * DM + u.pn * 256 + wc * 32 + 8 * fq;
#pragma unroll
                    for (int bj = 0; bj < 2; ++bj) { const f32x4 v0 = acc[ai][bj][m][0], v1 = acc[ai][bj][m][1];
                        u32x4 w; w.x = pg8::cvt_pk_bf16(v0[0], v0[1]); w.y = pg8::cvt_pk_bf16(v0[2], v0[3]); w.z = pg8::cvt_pk_bf16(v1[0], v1[1]); w.w = pg8::cvt_pk_bf16(v1[2], v1[3]);
                        *(u32x4*)(rowp + 128 * bj) = w; } } }
    }
};
struct EpiFinal {
    static constexpr bool PERM = false;
    float* out; const float* r3; const bf16_t* praw; const float* ssqp; const float* gout;
    __device__ __forceinline__ void operator()(const f32x4 (&acc)[2][2][4][2], const Unit& u, int wr, int wc, int fr, int fq) const {
        const int col0 = u.pn * 256 + wc * 32 + 4 * fq;
        f32x4 gv[2][2];
#pragma unroll
        for (int bj = 0; bj < 2; ++bj)
#pragma unroll
            for (int n = 0; n < 2; ++n) gv[bj][n] = *(const f32x4*)(gout + col0 + bj * 128 + n * 16);
#pragma unroll
        for (int ai = 0; ai < 2; ++ai)
#pragma unroll
            for (int m = 0; m < 4; ++m) { const int row = u.pm * 256 + ai * 128 + wr * 64 + m * 16 + fr; const float rs = r3[row];
                const f32x4* sp = (const f32x4*)(ssqp + (size_t)row * 16); const f32x4 s0 = sp[0], s1 = sp[1], s2 = sp[2], s3 = sp[3];
                const float q = (((s0[0] + s0[1]) + (s0[2] + s0[3])) + ((s1[0] + s1[1]) + (s1[2] + s1[3]))) + (((s2[0] + s2[1]) + (s2[2] + s2[3])) + ((s3[0] + s3[1]) + (s3[2] + s3[3])));
                const float rp = 1.0f / sqrtf(q * (1.0f / DM) + EPS); const size_t off = (size_t)row * DM + col0;
#pragma unroll
                for (int bj = 0; bj < 2; ++bj)
#pragma unroll
                    for (int n = 0; n < 2; ++n) { const f32x4 xv = *(const f32x4*)(out + off + bj * 128 + n * 16); const u32x2 pw = *(const u32x2*)(praw + off + bj * 128 + n * 16);
                        const f32x4 pv = (f32x4){bflo(pw.x), bfhi(pw.x), bflo(pw.y), bfhi(pw.y)}; f32x4 o;
#pragma unroll
                        for (int i = 0; i < 4; ++i) { const float z = acc[ai][bj][m][n][i] * rs; const float sg = 1.0f / (1.0f + __builtin_amdgcn_exp2f(-z * LOG2E)); o[i] = xv[i] + sg * (pv[i] * rp * gv[bj][n][i]); }
                        *(f32x4*)(out + off + bj * 128 + n * 16) = o; } }
    }
};

__device__ __forceinline__ void load_row64(const bf16_t* p, float (&q)[64]) {
#pragma unroll
    for (int c = 0; c < 8; ++c) { const u32x4 w = *(const u32x4*)(p + 8 * c);
        q[8 * c + 0] = bflo(w.x); q[8 * c + 1] = bfhi(w.x); q[8 * c + 2] = bflo(w.y); q[8 * c + 3] = bfhi(w.y); q[8 * c + 4] = bflo(w.z); q[8 * c + 5] = bfhi(w.z); q[8 * c + 6] = bflo(w.w); q[8 * c + 7] = bfhi(w.w); }
}
__device__ __forceinline__ float dot_row64(const bf16_t* p, const float (&q)[64]) {
    float s0 = 0.f, s1 = 0.f;
#pragma unroll
    for (int c = 0; c < 8; ++c) { const u32x4 w = *(const u32x4*)(p + 8 * c);
        s0 += q[8 * c + 0] * bflo(w.x) + q[8 * c + 2] * bflo(w.y) + q[8 * c + 4] * bflo(w.z) + q[8 * c + 6] * bflo(w.w);
        s1 += q[8 * c + 1] * bfhi(w.x) + q[8 * c + 3] * bfhi(w.y) + q[8 * c + 5] * bfhi(w.z) + q[8 * c + 7] * bfhi(w.w); }
    return s0 + s1;
}
__device__ __forceinline__ void p2_attention_naive(Frame& F) {
    const bf16_t* qkv = (const bf16_t*)(F.ws + WS_QKV); bf16_t* O = (bf16_t*)(F.ws + WS_O); float* ssq = (float*)(F.ws + WS_SSQ);
    const float* tab = (const float*)(F.ws + WS_BIAS); const float* kmp = (const float*)(F.ws + WS_KMP);
    const int gw = F.vcu * NWAVES + F.wave, NGW = F.G * NWAVES, lane = F.lane;
    for (int pair = gw; pair < T * NHQ; pair += NGW) {
        const int t = pair >> 4, hh = pair & 15, b = t >> 11, s = t & 2047;
        float q[64]; float o = 0.f, l = 0.f;
        if (hh < 8) {
            const int g = hh >> 2; load_row64(qkv + (size_t)t * INW + C_QA + 64 * hh, q);
            const float sink = F.in[I_SINKS][hh] * LOG2E; float sc[2];
#pragma unroll
            for (int i = 0; i < 2; ++i) { const int j = lane + 64 * i, kpos = s - j; sc[i] = -1e30f;
                if (kpos >= 0) sc[i] = dot_row64(qkv + (size_t)(b * SEQ + kpos) * INW + C_KA + 64 * g, q) + tab[hh * 132 + j]; }
            const float m = fmaxf(wave_max(fmaxf(sc[0], sc[1])), sink);
            float e[2];
#pragma unroll
            for (int i = 0; i < 2; ++i) e[i] = (sc[i] > -1e29f) ? __builtin_amdgcn_exp2f(sc[i] - m) : 0.f;
            l = wave_sum(e[0] + e[1]) + __builtin_amdgcn_exp2f(sink - m);
#pragma unroll
            for (int i = 0; i < 2; ++i)
                for (int jj = 0; jj < 64; ++jj) { const float pj = __shfl(e[i], jj); const int kpos = s - (jj + 64 * i);
                    if (kpos >= 0) o += pj * bf2f(qkv[(size_t)(b * SEQ + kpos) * INW + C_VA + 64 * g + lane]); }
        } else {
            const int hm = hh - 8, g = hm >> 2, ob = s >> 8; load_row64(qkv + (size_t)t * INW + C_QB + 64 * hm, q);
            const float qd = bf2f(qkv[(size_t)t * INW + C_QB + 64 * hm + lane]);
            float gate[8];
#pragma unroll
            for (int n = 0; n < 8; ++n) { gate[n] = -3e38f;
                if (n < ob) { const int pm = b * 8 + n; const float km = kmp[((pm * 2 + 0) * 2 + g) * 64 + lane] + kmp[((pm * 2 + 1) * 2 + g) * 64 + lane]; gate[n] = wave_sum(qd * km); } }
            unsigned sel = 0u; const int nsel = ob < 3 ? ob : 3;
            for (int k = 0; k < nsel; ++k) { float best = -3e38f; int bi = 0;
#pragma unroll
                for (int n = 0; n < 8; ++n) { const bool ok = (n < ob) && !((sel >> n) & 1u) && (gate[n] > best); if (ok) { best = gate[n]; bi = n; } }
                sel |= 1u << bi; }
            float m = -1e30f;
            for (int n = 0; n <= ob; ++n) {
                if (n < ob && !((sel >> n) & 1u)) continue;
                float sc[4]; float mx = -1e30f;
#pragma unroll
                for (int i = 0; i < 4; ++i) { const int kpos = n * 256 + 64 * i + lane; sc[i] = -1e30f;
                    if (kpos <= s) { const int dist = s - kpos; sc[i] = dot_row64(qkv + (size_t)(b * SEQ + kpos) * INW + C_KB + 64 * g, q) + tab[hh * 132 + (dist < 128 ? dist : 128)]; }
                    mx = fmaxf(mx, sc[i]); }
                const float mn = fmaxf(m, wave_max(mx)); const float f = __builtin_amdgcn_exp2f(m - mn); o *= f; l *= f; m = mn;
                float e[4]; float es = 0.f;
#pragma unroll
                for (int i = 0; i < 4; ++i) { e[i] = (sc[i] > -1e29f) ? __builtin_amdgcn_exp2f(sc[i] - m) : 0.f; es += e[i]; }
                l += wave_sum(es);
#pragma unroll
                for (int i = 0; i < 4; ++i)
                    for (int jj = 0; jj < 64; ++jj) { const float pj = __shfl(e[i], jj); const int kpos = n * 256 + 64 * i + jj;
                        o += pj * bf2f(qkv[(size_t)(b * SEQ + kpos) * INW + C_VB + 64 * g + lane]); }
            }
        }
        o = o / l;
        const float q2 = wave_sum(o * o);
        O[(size_t)t * DM + 64 * hh + lane] = (bf16_t)f2bf(o);
        if (lane == 0) ssq[(size_t)t * 16 + hh] = q2;
    }
}

__device__ __forceinline__ void p4_router(Frame& F) {
    const float* x1 = F.out; float* r2 = (float*)(F.ws + WS_R2); const float* Wr = (const float*)(F.ws + WS_WR);
    LAS float* wl = (LAS float*)F.lds;
    LAS int* lcnt = (LAS int*)(F.lds + MISC_OFF);
    LAS int* trec = (LAS int*)(F.lds + MISC_OFF + 512);
    unsigned* cnt = (unsigned*)(F.ctl + CW_CNT); unsigned* list = (unsigned*)(F.ws + WS_LIST); int* tok = (int*)(F.ws + WS_TOK);
    for (int i = F.tid; i < 36 * DM / 4; i += NTHREADS) ((LAS f32x4*)wl)[i] = ((const f32x4*)Wr)[i];
    if (F.tid < 64) lcnt[F.tid] = 0;
    __syncthreads();
    const int per = T / F.G;
    const int t0 = F.vcu * per;
    const float bg0 = F.in[I_B_RG][0], bg1 = F.in[I_B_RG][1], bg2 = F.in[I_B_RG][2], bg3 = F.in[I_B_RG][3];
    for (int lt = F.wave; lt < per; lt += NWAVES) {
        const int t = t0 + lt;
        const GAS f32x4* xr = (const GAS f32x4*)(x1 + (size_t)t * DM) + F.lane; f32x4 v[4]; float s = 0.f;
#pragma unroll
        for (int j = 0; j < 4; ++j) { v[j] = xr[64 * j]; s += (v[j].x * v[j].x + v[j].y * v[j].y) + (v[j].z * v[j].z + v[j].w * v[j].w); }
        const float rs = 1.0f / sqrtf(wave_sum(s) * (1.0f / DM) + EPS);
        float lg[36];
#pragma unroll
        for (int o = 0; o < 36; ++o) { float a = 0.f;
#pragma unroll
            for (int j = 0; j < 4; ++j) { const f32x4 w = *(const LAS f32x4*)(wl + o * DM + 256 * j + 4 * F.lane); a += (v[j].x * w.x + v[j].y * w.y) + (v[j].z * w.z + v[j].w * w.w); }
            lg[o] = wave_sum(a) * rs; }
        lg[0] += bg0; lg[1] += bg1; lg[2] += bg2; lg[3] += bg3;
        int gsel = 0; float gm = lg[0];
#pragma unroll
        for (int o = 1; o < 4; ++o) if (lg[o] > gm) { gm = lg[o]; gsel = o; }
        float den = 0.f;
#pragma unroll
        for (int o = 0; o < 4; ++o) den += __expf(lg[o] - gm);
        const float gwt = 1.0f / den;
        float el[8];
#pragma unroll
        for (int j = 0; j < 8; ++j) { float a = lg[4 + j];
#pragma unroll
            for (int gq = 1; gq < 4; ++gq) a = (gsel == gq) ? lg[4 + 8 * gq + j] : a;
            el[j] = a + F.in[I_B_RE][gsel * 8 + j]; }
        int i0 = 0; float v0 = el[0];
#pragma unroll
        for (int j = 1; j < 8; ++j) if (el[j] > v0) { v0 = el[j]; i0 = j; }
        int i1 = -1; float v1 = -3e38f;
#pragma unroll
        for (int j = 0; j < 8; ++j) if (j != i0 && el[j] > v1) { v1 = el[j]; i1 = j; }
        const float e1 = __expf(v1 - v0); const float w0 = gwt / (1.0f + e1), w1 = gwt * e1 / (1.0f + e1);
        if (F.lane == 0) {
            const int e0 = gsel * 8 + i0, e1i = gsel * 8 + i1;
            const int lr0 = __hip_atomic_fetch_add(&lcnt[e0], 1, __ATOMIC_RELAXED, __HIP_MEMORY_SCOPE_WORKGROUP);
            const int lr1 = __hip_atomic_fetch_add(&lcnt[e1i], 1, __ATOMIC_RELAXED, __HIP_MEMORY_SCOPE_WORKGROUP);
            trec[lt * 8 + 0] = e0; trec[lt * 8 + 1] = e1i; trec[lt * 8 + 2] = lr0; trec[lt * 8 + 3] = lr1;
            trec[lt * 8 + 4] = __builtin_bit_cast(int, w0); trec[lt * 8 + 5] = __builtin_bit_cast(int, w1);
            r2[t] = rs;
        }
    }
    __syncthreads();
    if (F.tid < 32) { const int c = lcnt[F.tid]; int base = 0; if (c > 0) base = (int)__hip_atomic_fetch_add(&cnt[F.tid], (unsigned)c, __ATOMIC_RELAXED, __HIP_MEMORY_SCOPE_AGENT); lcnt[32 + F.tid] = base; }
    __syncthreads();
    for (int lt = F.tid; lt < per; lt += NTHREADS) {
        const int t = t0 + lt; const int e0 = trec[lt * 8 + 0], e1 = trec[lt * 8 + 1];
        const int rk0 = lcnt[32 + e0] + trec[lt * 8 + 2], rk1 = lcnt[32 + e1] + trec[lt * 8 + 3];
        list[e0 * 16384 + rk0] = (unsigned)(t * 2); list[e1 * 16384 + rk1] = (unsigned)(t * 2 + 1);
        int* tr = tok + (size_t)t * 8; tr[0] = e0; tr[1] = e1; tr[2] = rk0; tr[3] = rk1; tr[4] = trec[lt * 8 + 4]; tr[5] = trec[lt * 8 + 5];
    }
    __syncthreads();
}

__device__ __forceinline__ void build_tile_table(Frame& F, LAS int* tb) {
    if (F.tid == 0) { const unsigned* cnt = (const unsigned*)(F.ctl + CW_CNT); int acc = 0;
        for (int e = 0; e < NEXP; ++e) { tb[e] = acc; acc += (int)((__hip_atomic_load(&cnt[e], __ATOMIC_RELAXED, __HIP_MEMORY_SCOPE_AGENT) + 255u) >> 8); } tb[NEXP] = acc; }
    __syncthreads();
}

__device__ __forceinline__ void p7_combine(Frame& F) {
    float* x = F.out; const bf16_t* Y = (const bf16_t*)(F.ws + WS_Y); bf16_t* x2b = (bf16_t*)(F.ws + WS_QKV); float* r3 = (float*)(F.ws + WS_R3); const int* tok = (const int*)(F.ws + WS_TOK);
    const int gw = F.vcu * NWAVES + F.wave, NGW = F.G * NWAVES;
    for (int t = gw; t < T; t += NGW) {
        const float w0 = __builtin_bit_cast(float, tok[(size_t)t * 8 + 4]), w1 = __builtin_bit_cast(float, tok[(size_t)t * 8 + 5]);
        GAS f32x4* xr = (GAS f32x4*)(x + (size_t)t * DM) + F.lane;
        const GAS u32x2* y0 = (const GAS u32x2*)(Y + (size_t)(2 * t) * DM) + F.lane; const GAS u32x2* y1 = (const GAS u32x2*)(Y + (size_t)(2 * t + 1) * DM) + F.lane;
        GAS u32x2* ob = (GAS u32x2*)(x2b + (size_t)t * DM) + F.lane; float s = 0.f;
#pragma unroll
        for (int j = 0; j < 4; ++j) { f32x4 v = xr[64 * j]; const u32x2 a = y0[64 * j], b = y1[64 * j];
            v.x += w0 * bflo(a.x) + w1 * bflo(b.x); v.y += w0 * bfhi(a.x) + w1 * bfhi(b.x); v.z += w0 * bflo(a.y) + w1 * bflo(b.y); v.w += w0 * bfhi(a.y) + w1 * bfhi(b.y);
            xr[64 * j] = v; u32x2 w; w.x = pk2(v.x, v.y); w.y = pk2(v.z, v.w); ob[64 * j] = w; s += (v.x * v.x + v.y * v.y) + (v.z * v.z + v.w * v.w); }
        s = wave_sum(s);
        if (F.lane == 0) r3[t] = 1.0f / sqrtf(s * (1.0f / DM) + EPS);
    }
}

__global__ void __launch_bounds__(NTHREADS, 2) hymba_fwd(Args args) {
    extern __shared__ __attribute__((aligned(16))) unsigned char lds[];
    Frame F;
    F.lds = (LAS unsigned char*)lds; F.ws = args.ws; F.ctl = (GAS unsigned*)(args.ws + WS_CTL);
    F.tid = threadIdx.x; F.lane = F.tid & 63; F.wave = __builtin_amdgcn_readfirstlane(F.tid >> 6);
    F.G = gridDim.x; { const int bx = blockIdx.x; F.vcu = (F.G % 8 == 0) ? (bx % 8) * (F.G / 8) + bx / 8 : bx; }
#pragma unroll
    for (int i = 0; i < 25; ++i) F.in[i] = args.in[i];
    F.out = args.out;
    const int lo = args.ph_lo, hi = args.ph_hi;
#ifdef ONLY_PHASE
#define IN(k) ((k) == ONLY_PHASE && lo <= (k) && (k) < hi)
#else
#define IN(k) (lo <= (k) && (k) < hi)
#endif
    unsigned char* ws = args.ws;
    LAS int* tb = (LAS int*)(F.lds + MISC_OFF + 8192);

    if (IN(0)) { p0_prologue(F); }
    if (IN(1)) {
        { pg8::DenseOrder S{(const char*)(ws + WS_XB), (const char*)(ws + WS_WIN), T / 256, INW / 256, DM, F.G, (int)blockIdx.x};
          EpiQKV E{(bf16_t*)(ws + WS_QKV), (const float*)(ws + WS_RS1), F.in[I_SWA_QN], F.in[I_SWA_KN], F.in[I_MOBA_QN], F.in[I_MOBA_KN], (float*)(ws + WS_KMP)};
          pg8::gemm_phase<EpiQKV, pg8::DenseOrder, true, false, false>(F.lds, DM, S, E); }
        { pg8::DenseOrder S{(const char*)(ws + WS_PB), (const char*)(ws + WS_WPP), T / 256, DM / 256, PLE, F.G, (int)(F.G - 1 - blockIdx.x)};
          EpiProj E{(bf16_t*)(ws + WS_PRAW), (float*)(ws + WS_SSQP)};
          pg8::gemm_phase<EpiProj, pg8::DenseOrder, true, false, false>(F.lds, PLE, S, E); }
    }
    if (IN(2)) { p2_attention_naive(F); }
    if (IN(3)) {
        pg8::DenseOrder S{(const char*)(ws + WS_O), (const char*)(ws + WS_WOUT), T / 256, DM / 256, DM, F.G, (int)blockIdx.x};
        EpiOut E{F.in[I_X], F.out, (bf16_t*)(ws + WS_XB), (const float*)(ws + WS_SSQ)};
        pg8::gemm_phase<EpiOut, pg8::DenseOrder, false, false, true>(F.lds, DM, S, E);
    }
    if (IN(4)) { p4_router(F); }
    if (IN(5)) {
        build_tile_table(F, tb);
        MoeOrder S{(const char*)(ws + WS_XB), (const char*)(ws + WS_WGU), tb, (const unsigned*)(F.ctl + CW_CNT), (const unsigned*)(ws + WS_LIST), DM, (size_t)DM * DM * 2, (size_t)DM * 2, F.G, (int)blockIdx.x, true};
        EpiG1 E{(bf16_t*)(ws + WS_QKV), (const float*)(ws + WS_R2), (const unsigned*)(ws + WS_LIST)};
        pg8::gemm_phase<EpiG1, MoeOrder, true, true, false>(F.lds, DM, S, E);
    }
    if (IN(6)) {
        build_tile_table(F, tb);
        MoeOrder S{(const char*)(ws + WS_QKV), (const char*)(ws + WS_WD), tb, (const unsigned*)(F.ctl + CW_CNT), (const unsigned*)(ws + WS_LIST), DEXP, (size_t)DM * DEXP * 2, (size_t)DEXP * 2, F.G, (int)blockIdx.x, false};
        EpiG2 E{(bf16_t*)(ws + WS_Y), (const unsigned*)(ws + WS_LIST)};
        pg8::gemm_phase<EpiG2, MoeOrder, true, false, false>(F.lds, DEXP, S, E);
    }
    if (IN(7)) { p7_combine(F); }
    if (IN(8)) {
        pg8::DenseOrder S{(const char*)(ws + WS_QKV), (const char*)(ws + WS_WPG), T / 256, DM / 256, DM, F.G, (int)blockIdx.x};
        EpiFinal E{F.out, (const float*)(ws + WS_R3), (const bf16_t*)(ws + WS_PRAW), (const float*)(ws + WS_SSQP), F.in[I_PLE_ON]};
        pg8::gemm_phase<EpiFinal, pg8::DenseOrder, false, false, false>(F.lds, DM, S, E);
    }
#undef IN
}

extern "C" void kernel_launch(void* const* d_in, const int* in_sizes, int n_in, void* d_out, int out_size, void* d_ws, size_t ws_size, hipStream_t stream) {
    static int grid = 0;
    if (grid == 0) {
        if (n_in != 25 || in_sizes[0] != T * DM || out_size != T * DM || ws_size < WS_END) { fprintf(stderr, "kernel_launch: unexpected shapes (n_in %d, in0 %d, out %d, ws %zu)\n", n_in, n_in > 0 ? in_sizes[0] : -1, out_size, ws_size); grid = -1; return; }
        int dev = 0, cus = 0, per_cu = 0;
        if (hipGetDevice(&dev) != hipSuccess || hipDeviceGetAttribute(&cus, hipDeviceAttributeMultiprocessorCount, dev) != hipSuccess) { grid = -1; return; }
        if (hipFuncSetAttribute((const void*)hymba_fwd, hipFuncAttributeMaxDynamicSharedMemorySize, LDS_BYTES) != hipSuccess) { fprintf(stderr, "kernel_launch: hipFuncSetAttribute failed\n"); grid = -1; return; }
        if (hipOccupancyMaxActiveBlocksPerMultiprocessor(&per_cu, (const void*)hymba_fwd, NTHREADS, LDS_BYTES) != hipSuccess || per_cu < 1) { fprintf(stderr, "kernel_launch: occupancy query says %d\n", per_cu); per_cu = 1; }
        (void)hipGetLastError();
        grid = cus;
        if (grid != 256) fprintf(stderr, "kernel_launch: %d CUs (built for 256)\n", grid);
    }
    if (grid < 0) return;
    (void)hipMemsetAsync((char*)d_ws + WS_CTL, 0, CTL_ZERO_BYTES, stream);
    Args a{};
    for (int i = 0; i < 25; ++i) a.in[i] = (const float*)d_in[i];
    a.out = (float*)d_out; a.ws = (unsigned char*)d_ws;
    constexpr int NPH = 9;
    for (int li = 0; li < MK_N_LAUNCHES; ++li) {
        a.ph_lo = (MK_N_LAUNCHES == NPH) ? li : 0; a.ph_hi = (MK_N_LAUNCHES == NPH) ? li + 1 : NPH; a.li = li;
        hipLaunchKernelGGL(hymba_fwd, dim3(grid), dim3(NTHREADS), LDS_BYTES, stream, a);
    }
}
```

```cpp
#include <hip/hip_runtime.h>
#include <cstdio>
#include <cstdint>

#ifndef MK_N_LAUNCHES
#define MK_N_LAUNCHES 1
#endif

#ifndef REPEAT_MASK
#define REPEAT_MASK 0
#endif
#define LAS __attribute__((address_space(3)))
#define GAS __attribute__((address_space(1)))
typedef unsigned short bf16_t;
typedef short bf16x8 __attribute__((ext_vector_type(8)));
typedef float f32x4 __attribute__((ext_vector_type(4)));
typedef float f32x2 __attribute__((ext_vector_type(2)));
typedef unsigned u32x4 __attribute__((ext_vector_type(4)));
typedef unsigned u32x2 __attribute__((ext_vector_type(2)));

constexpr int BATCH = 8, SEQ = 2048, DM = 1024, T = BATCH * SEQ;
constexpr int INW = 1536, NHQ = 16, HD = 64;
constexpr int NEXP = 32, DEXP = 512, PLE = 256;
constexpr int MAXTILES = 160;
constexpr float EPS = 1e-6f;
constexpr float LOG2E = 1.4426950408889634f;
constexpr float QSCALE = 0.125f * LOG2E;
constexpr int NWAVES = 8, NTHREADS = 512;

constexpr int C_QA = 0, C_KA = 512, C_VA = 640, C_QB = 768, C_KB = 1280, C_VB = 1408;

constexpr size_t KiB = 1024, MiB = 1u << 20;
constexpr size_t WS_CTL = 0, CTL_ZERO_BYTES = 1 * MiB;
constexpr size_t WS_RS1 = 1 * MiB, WS_R2 = WS_RS1 + 64 * KiB, WS_R3 = WS_R2 + 64 * KiB, WS_KMP = WS_R3 + 64 * KiB;
constexpr size_t WS_WR = WS_KMP + 64 * KiB;
constexpr size_t WS_BIAS = WS_WR + 192 * KiB;
constexpr size_t WS_TOK = 1 * MiB + 512 * KiB;
constexpr size_t WS_SSQ = 2 * MiB;
constexpr size_t WS_SSQP = 3 * MiB;
constexpr size_t WS_LIST = 4 * MiB;
constexpr size_t WS_WIN = 8 * MiB, WS_WOUT = 11 * MiB, WS_WPG = 13 * MiB, WS_WPP = 15 * MiB;
constexpr size_t WS_WGU = 16 * MiB;
constexpr size_t WS_WD = 80 * MiB;
constexpr size_t WS_PRAW = 112 * MiB;
constexpr size_t WS_X1B = 144 * MiB;
constexpr size_t WS_X2B = WS_X1B;
constexpr size_t WS_H = 176 * MiB;
constexpr size_t WS_Y = 216 * MiB;
constexpr size_t WS_QKV = 176 * MiB;
constexpr size_t WS_O = 224 * MiB;
constexpr size_t WS_PB = 240 * MiB;
constexpr size_t WS_XB = WS_X1B;
constexpr size_t WS_END = 280 * MiB;
constexpr int CW_CNT = 64;
constexpr int CW_BAR = 4096;

constexpr int RING_BYTES = 131072;
constexpr int MISC_OFF = 147456;
constexpr int LDS_BYTES = 163840;

__device__ __forceinline__ unsigned f2bf(float f) { unsigned u = __builtin_bit_cast(unsigned, f); return (u + 0x7fffu + ((u >> 16) & 1u)) >> 16; }
__device__ __forceinline__ unsigned pk2(float lo, float hi) { return f2bf(lo) | (f2bf(hi) << 16); }
__device__ __forceinline__ float bf2f(unsigned short h) { return __builtin_bit_cast(float, (unsigned)h << 16); }
__device__ __forceinline__ float bflo(unsigned w) { return __builtin_bit_cast(float, w << 16); }
__device__ __forceinline__ float bfhi(unsigned w) { return __builtin_bit_cast(float, w & 0xffff0000u); }
__device__ __forceinline__ float wave_sum(float v) {
#pragma unroll
    for (int o = 1; o < 64; o <<= 1) v += __shfl_xor(v, o);
    return v;
}
__device__ __forceinline__ float wave_max(float v) {
#pragma unroll
    for (int o = 1; o < 64; o <<= 1) v = fmaxf(v, __shfl_xor(v, o));
    return v;
}
#define LDS_WAIT() asm volatile("s_waitcnt lgkmcnt(0)" ::: "memory")
#define VM_WAIT() asm volatile("s_waitcnt vmcnt(0)" ::: "memory")

namespace pg8 {
constexpr int BM = 256, BK = 64, HALF = 128, HTB = HALF * BK * 2, STAGE_BYTES = 8 * HTB, NXCD = 8, WGM = 8;
__host__ __device__ __forceinline__ int lds_byte(int r, int c) { const int st = (r >> 4) * 2 + (c >> 5), rr = r & 15, cc = c & 31, ob = rr * 64 + cc * 2; return st * 1024 + (ob ^ (((ob >> 9) & 1) << 5)); }
__host__ __device__ __forceinline__ void stage_rc(int b, int& R, int& C) { const int st = b / 1024, sb = b % 1024, swz = sb ^ (((sb >> 9) & 1) << 5); R = (st >> 1) * 16 + swz / 64; C = (st & 1) * 32 + (swz % 64) / 2; }
__host__ __device__ __forceinline__ int perm32(int rho) { const int n = rho >> 4, i = rho & 15; return 8 * (i >> 2) + 4 * n + (i & 3); }

struct Unit { const char* A; const char* B; int pm, pn, e, nvalid; };

__device__ __forceinline__ bool static_tile(int i, int G, int c, int nM, int nN, int& pm, int& pn) {
    const int nwg = nM * nN; const long L = (long)i * G + c; if (L >= nwg) return false;
    int wgid = (int)L; { const int q = nwg / NXCD, r = nwg % NXCD, xcd = wgid % NXCD, off = wgid / NXCD; wgid = (xcd < r ? xcd * (q + 1) : r * (q + 1) + (xcd - r) * q) + off; }
    const int nig = WGM * nN, gid = wgid / nig, fm = gid * WGM, gsz = (nM - fm) < WGM ? (nM - fm) : WGM;
    pm = fm + ((wgid % nig) % gsz); pn = (wgid % nig) / gsz; return true;
}
struct DenseOrder {
    const char* A; const char* Bt; int nM, nN, K, G, c;
    __device__ __forceinline__ bool next(int i, Unit& u) const {
        int pm, pn; if (!static_tile(i, G, c, nM, nN, pm, pn)) return false;
        u.pm = pm; u.pn = pn; u.e = 0; u.nvalid = 256; u.A = A + (size_t)pm * 256 * K * 2; u.B = Bt + (size_t)pn * 256 * K * 2; return true;
    }
    __device__ __forceinline__ unsigned row_off(const Unit&, int) const { return 0u; }
};

__device__ __forceinline__ unsigned cvt_pk_bf16(float lo, float hi) { unsigned r; asm volatile("v_cvt_pk_bf16_f32 %0, %1, %2" : "=v"(r) : "v"(lo), "v"(hi)); return r; }

template <class Epi, class Sched, bool ALIGN_EPI, bool GATHER, bool MID>
__device__ __forceinline__ void gemm_phase(LAS unsigned char* lds, const int K, const Sched& S, const Epi& E) {
    int tid_ = threadIdx.x; asm volatile("" : "+v"(tid_));
    const int tid = tid_, wid = __builtin_amdgcn_readfirstlane(tid >> 6), lane = tid & 63, wr = wid >> 2, wc = wid & 3, fr = lane & 15, fq = lane >> 4;
    const int nt = K / BK;
    int Rst[2], Cst[2]; unsigned voffB[2];
#pragma unroll
    for (int i = 0; i < 2; ++i) { int R, C; stage_rc(tid * 16 + i * 8192, R, C); Rst[i] = R; Cst[i] = C; const int Rb = Epi::PERM ? ((R & ~31) + perm32(R & 31)) : R; voffB[i] = (unsigned)(Rb * K + C) * 2u; }
    const size_t kstep = (size_t)(BK * 2);
    const size_t hstep = (size_t)HALF * K * 2;
    const unsigned ldsw = (unsigned)wid * 1024u;
    const int aoff = lds_byte(wr * 64 + fr, fq * 8), boff = lds_byte(wc * 32 + fr, fq * 8);
#define PG8_SA(b, h) (((b) * 2 + (h)) * HTB)
#define PG8_SB(b, h) ((4 + (b) * 2 + (h)) * HTB)
#define PG8_STAGE(bufoff, gbase, voff) do { _Pragma("unroll") for (int _i = 0; _i < 2; ++_i) \
        __builtin_amdgcn_global_load_lds((const unsigned*)((const char*)(gbase) + (voff)[_i]), (LAS unsigned*)(lds + (bufoff) + ldsw + _i * 8192), 16, 0, 0); } while (0)
#define PG8_LDA(dst, b, h) do { _Pragma("unroll") for (int m = 0; m < 4; ++m) _Pragma("unroll") for (int k = 0; k < 2; ++k) dst[m][k] = *(const LAS bf16x8*)(lds + PG8_SA(b, h) + aoff + m * 2048 + k * 1024); } while (0)
#define PG8_LDB(dst, b, h) do { _Pragma("unroll") for (int n = 0; n < 2; ++n) _Pragma("unroll") for (int k = 0; k < 2; ++k) dst[n][k] = *(const LAS bf16x8*)(lds + PG8_SB(b, h) + boff + n * 2048 + k * 1024); } while (0)
#define PG8_MMA(ai, bj, At, Bt) do { __builtin_amdgcn_s_setprio(1); _Pragma("unroll") for (int m = 0; m < 4; ++m) _Pragma("unroll") for (int n = 0; n < 2; ++n) _Pragma("unroll") for (int k = 0; k < 2; ++k) \
        acc[ai][bj][m][n] = __builtin_amdgcn_mfma_f32_16x16x32_bf16(Bt[n][k], At[m][k], acc[ai][bj][m][n], 0, 0, 0); __builtin_amdgcn_s_setprio(0); } while (0)
#define PG8_WAIT_V(n) asm volatile("s_waitcnt vmcnt(" #n ")" ::: "memory")
#define PG8_WAIT_L(n) asm volatile("s_waitcnt lgkmcnt(" #n ")" ::: "memory")
#define PG8_BAR __builtin_amdgcn_s_barrier()
#define PG8_SCHED __builtin_amdgcn_sched_barrier(0)
#define PG8_AOFFS(dst, u) do { _Pragma("unroll") for (int _h = 0; _h < 2; ++_h) _Pragma("unroll") for (int _i = 0; _i < 2; ++_i) { \
        if constexpr (GATHER) dst[_h][_i] = S.row_off(u, _h * HALF + Rst[_i]) + (unsigned)Cst[_i] * 2u; \
        else dst[_h][_i] = (unsigned)((_h * HALF + Rst[_i]) * K + Cst[_i]) * 2u; } \
        if constexpr (GATHER) { asm volatile("" : "+v"(dst[0][0]), "+v"(dst[0][1]), "+v"(dst[1][0]), "+v"(dst[1][1]) :: "memory"); } } while (0)
    Unit cur, nxt; int ui = 0;
    if (!S.next(0, cur)) return;
    bool has_next = S.next(1, nxt);
    unsigned vA[2][2], vN[2][2];
    PG8_AOFFS(vA, cur);
    if constexpr (GATHER) { if (has_next) { PG8_AOFFS(vN, nxt); } else {
#pragma unroll
        for (int h = 0; h < 2; ++h) { vN[h][0] = vA[h][0]; vN[h][1] = vA[h][1]; } } }
    f32x4 acc[2][2][4][2];
#pragma unroll
    for (int a = 0; a < 2; ++a)
#pragma unroll
        for (int b = 0; b < 2; ++b)
#pragma unroll
            for (int m = 0; m < 4; ++m)
#pragma unroll
                for (int n = 0; n < 2; ++n) acc[a][b][m][n] = (f32x4){0.f, 0.f, 0.f, 0.f};
    bf16x8 At[4][2], B0[2][2], B1[2][2];
    const char* cA = cur.A; const char* cB = cur.B;
    PG8_STAGE(PG8_SB(0, 0), cB, voffB); PG8_STAGE(PG8_SB(0, 1), cB + hstep, voffB); PG8_STAGE(PG8_SA(0, 0), cA, vA[0]); PG8_STAGE(PG8_SA(0, 1), cA, vA[1]);
    if (wr == 1) PG8_BAR;
    PG8_WAIT_V(2); PG8_BAR;
    PG8_STAGE(PG8_SB(1, 0), cB + kstep, voffB); PG8_STAGE(PG8_SA(1, 0), cA + kstep, vA[0]); PG8_STAGE(PG8_SB(1, 1), cB + hstep + kstep, voffB);
    PG8_WAIT_V(6); PG8_BAR;
    for (;;) {
        const char* nA = has_next ? nxt.A : cA; const char* nB = has_next ? nxt.B : cB;
#pragma unroll 1
        for (int t = 0; t < nt; t += 2) {
            const bool last = (t == nt - 2);
            if constexpr (MID) { if (t == nt / 2) { int frE = fr, fqE = fq; asm volatile("" : "+v"(frE), "+v"(fqE)); E.mid(acc, cur, wr, wc, frE, fqE); } }
            const char* a1 = cA + (size_t)(t + 1) * kstep;
            const char* a2 = last ? nA : cA + (size_t)(t + 2) * kstep; const char* b2 = last ? nB : cB + (size_t)(t + 2) * kstep;
            const char* a3 = a2 + kstep; const char* b3 = b2 + kstep;
            unsigned v2[2][2];
#pragma unroll
            for (int h = 0; h < 2; ++h) { if constexpr (GATHER) { v2[h][0] = last ? vN[h][0] : vA[h][0]; v2[h][1] = last ? vN[h][1] : vA[h][1]; } else { v2[h][0] = vA[h][0]; v2[h][1] = vA[h][1]; } }
            PG8_LDB(B0, 0, 0); PG8_LDB(B1, 0, 1); PG8_SCHED; PG8_LDA(At, 0, 0); PG8_STAGE(PG8_SA(1, 1), a1, vA[1]);
            PG8_WAIT_V(8); PG8_WAIT_L(0); PG8_BAR; PG8_MMA(0, 0, At, B0); PG8_MMA(0, 1, At, B1); PG8_BAR; PG8_SCHED;
            PG8_LDA(At, 0, 1); PG8_STAGE(PG8_SB(0, 0), b2, voffB); PG8_STAGE(PG8_SB(0, 1), b2 + hstep, voffB); PG8_STAGE(PG8_SA(0, 0), a2, v2[0]);
            PG8_WAIT_V(8); PG8_WAIT_L(0); PG8_BAR; PG8_MMA(1, 0, At, B0); PG8_MMA(1, 1, At, B1); PG8_BAR; PG8_SCHED;
            PG8_LDB(B0, 1, 0); PG8_LDB(B1, 1, 1); PG8_SCHED; PG8_LDA(At, 1, 0); PG8_STAGE(PG8_SA(0, 1), a2, v2[1]);
            PG8_WAIT_V(8); PG8_WAIT_L(0); PG8_BAR; PG8_MMA(0, 0, At, B0); PG8_MMA(0, 1, At, B1); PG8_BAR; PG8_SCHED;
            PG8_LDA(At, 1, 1); PG8_STAGE(PG8_SB(1, 0), b3, voffB); PG8_STAGE(PG8_SB(1, 1), b3 + hstep, voffB); PG8_STAGE(PG8_SA(1, 0), a3, v2[0]);
            PG8_WAIT_V(8); PG8_WAIT_L(0); PG8_BAR; PG8_MMA(1, 0, At, B0); PG8_MMA(1, 1, At, B1); PG8_BAR; PG8_SCHED;
        }
        if constexpr (ALIGN_EPI) { if (wr == 0) PG8_BAR; }
        { int frE = fr, fqE = fq; asm volatile("" : "+v"(frE), "+v"(fqE));
          E(acc, cur, wr, wc, frE, fqE); }
        if (!has_next) break;
#pragma unroll
        for (int a = 0; a < 2; ++a)
#pragma unroll
            for (int b = 0; b < 2; ++b)
#pragma unroll
                for (int m = 0; m < 4; ++m)
#pragma unroll
                    for (int n = 0; n < 2; ++n) acc[a][b][m][n] = (f32x4){0.f, 0.f, 0.f, 0.f};
        cur = nxt; cA = nA; cB = nB; ++ui;
        if constexpr (GATHER) {
#pragma unroll
            for (int h = 0; h < 2; ++h) { vA[h][0] = vN[h][0]; vA[h][1] = vN[h][1]; } }
        has_next = S.next(ui + 1, nxt);
        if constexpr (GATHER) { if (has_next) { PG8_AOFFS(vN, nxt); } }
        if constexpr (ALIGN_EPI) { if (wr == 1) PG8_BAR; }
    }
    PG8_WAIT_V(0);
    if constexpr (!ALIGN_EPI) { if (wr == 0) PG8_BAR; }
    PG8_BAR;
#undef PG8_SA
#undef PG8_SB
#undef PG8_STAGE
#undef PG8_LDA
#undef PG8_LDB
#undef PG8_MMA
#undef PG8_WAIT_V
#undef PG8_WAIT_L
#undef PG8_BAR
#undef PG8_SCHED
#undef PG8_AOFFS
}
}

struct Args { const float* in[25]; float* out; unsigned char* ws; int ph_lo, ph_hi, li, pad; };
struct Frame {
    LAS unsigned char* lds; unsigned char* ws; GAS unsigned* ctl;
    int tid, lane, wave, vcu, G;
    float* out; const __attribute__((address_space(4))) char* ka;
};
#define FIN(i) (((const float* const __attribute__((address_space(4)))*)F.ka)[i])
enum { I_X = 0, I_P, I_RELB, I_ATTN_NORM, I_W_IN, I_SWA_QN, I_SWA_KN, I_SINKS, I_MOBA_QN, I_MOBA_KN, I_SWA_ON, I_MOBA_ON, I_W_OUT, I_FFN_NORM,
       I_W_RG, I_B_RG, I_W_RE, I_B_RE, I_W_EG, I_W_EU, I_W_ED, I_PLE_NORM, I_W_PG, I_W_PP, I_PLE_ON };

struct TrItem { const float* src; bf16_t* dst; const float* gk; int N, K; };
__device__ __forceinline__ int map_in(int n0) { const int head = n0 >> 6, d = n0 & 63; return 256 * (head >> 2) + 128 * (d >> 5) + 32 * (head & 3) + (d & 31); }
__device__ __forceinline__ int map_gu(int n0, int up) { return 256 * (n0 >> 7) + 128 * up + (n0 & 127); }
constexpr int TI_IN = (DM / 64) * (INW / 32), TI_OUT = (DM / 64) * (DM / 32), TI_PG = TI_OUT, TI_PP = (PLE / 64) * (DM / 32);
constexpr int TI_G1 = (DM / 64) * (DEXP / 32), TI_D1 = (DEXP / 64) * (DM / 32);
constexpr int TI_TOTAL = TI_IN + TI_OUT + TI_PG + TI_PP + NEXP * (2 * TI_G1);
constexpr int TI_DOWN_BASE = 1 << 20, TI_DOWN = NEXP * TI_D1;
__device__ __forceinline__ void tr_decode(const Frame& F, int it, TrItem& d) {
    unsigned char* ws = F.ws;
    const float* W; bf16_t* WT; const float* g = nullptr; int K, N, mode = 0, up = 0; int r = it;
    if (it >= TI_DOWN_BASE) r = 1 << 28;
    if (r < TI_IN) { W = FIN(I_W_IN); WT = (bf16_t*)(ws + WS_WIN); K = DM; N = INW; g = FIN(I_ATTN_NORM); mode = 1; }
    else if ((r -= TI_IN) < TI_OUT) { W = FIN(I_W_OUT); WT = (bf16_t*)(ws + WS_WOUT); K = DM; N = DM; mode = 3; }
    else if ((r -= TI_OUT) < TI_PG) { W = FIN(I_W_PG); WT = (bf16_t*)(ws + WS_WPG); K = DM; N = DM; g = FIN(I_PLE_NORM); }
    else if ((r -= TI_PG) < TI_PP) { W = FIN(I_W_PP); WT = (bf16_t*)(ws + WS_WPP); K = PLE; N = DM; }
    else if (it >= TI_DOWN_BASE) { r = it - TI_DOWN_BASE; const int e = r / TI_D1; r -= e * TI_D1; W = FIN(I_W_ED) + (size_t)e * DEXP * DM; WT = (bf16_t*)(ws + WS_WD) + (size_t)e * DM * DEXP; K = DEXP; N = DM; }
    else { r -= TI_PP; const int e = r / (2 * TI_G1); r -= e * (2 * TI_G1);
        if (r < TI_G1) { W = FIN(I_W_EG) + (size_t)e * DM * DEXP; WT = (bf16_t*)(ws + WS_WGU) + (size_t)e * DM * DM; K = DM; N = DEXP; g = FIN(I_FFN_NORM); mode = 2; up = 0; }
        else { r -= TI_G1; W = FIN(I_W_EU) + (size_t)e * DM * DEXP; WT = (bf16_t*)(ws + WS_WGU) + (size_t)e * DM * DM; K = DM; N = DEXP; g = FIN(I_FFN_NORM); mode = 2; up = 1; } }
    const int nblk = N / 32, kb = r / nblk, nb = r % nblk, k0 = 64 * kb, n0 = 32 * nb;
    if (mode == 3) g = (k0 < 512) ? FIN(I_SWA_ON) : (FIN(I_MOBA_ON) - 512);
    const int drow0 = mode == 1 ? map_in(n0) : mode == 2 ? map_gu(n0, up) : n0;
    d.src = W + (size_t)k0 * N + n0; d.dst = WT + (size_t)drow0 * K + k0; d.gk = g ? g + k0 : nullptr; d.N = N; d.K = K;
}
__device__ __forceinline__ void tr_load(const TrItem& d, int lane, float (&v)[32], f32x4 (&gv)[2]) {
    const float* p = d.src + (size_t)(lane >> 5) * d.N + (lane & 31);
#pragma unroll
    for (int i = 0; i < 32; ++i) v[i] = p[(size_t)(2 * i) * d.N];
    const int c = lane & 7;
    if (d.gk) { gv[0] = *(const f32x4*)(d.gk + 8 * c); gv[1] = *(const f32x4*)(d.gk + 8 * c + 4); } else { gv[0] = (f32x4){1.f, 1.f, 1.f, 1.f}; gv[1] = gv[0]; }
}
__device__ __forceinline__ void tr_process(const TrItem& d, int lane, const float (&v)[32], const f32x4 (&gv)[2], LAS float* scr) {
#pragma unroll
    for (int i = 0; i < 32; ++i) scr[(2 * i + (lane >> 5)) * 33 + (lane & 31)] = v[i];
    LDS_WAIT(); asm volatile("" ::: "memory");
    const int c = lane & 7;
#pragma unroll
    for (int j = 0; j < 4; ++j) { const int n = (lane >> 3) + 8 * j; const LAS float* sp = scr + (8 * c) * 33 + n;
        u32x4 o; o.x = pk2(sp[0 * 33] * gv[0][0], sp[1 * 33] * gv[0][1]); o.y = pk2(sp[2 * 33] * gv[0][2], sp[3 * 33] * gv[0][3]); o.z = pk2(sp[4 * 33] * gv[1][0], sp[5 * 33] * gv[1][1]); o.w = pk2(sp[6 * 33] * gv[1][2], sp[7 * 33] * gv[1][3]);
        *(GAS u32x4*)(d.dst + (size_t)n * d.K + 8 * c) = o; }
    LDS_WAIT(); asm volatile("" ::: "memory");
}

__constant__ unsigned char c_bucket[128] = {0,1,2,3,4,5,6,7,8,9,10,11,12,13,14,15,16,16,16,17,17,18,18,18,19,19,19,20,20,20,20,21,21,21,21,22,22,22,22,22,23,23,23,23,23,23,24,24,24,24,24,24,25,25,25,25,25,25,25,26,26,26,26,26,26,26,26,27,27,27,27,27,27,27,27,27,27,28,28,28,28,28,28,28,28,28,28,29,29,29,29,29,29,29,29,29,29,29,29,30,30,30,30,30,30,30,30,30,30,30,30,30,30,31,31,31,31,31,31,31,31,31,31,31,31,31,31,31};

__device__ __forceinline__ void tr_stream(Frame& F, LAS float* scr, int first, int step, int count, int base) {
    TrItem cur, nxt; float v[32], vn[32]; f32x4 gv[2], gn[2];
    int it = first; bool have = it < count;
    if (have) { tr_decode(F, base + it, cur); tr_load(cur, F.lane, v, gv); }
    while (have) {
        const int itn = it + step; const bool hn = itn < count;
        if (hn) { tr_decode(F, base + itn, nxt); tr_load(nxt, F.lane, vn, gn); }
        tr_process(cur, F.lane, v, gv, scr);
        cur = nxt; gv[0] = gn[0]; gv[1] = gn[1];
#pragma unroll
        for (int i = 0; i < 32; ++i) v[i] = vn[i];
        it = itn; have = hn;
    }
}
__device__ __forceinline__ void p0_prologue(Frame& F) {
    LAS float* scr = (LAS float*)(F.lds + F.wave * 16384);
    const int gw = F.vcu * NWAVES + F.wave, NGW = F.G * NWAVES;
    tr_stream(F, scr, gw, NGW, TI_TOTAL, 0);
    const float* x = FIN(I_X); bf16_t* xb = (bf16_t*)(F.ws + WS_XB); float* rs1 = (float*)(F.ws + WS_RS1);
    for (int m = gw; m < T; m += 2 * NGW) {
        const int m2 = m + NGW; const bool h2 = m2 < T;
        const GAS f32x4* xr = (const GAS f32x4*)(x + (size_t)m * DM) + F.lane; const GAS f32x4* xr2 = (const GAS f32x4*)(x + (size_t)(h2 ? m2 : m) * DM) + F.lane;
        f32x4 v[4], u[4]; float s = 0.f, s2 = 0.f;
#pragma unroll
        for (int j = 0; j < 4; ++j) { v[j] = xr[64 * j]; u[j] = xr2[64 * j]; }
#pragma unroll
        for (int j = 0; j < 4; ++j) { s += (v[j].x * v[j].x + v[j].y * v[j].y) + (v[j].z * v[j].z + v[j].w * v[j].w); s2 += (u[j].x * u[j].x + u[j].y * u[j].y) + (u[j].z * u[j].z + u[j].w * u[j].w); }
        s = wave_sum(s); s2 = wave_sum(s2);
        GAS u32x2* o8 = (GAS u32x2*)(xb + (size_t)m * DM) + F.lane;
#pragma unroll
        for (int j = 0; j < 4; ++j) { u32x2 w; w.x = pk2(v[j].x, v[j].y); w.y = pk2(v[j].z, v[j].w); o8[64 * j] = w; }
        if (F.lane == 0) rs1[m] = 1.0f / sqrtf(s * (1.0f / DM) + EPS);
        if (h2) { GAS u32x2* o9 = (GAS u32x2*)(xb + (size_t)m2 * DM) + F.lane;
#pragma unroll
            for (int j = 0; j < 4; ++j) { u32x2 w; w.x = pk2(u[j].x, u[j].y); w.y = pk2(u[j].z, u[j].w); o9[64 * j] = w; }
            if (F.lane == 0) rs1[m2] = 1.0f / sqrtf(s2 * (1.0f / DM) + EPS); }
    }
    { const GAS f32x4* p4 = (const GAS f32x4*)FIN(I_P); GAS u32x2* o = (GAS u32x2*)(F.ws + WS_PB); const int n4 = T * PLE / 4;
      for (int i = (F.vcu * NTHREADS + F.tid); i < n4; i += F.G * NTHREADS) { const f32x4 v = p4[i]; u32x2 w; w.x = pk2(v.x, v.y); w.y = pk2(v.z, v.w); o[i] = w; } }
    { bf16_t* Wt = (bf16_t*)(F.ws + WS_WR); const float* g = FIN(I_FFN_NORM); const float* wrg = FIN(I_W_RG); const float* wre = FIN(I_W_RE);
      for (int i = (F.vcu * NTHREADS + F.tid); i < 96 * DM; i += F.G * NTHREADS) { const int n = i / DM, c = i % DM; int o = -1; bool lo = false;
          if (n < 32) o = n; else if (n < 64) { o = n - 32; lo = true; } else if (n < 68) o = 32 + (n - 64); else if (n < 72) { o = 32 + (n - 68); lo = true; }
          unsigned short r = 0;
          if (o >= 0) { const float w = g[c] * ((o < 4) ? wrg[c * 4 + o] : wre[c * 32 + (o - 4)]); const unsigned h = f2bf(w); r = (unsigned short)h;
              if (lo) r = (unsigned short)f2bf(w - bf2f((unsigned short)h)); }
          Wt[i] = r; } }
    { float* tab = (float*)(F.ws + WS_BIAS);
      for (int i = (F.vcu * NTHREADS + F.tid); i < 16 * 132; i += F.G * NTHREADS) { const int hh = i / 132, dd = i % 132; const int bk = dd < 128 ? (int)c_bucket[dd] : 31;
          tab[i] = FIN(I_RELB)[bk * NHQ + hh] * LOG2E; } }
}

using pg8::Unit;
struct EpiQKV {
    static constexpr bool PERM = true;
    bf16_t* qkv; const float* rs1; const float* gq_a; const float* gk_a; const float* gq_b; const float* gk_b; float* kmp;
    __device__ __forceinline__ void operator()(const f32x4 (&acc)[2][2][4][2], const Unit& u, int wr, int wc, int fr, int fq) const {
        const int head = 4 * u.pn + wc;
        const float* gain = nullptr; float qs = 1.f; bool kmean = false;
        if (head < 8) { gain = gq_a; qs = QSCALE; } else if (head < 10) { gain = gk_a; } else if (head < 12) {} else if (head < 20) { gain = gq_b; qs = QSCALE; } else if (head < 22) { gain = gk_b; kmean = true; }
        f32x4 gv[2][2];
#pragma unroll
        for (int bj = 0; bj < 2; ++bj)
#pragma unroll
            for (int n = 0; n < 2; ++n) { if (gain) { gv[bj][n] = *(const f32x4*)(gain + 32 * bj + 8 * fq + 4 * n) * qs; } else gv[bj][n] = (f32x4){1.f, 1.f, 1.f, 1.f}; }
        f32x4 ks[2][2];
#pragma unroll
        for (int bj = 0; bj < 2; ++bj)
#pragma unroll
            for (int n = 0; n < 2; ++n) ks[bj][n] = (f32x4){0.f, 0.f, 0.f, 0.f};
        float rsv[2][4];
#pragma unroll
        for (int ai = 0; ai < 2; ++ai)
#pragma unroll
            for (int m = 0; m < 4; ++m) rsv[ai][m] = rs1[u.pm * 256 + ai * 128 + wr * 64 + m * 16 + fr];
        asm volatile("" ::: "memory");
#pragma unroll
        for (int ai = 0; ai < 2; ++ai)
#pragma unroll
            for (int m = 0; m < 4; ++m) {
                const int row = u.pm * 256 + ai * 128 + wr * 64 + m * 16 + fr; const float rs = rsv[ai][m];
                f32x4 v[2][2]; float ss = 0.f;
#pragma unroll
                for (int bj = 0; bj < 2; ++bj)
#pragma unroll
                    for (int n = 0; n < 2; ++n) { v[bj][n] = acc[ai][bj][m][n] * rs; const f32x4 q = v[bj][n] * v[bj][n]; ss += (q[0] + q[1]) + (q[2] + q[3]); }
                float rn = 1.f;
                if (gain) { ss += __shfl_xor(ss, 16); ss += __shfl_xor(ss, 32); rn = 1.0f / sqrtf(ss * (1.0f / HD) + EPS); }
                bf16_t* rowp = qkv + (size_t)row * INW + 64 * head + 8 * fq;
#pragma unroll
                for (int bj = 0; bj < 2; ++bj) { const f32x4 v0 = v[bj][0] * rn * gv[bj][0], v1 = v[bj][1] * rn * gv[bj][1];
                    if (kmean) { ks[bj][0] += v0; ks[bj][1] += v1; }
                    u32x4 w; w.x = pg8::cvt_pk_bf16(v0[0], v0[1]); w.y = pg8::cvt_pk_bf16(v0[2], v0[3]); w.z = pg8::cvt_pk_bf16(v1[0], v1[1]); w.w = pg8::cvt_pk_bf16(v1[2], v1[3]);
                    *(u32x4*)(rowp + 32 * bj) = w; }
            }
        if (kmean) {
#pragma unroll
            for (int bj = 0; bj < 2; ++bj)
#pragma unroll
                for (int n = 0; n < 2; ++n)
#pragma unroll
                    for (int i = 0; i < 4; ++i) { float s = ks[bj][n][i]; s += __shfl_xor(s, 1); s += __shfl_xor(s, 2); s += __shfl_xor(s, 4); s += __shfl_xor(s, 8);
                        if (fr == 0) kmp[((u.pm * 2 + wr) * 2 + (head - 20)) * 64 + 32 * bj + 8 * fq + 4 * n + i] = s; }
        }
    }
};
struct EpiProj {
    static constexpr bool PERM = true;
    bf16_t* praw; float* ssqp;
    __device__ __forceinline__ void operator()(const f32x4 (&acc)[2][2][4][2], const Unit& u, int wr, int wc, int fr, int fq) const {
#pragma unroll
        for (int ai = 0; ai < 2; ++ai)
#pragma unroll
            for (int m = 0; m < 4; ++m) {
                const int row = u.pm * 256 + ai * 128 + wr * 64 + m * 16 + fr; float ss = 0.f;
                bf16_t* rowp = praw + (size_t)row * DM + u.pn * 256 + wc * 32 + 8 * fq;
#pragma unroll
                for (int bj = 0; bj < 2; ++bj) { const f32x4 v0 = acc[ai][bj][m][0], v1 = acc[ai][bj][m][1];
                    const f32x4 q = v0 * v0 + v1 * v1; ss += (q[0] + q[1]) + (q[2] + q[3]);
                    u32x4 w; w.x = pg8::cvt_pk_bf16(v0[0], v0[1]); w.y = pg8::cvt_pk_bf16(v0[2], v0[3]); w.z = pg8::cvt_pk_bf16(v1[0], v1[1]); w.w = pg8::cvt_pk_bf16(v1[2], v1[3]);
                    *(u32x4*)(rowp + 128 * bj) = w; }
                ss += __shfl_xor(ss, 16); ss += __shfl_xor(ss, 32);
                if (fq == 0) ssqp[(size_t)row * 16 + u.pn * 4 + wc] = ss;
            }
    }
};
struct EpiOut {
    static constexpr bool PERM = true;
    bf16_t* x1b; const LAS f32x2* tab;
    __device__ __forceinline__ void mid(f32x4 (&acc)[2][2][4][2], const Unit& u, int wr, int wc, int fr, int fq) const {
#pragma unroll
        for (int ai = 0; ai < 2; ++ai)
#pragma unroll
            for (int m = 0; m < 4; ++m) { const f32x2 sc = tab[ai * 128 + wr * 64 + m * 16 + fr]; const float r = sc.x / sc.y;
#pragma unroll
                for (int bj = 0; bj < 2; ++bj)
#pragma unroll
                    for (int n = 0; n < 2; ++n) acc[ai][bj][m][n] *= r; }
    }
    __device__ __forceinline__ void operator()(const f32x4 (&acc)[2][2][4][2], const Unit& u, int wr, int wc, int fr, int fq) const {
        const int col0 = u.pn * 256 + wc * 32 + 8 * fq;
#pragma unroll
        for (int ai = 0; ai < 2; ++ai) {
            u32x4 xv[4][2];
#pragma unroll
            for (int m = 0; m < 4; ++m) { const size_t off = (size_t)(u.pm * 256 + ai * 128 + wr * 64 + m * 16 + fr) * DM + col0;
#pragma unroll
                for (int bj = 0; bj < 2; ++bj) xv[m][bj] = *(const u32x4*)(x1b + off + bj * 128); }
            asm volatile("" ::: "memory");
#pragma unroll
            for (int m = 0; m < 4; ++m) { const int r = ai * 128 + wr * 64 + m * 16 + fr; const float sb = tab[r].y; const size_t off = (size_t)(u.pm * 256 + r) * DM + col0;
#pragma unroll
                for (int bj = 0; bj < 2; ++bj) { const u32x4 xw = xv[m][bj];
                    const f32x4 o0 = (f32x4){bflo(xw.x), bfhi(xw.x), bflo(xw.y), bfhi(xw.y)} + acc[ai][bj][m][0] * sb, o1 = (f32x4){bflo(xw.z), bfhi(xw.z), bflo(xw.w), bfhi(xw.w)} + acc[ai][bj][m][1] * sb;
                    u32x4 w; w.x = pg8::cvt_pk_bf16(o0[0], o0[1]); w.y = pg8::cvt_pk_bf16(o0[2], o0[3]); w.z = pg8::cvt_pk_bf16(o1[0], o1[1]); w.w = pg8::cvt_pk_bf16(o1[2], o1[3]);
                    *(u32x4*)(x1b + off + bj * 128) = w; } }
            asm volatile("" ::: "memory");
        }
    }
};
struct MoeOrder {
    const char* A; const char* Bt; const LAS int* tb; const unsigned* cnt; const unsigned* list; int K; size_t wstride; size_t arow_bytes; int G, c; bool gather;
    __device__ __forceinline__ bool next(int i, Unit& u) const {
        const int NT = tb[NEXP]; const int nwg = NT * 4; const long L = (long)i * G + c; if (L >= nwg) return false;
        int wgid = (int)L; { const int q = nwg / 8, r = nwg % 8, xcd = wgid % 8, off = wgid / 8; wgid = (xcd < r ? xcd * (q + 1) : r * (q + 1) + (xcd - r) * q) + off; }
        const int gt = wgid >> 2, pn = wgid & 3; int e = 0;
#pragma unroll 1
        while (e < NEXP - 1 && gt >= tb[e + 1]) ++e;
        const int lt = gt - tb[e]; const int nv = (int)cnt[e] - lt * 256;
        u.pm = gt; u.pn = pn; u.e = e * 16384 + lt * 256; u.nvalid = nv < 256 ? nv : 256;
        u.A = gather ? A : A + (size_t)gt * 256 * arow_bytes; u.B = Bt + (size_t)e * wstride + (size_t)pn * 256 * K * 2; return true;
    }
    __device__ __forceinline__ unsigned row_off(const Unit& u, int r) const {
        const unsigned ent = (r < u.nvalid) ? list[u.e + r] : 0u; return (ent >> 1) * (unsigned)arow_bytes;
    }
};
struct EpiG1 {
    static constexpr bool PERM = true;
    bf16_t* H; const float* r2; const unsigned* list;
    __device__ __forceinline__ void operator()(const f32x4 (&acc)[2][2][4][2], const Unit& u, int wr, int wc, int fr, int fq) const {
        unsigned entv[2][4]; float rsv[2][4];
#pragma unroll
        for (int ai = 0; ai < 2; ++ai)
#pragma unroll
            for (int m = 0; m < 4; ++m) { const int r = ai * 128 + wr * 64 + m * 16 + fr; entv[ai][m] = (r < u.nvalid) ? list[u.e + r] : 0u; }
#pragma unroll
        for (int ai = 0; ai < 2; ++ai)
#pragma unroll
            for (int m = 0; m < 4; ++m) rsv[ai][m] = r2[entv[ai][m] >> 1];
        asm volatile("" ::: "memory");
#pragma unroll
        for (int ai = 0; ai < 2; ++ai)
#pragma unroll
            for (int m = 0; m < 4; ++m) { const int r = ai * 128 + wr * 64 + m * 16 + fr; const float rs = rsv[ai][m];
                float h[8];
#pragma unroll
                for (int n = 0; n < 2; ++n)
#pragma unroll
                    for (int i = 0; i < 4; ++i) { const float g = acc[ai][0][m][n][i] * rs, up = acc[ai][1][m][n][i] * rs; h[4 * n + i] = g / (1.0f + __builtin_amdgcn_exp2f(-g * LOG2E)) * up; }
                u32x4 w; w.x = pg8::cvt_pk_bf16(h[0], h[1]); w.y = pg8::cvt_pk_bf16(h[2], h[3]); w.z = pg8::cvt_pk_bf16(h[4], h[5]); w.w = pg8::cvt_pk_bf16(h[6], h[7]);
                *(u32x4*)(H + (size_t)(u.pm * 256 + r) * DEXP + u.pn * 128 + wc * 32 + 8 * fq) = w; }
    }
};
struct EpiG2 {
    static constexpr bool PERM = true;
    bf16_t* Y; const unsigned* list;
    __device__ __forceinline__ void operator()(const f32x4 (&acc)[2][2][4][2], const Unit& u, int wr, int wc, int fr, int fq) const {
        unsigned entv[2][4];
#pragma unroll
        for (int ai = 0; ai < 2; ++ai)
#pragma unroll
            for (int m = 0; m < 4; ++m) { const int r = ai * 128 + wr * 64 + m * 16 + fr; entv[ai][m] = (r < u.nvalid) ? list[u.e + r] : 0u; }
        asm volatile("" ::: "memory");
#pragma unroll
        for (int ai = 0; ai < 2; ++ai)
#pragma unroll
            for (int m = 0; m < 4; ++m) { const int r = ai * 128 + wr * 64 + m * 16 + fr;
                if (r < u.nvalid) { const unsigned ent = entv[ai][m]; bf16_t* rowp = Y + (size_t)ent * DM + u.pn * 256 + wc * 32 + 8 * fq;
#pragma unroll
                    for (int bj = 0; bj < 2; ++bj) { const f32x4 v0 = acc[ai][bj][m][0], v1 = acc[ai][bj][m][1];
                        u32x4 w; w.x = pg8::cvt_pk_bf16(v0[0], v0[1]); w.y = pg8::cvt_pk_bf16(v0[2], v0[3]); w.z = pg8::cvt_pk_bf16(v1[0], v1[1]); w.w = pg8::cvt_pk_bf16(v1[2], v1[3]);
                        *(u32x4*)(rowp + 128 * bj) = w; } } }
    }
};
struct EpiFinal {
    static constexpr bool PERM = false;
    float* out; const bf16_t* x2b; const bf16_t* praw; const float* gout; const LAS f32x2* tab;
    __device__ __forceinline__ void operator()(const f32x4 (&acc)[2][2][4][2], const Unit& u, int wr, int wc, int fr, int fq) const {
        const int col0 = u.pn * 256 + wc * 32 + 4 * fq;
        f32x4 gv[2][2];
#pragma unroll
        for (int bj = 0; bj < 2; ++bj)
#pragma unroll
            for (int n = 0; n < 2; ++n) gv[bj][n] = *(const f32x4*)(gout + col0 + bj * 128 + n * 16);
#pragma unroll
        for (int am = 0; am < 4; ++am) { const int ai = am >> 1, mb = 2 * (am & 1);
            u32x2 xw[2][2][2], pw[2][2][2];
#pragma unroll
            for (int mm = 0; mm < 2; ++mm) { const size_t off = (size_t)(u.pm * 256 + ai * 128 + wr * 64 + (mb + mm) * 16 + fr) * DM + col0;
#pragma unroll
                for (int bj = 0; bj < 2; ++bj)
#pragma unroll
                    for (int n = 0; n < 2; ++n) { xw[mm][bj][n] = *(const u32x2*)(x2b + off + bj * 128 + n * 16); pw[mm][bj][n] = *(const u32x2*)(praw + off + bj * 128 + n * 16); } }
            asm volatile("" ::: "memory");
#pragma unroll
            for (int mm = 0; mm < 2; ++mm) { const int m = mb + mm; const int r = ai * 128 + wr * 64 + m * 16 + fr; const f32x2 sc = tab[r]; const size_t off = (size_t)(u.pm * 256 + r) * DM + col0;
#pragma unroll
                for (int bj = 0; bj < 2; ++bj)
#pragma unroll
                    for (int n = 0; n < 2; ++n) { const u32x2 a = xw[mm][bj][n], p = pw[mm][bj][n];
                        const f32x4 xv = (f32x4){bflo(a.x), bfhi(a.x), bflo(a.y), bfhi(a.y)}, pv = (f32x4){bflo(p.x), bfhi(p.x), bflo(p.y), bfhi(p.y)}; f32x4 o;
#pragma unroll
                        for (int i = 0; i < 4; ++i) { const float z = acc[ai][bj][m][n][i] * sc.x; const float sg = 1.0f / (1.0f + __builtin_amdgcn_exp2f(-z * LOG2E)); o[i] = xv[i] + sg * (pv[i] * sc.y * gv[bj][n][i]); }
                        *(f32x4*)(out + off + bj * 128 + n * 16) = o; }
                asm volatile("" ::: "memory"); }
        }
    }
};

namespace att {
typedef float f32x16 __attribute__((ext_vector_type(16)));
typedef short s16x4 __attribute__((ext_vector_type(4)));
constexpr int NSLOT = 6, KBUF = 0, VBUF = NSLOT * 8192, LUT_OFF = 2 * NSLOT * 8192, KM_OFF = LUT_OFF + 2048;
constexpr float NEGBIG = -1e30f, MFLOOR = -1e20f;
__device__ __forceinline__ s16x4 vtr(const LAS unsigned char* p) { return __builtin_bit_cast(s16x4, __builtin_amdgcn_ds_read_tr16_b64_v4i16((LAS s16x4*)p)); }
__device__ __forceinline__ unsigned pkbf(float lo, float hi) { f32x2 v = {lo, hi}; typedef __bf16 bf2 __attribute__((ext_vector_type(2))); bf2 b = __builtin_convertvector(v, bf2); return __builtin_bit_cast(unsigned, b); }

template <int TYPE>
__device__ __forceinline__ void attn_unit(Frame& F, int b, int hlp, int n) {
    const int tid = F.tid, lane = F.lane, w = F.wave, r32 = lane & 31, hi = lane >> 5;
    const int hl = TYPE ? hlp : 2 * hlp + (w >> 2);
    const int hh = TYPE * 8 + hl, g = hl >> 2;
    const int colQ = (TYPE ? C_QB : C_QA) + 64 * hl, colK = (TYPE ? C_KB : C_KA) + 64 * g, colV = (TYPE ? C_VB : C_VA) + 64 * g;
    const bf16_t* qkv = (const bf16_t*)(F.ws + WS_QKV); bf16_t* O = (bf16_t*)(F.ws + WS_O); float* ssq = (float*)(F.ws + WS_SSQ);
    const float* tab = (const float*)(F.ws + WS_BIAS); const float* kmp = (const float*)(F.ws + WS_KMP);
    const size_t rowb = (size_t)b * SEQ;
    LAS unsigned char* L = F.lds; LAS float* lut = (LAS float*)(L + LUT_OFF) + (TYPE ? 0 : 316 * (w >> 2)); LAS float* kml = (LAS float*)(L + KM_OFF);
    const int q0w = TYPE ? 256 * n + 32 * w : 128 * n + 32 * (w & 3);
    const int t_lo = TYPE ? 0 : (2 * n - 2 > 0 ? 2 * n - 2 : 0), t_hi = TYPE ? 4 * n + 3 : 2 * n + 1;
    __syncthreads();
    for (int e = tid; e < (TYPE ? 316 : 632); e += NTHREADS) { const int ti = TYPE ? e : e % 316, hx = TYPE ? hh : 2 * hlp + e / 316; const int dist = 221 - ti; float v;
        if (dist < 0) v = NEGBIG; else if (dist < 128) v = tab[hx * 132 + dist] - (TYPE ? tab[hx * 132 + 128] : 0.f); else v = TYPE ? 0.f : NEGBIG;
        ((LAS float*)(L + LUT_OFF))[e] = v; }
    if (TYPE) { const int nb = tid >> 6, d = tid & 63; float v = 0.f;
        if (nb < n) { const int pm = b * 8 + nb; v = kmp[((pm * 2 + 0) * 2 + g) * 64 + d] + kmp[((pm * 2 + 1) * 2 + g) * 64 + d]; }
        kml[tid] = v; }
    bf16x8 qf[4];
    { const bf16_t* qp = qkv + (rowb + q0w + r32) * INW + colQ + 8 * hi;
#pragma unroll
      for (int d0 = 0; d0 < 4; ++d0) qf[d0] = *(const bf16x8*)(qp + 16 * d0); }
    const int srow = 8 * w + (lane >> 3);
    const bf16_t* kg = qkv + (rowb + srow) * INW + colK + 8 * ((lane & 7) ^ ((srow >> 1) & 7));
    const bf16_t* vg = qkv + (rowb + srow) * INW + colV + 8 * ((lane & 7) ^ (((srow >> 1) & 1) << 2));
    const int ntl = t_hi - t_lo + 1;
#define TILE_OF(i) (TYPE ? ((i) < 4 ? 4 * n + (i) : (i) - 4) : t_lo + (i))
#define STAGE(ti, slot) do { const int ti_ = (ti) < ntl ? (ti) : ntl - 1; const size_t go_ = (size_t)TILE_OF(ti_) * 64 * INW; \
        __builtin_amdgcn_global_load_lds((const unsigned*)(kg + go_), (LAS unsigned*)(L + KBUF + (slot) * 8192 + w * 1024), 16, 0, 0); \
        __builtin_amdgcn_global_load_lds((const unsigned*)(vg + go_), (LAS unsigned*)(L + VBUF + (slot) * 8192 + w * 1024), 16, 0, 0); } while (0)
    STAGE(0, 0); STAGE(1, 1); STAGE(2, 2); STAGE(3, 3);
    asm volatile("s_waitcnt vmcnt(4)" ::: "memory");
    asm volatile("s_waitcnt lgkmcnt(0)" ::: "memory"); __builtin_amdgcn_s_barrier(); asm volatile("" ::: "memory");
    unsigned sel = 0u;
    if (TYPE) {
        float gate[8];
#pragma unroll
        for (int nb = 0; nb < 8; ++nb) gate[nb] = 0.f;
#pragma unroll
        for (int d0 = 0; d0 < 4; ++d0) { float q8[8];
#pragma unroll
            for (int j = 0; j < 8; ++j) q8[j] = bf2f((unsigned short)qf[d0][j]);
#pragma unroll
            for (int nb = 0; nb < 7; ++nb) if (nb < n) { const f32x4 k0 = *(const LAS f32x4*)(kml + nb * 64 + 16 * d0 + 8 * hi), k1 = *(const LAS f32x4*)(kml + nb * 64 + 16 * d0 + 8 * hi + 4);
                gate[nb] += (q8[0] * k0[0] + q8[1] * k0[1]) + (q8[2] * k0[2] + q8[3] * k0[3]) + (q8[4] * k1[0] + q8[5] * k1[1]) + (q8[6] * k1[2] + q8[7] * k1[3]); } }
#pragma unroll
        for (int nb = 0; nb < 7; ++nb) gate[nb] += __shfl_xor(gate[nb], 32);
        const int nsel = n < 3 ? n : 3;
        for (int k = 0; k < nsel; ++k) { float best = -3e38f; int bi = 0;
#pragma unroll
            for (int nb = 0; nb < 7; ++nb) { const bool ok = (nb < n) && !((sel >> nb) & 1u) && (gate[nb] > best); if (ok) { best = gate[nb]; bi = nb; } }
            sel |= 1u << bi; }
    }
    float m = TYPE ? 0.f : FIN(I_SINKS)[hl] * LOG2E, l = (TYPE == 0 && hi == 0) ? 1.f : 0.f;
    f32x16 negm;
#pragma unroll
    for (int r = 0; r < 16; ++r) negm[r] = -m;
    f32x16 o0 = {}, o1 = {};
    const int qpos = q0w + r32;
    const int kroff = r32 * 128;  const int ksw = (r32 >> 1) & 7;
    const int q_ = (lane & 15) >> 2, p_ = lane & 3, sw = (q_ >> 1) & 1, clow = 2 * ((lane >> 4) & 1) + (p_ >> 1);
    const int vrow = (4 * hi + q_) * 128 + (p_ & 1) * 8;
    const int vb0 = vrow + ((4 * (0 ^ sw) + clow) << 4), vb1 = vrow + ((4 * (1 ^ sw) + clow) << 4);
    const int vaddr0 = (int)(unsigned)(unsigned long)(L + VBUF) + vb0, vaddr1 = (int)(unsigned)(unsigned long)(L + VBUF) + vb1;
    constexpr float THR = 8.0f;
#define ATT_STEP(IDX, SLOT) do { const int i = (IDX);         const int kt = TILE_OF(i); const int cur = (SLOT); \
        const int k0 = 64 * kt; const int dmax = q0w + 31 - k0, dmin = q0w - k0 - 63; \
        bool active, near, mine = true; \
        if (TYPE == 0) { active = (dmax >= 0) && (dmin <= 127); near = true; } \
        else if (kt >= 4 * n) { active = dmax >= 0; near = dmin < 128; } \
        else { mine = (sel >> (kt >> 2)) & 1u; active = __ballot(mine) != 0ull; near = dmin < 128; } \
        if (active) { \
            const LAS unsigned char* Kb = L + KBUF + cur * 8192; const LAS unsigned char* Vb = L + VBUF + cur * 8192; \
            f32x16 p0, p1, c = negm; \
            if (TYPE && kt < 4 * n) { \
        _Pragma("unroll") \
                for (int r = 0; r < 16; ++r) c[r] = mine ? negm[r] : NEGBIG; } \
            { const int co = ((0 + hi) ^ ksw) << 4; const bf16x8 ka = *(const LAS bf16x8*)(Kb + kroff + co), kb2 = *(const LAS bf16x8*)(Kb + 4096 + kroff + co); \
              p0 = __builtin_amdgcn_mfma_f32_32x32x16_bf16(ka, qf[0], c, 0, 0, 0); p1 = __builtin_amdgcn_mfma_f32_32x32x16_bf16(kb2, qf[0], c, 0, 0, 0); } \
        _Pragma("unroll") \
            for (int d0 = 1; d0 < 4; ++d0) { const int co = ((2 * d0 + hi) ^ ksw) << 4; \
                const bf16x8 ka = *(const LAS bf16x8*)(Kb + kroff + co), kb2 = *(const LAS bf16x8*)(Kb + 4096 + kroff + co); \
                p0 = __builtin_amdgcn_mfma_f32_32x32x16_bf16(ka, qf[d0], p0, 0, 0, 0); p1 = __builtin_amdgcn_mfma_f32_32x32x16_bf16(kb2, qf[d0], p1, 0, 0, 0); } \
            if (near) { const LAS float* lp = lut + (221 - (qpos - k0 - 4 * hi)); \
        _Pragma("unroll") \
                for (int r = 0; r < 16; ++r) { const int ko = (r & 3) + 8 * (r >> 2); p0[r] += lp[ko]; p1[r] += lp[32 + ko]; } } \
            float mx = __builtin_fmaxf(__builtin_fmaxf(p0[0], p1[0]), p0[1]); \
        _Pragma("unroll") \
            for (int r = 1; r < 16; ++r) mx = (r == 1) ? __builtin_fmaxf(mx, p1[1]) : __builtin_fmaxf(__builtin_fmaxf(mx, p0[r]), p1[r]); \
            mx = __builtin_fmaxf(mx, __shfl_xor(mx, 32)); \
            const bool first = (TYPE == 1) && (i == 0); \
            const float delta = first ? mx : (mx > THR ? mx : 0.f); \
            if (__ballot(delta != 0.f) != 0ull) { \
                m += delta; const float alpha = __builtin_amdgcn_exp2f(-delta); l *= alpha; \
        _Pragma("unroll") \
                for (int r = 0; r < 16; ++r) { o0[r] *= alpha; o1[r] *= alpha; negm[r] = -m; p0[r] -= delta; p1[r] -= delta; } \
            } \
            float ps = 0.f; \
        _Pragma("unroll") \
            for (int r = 0; r < 16; ++r) { p0[r] = __builtin_amdgcn_exp2f(p0[r]); p1[r] = __builtin_amdgcn_exp2f(p1[r]); ps += p0[r] + p1[r]; } \
            l += ps; \
            s16x4 ta[4][2], tc[4][2];                                    \
        _Pragma("unroll") \
            for (int s = 0; s < 4; ++s) { \
                asm volatile("ds_read_b64_tr_b16 %0, %1 offset:%c2" : "=&v"(ta[s][0]) : "v"(vaddr0 + cur * 8192), "i"(s * 2048) : "memory"); \
                asm volatile("ds_read_b64_tr_b16 %0, %1 offset:%c2" : "=&v"(ta[s][1]) : "v"(vaddr0 + cur * 8192), "i"(s * 2048 + 1024) : "memory"); \
                asm volatile("ds_read_b64_tr_b16 %0, %1 offset:%c2" : "=&v"(tc[s][0]) : "v"(vaddr1 + cur * 8192), "i"(s * 2048) : "memory"); \
                asm volatile("ds_read_b64_tr_b16 %0, %1 offset:%c2" : "=&v"(tc[s][1]) : "v"(vaddr1 + cur * 8192), "i"(s * 2048 + 1024) : "memory"); } \
            asm volatile("s_waitcnt lgkmcnt(0)" ::: "memory"); __builtin_amdgcn_sched_barrier(0); \
        _Pragma("unroll") \
            for (int s = 0; s < 4; ++s) { \
                u32x4 pw; \
                if (s < 2) { pw.x = pkbf(p0[8 * s + 0], p0[8 * s + 1]); pw.y = pkbf(p0[8 * s + 2], p0[8 * s + 3]); pw.z = pkbf(p0[8 * s + 4], p0[8 * s + 5]); pw.w = pkbf(p0[8 * s + 6], p0[8 * s + 7]); } \
                else { const int s2 = s - 2; pw.x = pkbf(p1[8 * s2 + 0], p1[8 * s2 + 1]); pw.y = pkbf(p1[8 * s2 + 2], p1[8 * s2 + 3]); pw.z = pkbf(p1[8 * s2 + 4], p1[8 * s2 + 5]); pw.w = pkbf(p1[8 * s2 + 6], p1[8 * s2 + 7]); } \
                const bf16x8 pb = __builtin_bit_cast(bf16x8, pw); \
                const s16x4 a0 = ta[s][0], a1 = ta[s][1], c0 = tc[s][0], c1 = tc[s][1]; \
                const bf16x8 va = (bf16x8){a0[0], a0[1], a0[2], a0[3], a1[0], a1[1], a1[2], a1[3]}, vc = (bf16x8){c0[0], c0[1], c0[2], c0[3], c1[0], c1[1], c1[2], c1[3]}; \
                o0 = __builtin_amdgcn_mfma_f32_32x32x16_bf16(va, pb, o0, 0, 0, 0); o1 = __builtin_amdgcn_mfma_f32_32x32x16_bf16(vc, pb, o1, 0, 0, 0); \
            } \
        } \
    } while (0)
    { int sc = 0;
      for (int i2 = 0; i2 < ntl; i2 += 2) {
          const int s4 = (sc + 4 >= NSLOT) ? sc + 4 - NSLOT : sc + 4, s5 = (sc + 5 >= NSLOT) ? sc + 5 - NSLOT : sc + 5, sn = sc + 1;
          STAGE(i2 + 4, s4); STAGE(i2 + 5, s5);
          ATT_STEP(i2, sc); ATT_STEP(i2 + 1, sn);
          asm volatile("s_waitcnt vmcnt(4)" ::: "memory");
          asm volatile("s_waitcnt lgkmcnt(0)" ::: "memory"); __builtin_amdgcn_s_barrier(); asm volatile("" ::: "memory");
          sc = (sc + 2 >= NSLOT) ? sc + 2 - NSLOT : sc + 2; } }
    asm volatile("s_waitcnt vmcnt(0)" ::: "memory");
#undef ATT_STEP
#undef STAGE
#undef TILE_OF
    l += __shfl_xor(l, 32);
    const float rl = 1.0f / l; float q2 = 0.f;
    const size_t t = rowb + qpos; bf16_t* op = O + t * DM + 64 * hh + 4 * hi;
#pragma unroll
    for (int c4 = 0; c4 < 4; ++c4) {
        const float a0 = o0[4 * c4 + 0] * rl, a1 = o0[4 * c4 + 1] * rl, a2 = o0[4 * c4 + 2] * rl, a3 = o0[4 * c4 + 3] * rl;
        const float b0 = o1[4 * c4 + 0] * rl, b1 = o1[4 * c4 + 1] * rl, b2 = o1[4 * c4 + 2] * rl, b3 = o1[4 * c4 + 3] * rl;
        q2 += (a0 * a0 + a1 * a1) + (a2 * a2 + a3 * a3) + (b0 * b0 + b1 * b1) + (b2 * b2 + b3 * b3);
        u32x2 wa; wa.x = pkbf(a0, a1); wa.y = pkbf(a2, a3); *(u32x2*)(op + 8 * c4) = wa;
        u32x2 wb; wb.x = pkbf(b0, b1); wb.y = pkbf(b2, b3); *(u32x2*)(op + 32 + 8 * c4) = wb;
    }
    q2 += __shfl_xor(q2, 32);
    if (hi == 0) ssq[t * 16 + hh] = q2;
}
}
__device__ __forceinline__ void p2_attention(Frame& F) {
    for (int j = F.vcu; j < 512; j += F.G) {
        if (j < 256) { const int b = j >> 5, hm = (j >> 2) & 7, pi = j & 3; att::attn_unit<1>(F, b, hm, 7 - pi); att::attn_unit<1>(F, b, hm, pi); }
        else { const int id = 2 * (j - 256);
#pragma unroll 1
            for (int k = 0; k < 2; ++k) { const int u = id + k; att::attn_unit<0>(F, u >> 6, (u >> 4) & 3, u & 15); } }
    }
    __syncthreads();
}

__device__ __forceinline__ void p4_router(Frame& F) {
    typedef float f32x16 __attribute__((ext_vector_type(16)));
    const bf16_t* x1b = (const bf16_t*)(F.ws + WS_X1B); float* r2 = (float*)(F.ws + WS_R2); const bf16_t* Wt = (const bf16_t*)(F.ws + WS_WR);
    LAS float* part = (LAS float*)F.lds;
    LAS float* sspart = (LAS float*)(F.lds + 98304);
    LAS int* lcnt = (LAS int*)(F.lds + MISC_OFF);
    LAS int* trec = (LAS int*)(F.lds + MISC_OFF + 512);
    unsigned* cnt = (unsigned*)(F.ctl + CW_CNT); unsigned* list = (unsigned*)(F.ws + WS_LIST); int* tok = (int*)(F.ws + WS_TOK);
    if (F.tid < 64) lcnt[F.tid] = 0;
    const int per = T / F.G;
    const int t0 = F.vcu * per;
    {
        const int tg = F.wave >> 2, kq = F.wave & 3, r32 = F.lane & 31, hi = F.lane >> 5;
        const bf16_t* ap = x1b + (size_t)(t0 + 32 * tg + r32) * DM + 256 * kq + 8 * hi;
        const bf16_t* bp = Wt + (size_t)r32 * DM + 256 * kq + 8 * hi;
        f32x16 a0 = {}, a1 = {}, a2 = {}; float ss = 0.f;
#pragma unroll 4
        for (int s = 0; s < 16; ++s) {
            const bf16x8 a = *(const bf16x8*)(ap + 16 * s);
            const bf16x8 b0 = *(const bf16x8*)(bp + 16 * s), b1 = *(const bf16x8*)(bp + (size_t)32 * DM + 16 * s), b2 = *(const bf16x8*)(bp + (size_t)64 * DM + 16 * s);
            a0 = __builtin_amdgcn_mfma_f32_32x32x16_bf16(a, b0, a0, 0, 0, 0); a1 = __builtin_amdgcn_mfma_f32_32x32x16_bf16(a, b1, a1, 0, 0, 0); a2 = __builtin_amdgcn_mfma_f32_32x32x16_bf16(a, b2, a2, 0, 0, 0);
#pragma unroll
            for (int j = 0; j < 8; ++j) { const float v = bf2f((unsigned short)a[j]); ss += v * v; }
        }
        LAS float* pp = part + ((tg * 4 + kq) * 32) * 96 + r32;
#pragma unroll
        for (int r = 0; r < 16; ++r) { const int tk = (r & 3) + 8 * (r >> 2) + 4 * hi; pp[tk * 96] = a0[r]; pp[tk * 96 + 32] = a1[r]; pp[tk * 96 + 64] = a2[r]; }
        sspart[((tg * 4 + kq) * 2 + hi) * 32 + r32] = ss;
    }
    __syncthreads();
    if (F.tid < per) {
        const int lt = F.tid, tg = lt >> 5, tk = lt & 31, t = t0 + lt;
        float lg[36]; float ssq = 0.f;
#pragma unroll
        for (int o = 0; o < 36; ++o) lg[o] = 0.f;
#pragma unroll
        for (int kq = 0; kq < 4; ++kq) { const LAS float* pr = part + ((tg * 4 + kq) * 32 + tk) * 96;
#pragma unroll
            for (int o = 0; o < 32; ++o) lg[o] += pr[o] + pr[32 + o];
#pragma unroll
            for (int o = 0; o < 4; ++o) lg[32 + o] += pr[64 + o] + pr[68 + o];
            ssq += sspart[((tg * 4 + kq) * 2 + 0) * 32 + tk] + sspart[((tg * 4 + kq) * 2 + 1) * 32 + tk]; }
        const float rs = 1.0f / sqrtf(ssq * (1.0f / DM) + EPS);
#pragma unroll
        for (int o = 0; o < 36; ++o) lg[o] *= rs;
        const float* brg = FIN(I_B_RG); const float* bre = FIN(I_B_RE);
        lg[0] += brg[0]; lg[1] += brg[1]; lg[2] += brg[2]; lg[3] += brg[3];
        int gsel = 0; float gm = lg[0];
#pragma unroll
        for (int o = 1; o < 4; ++o) if (lg[o] > gm) { gm = lg[o]; gsel = o; }
        float den = 0.f;
#pragma unroll
        for (int o = 0; o < 4; ++o) den += __expf(lg[o] - gm);
        const float gwt = 1.0f / den;
        float el[8];
#pragma unroll
        for (int j = 0; j < 8; ++j) { float a = lg[4 + j];
#pragma unroll
            for (int gq = 1; gq < 4; ++gq) a = (gsel == gq) ? lg[4 + 8 * gq + j] : a;
            el[j] = a + bre[gsel * 8 + j]; }
        int i0 = 0; float v0 = el[0];
#pragma unroll
        for (int j = 1; j < 8; ++j) if (el[j] > v0) { v0 = el[j]; i0 = j; }
        int i1 = -1; float v1 = -3e38f;
#pragma unroll
        for (int j = 0; j < 8; ++j) if (j != i0 && el[j] > v1) { v1 = el[j]; i1 = j; }
        const float e1 = __expf(v1 - v0); const float w0 = gwt / (1.0f + e1), w1 = gwt * e1 / (1.0f + e1);
        const int e0 = gsel * 8 + i0, e1i = gsel * 8 + i1;
        const int lr0 = __hip_atomic_fetch_add(&lcnt[e0], 1, __ATOMIC_RELAXED, __HIP_MEMORY_SCOPE_WORKGROUP);
        const int lr1 = __hip_atomic_fetch_add(&lcnt[e1i], 1, __ATOMIC_RELAXED, __HIP_MEMORY_SCOPE_WORKGROUP);
        trec[lt * 8 + 0] = e0; trec[lt * 8 + 1] = e1i; trec[lt * 8 + 2] = lr0; trec[lt * 8 + 3] = lr1;
        trec[lt * 8 + 4] = __builtin_bit_cast(int, w0); trec[lt * 8 + 5] = __builtin_bit_cast(int, w1);
        r2[t] = rs;
    }
    __syncthreads();
    if (F.tid < 32) { const int c = lcnt[F.tid]; int base = 0; if (c > 0) base = (int)__hip_atomic_fetch_add(&cnt[F.tid], (unsigned)c, __ATOMIC_RELAXED, __HIP_MEMORY_SCOPE_AGENT); lcnt[32 + F.tid] = base; }
    __syncthreads();
    for (int lt = F.tid; lt < per; lt += NTHREADS) {
        const int t = t0 + lt; const int e0 = trec[lt * 8 + 0], e1 = trec[lt * 8 + 1];
        const int rk0 = lcnt[32 + e0] + trec[lt * 8 + 2], rk1 = lcnt[32 + e1] + trec[lt * 8 + 3];
        list[e0 * 16384 + rk0] = (unsigned)(t * 2); list[e1 * 16384 + rk1] = (unsigned)(t * 2 + 1);
        int* tr = tok + (size_t)t * 8; tr[0] = e0; tr[1] = e1; tr[2] = rk0; tr[3] = rk1; tr[4] = trec[lt * 8 + 4]; tr[5] = trec[lt * 8 + 5];
    }
    __syncthreads();
}

__device__ __forceinline__ void build_tile_table(Frame& F, LAS int* tb) {
    if (F.tid == 0) { const unsigned* cnt = (const unsigned*)(F.ctl + CW_CNT); int acc = 0;
        for (int e = 0; e < NEXP; ++e) { tb[e] = acc; acc += (int)((__hip_atomic_load(&cnt[e], __ATOMIC_RELAXED, __HIP_MEMORY_SCOPE_AGENT) + 255u) >> 8); } tb[NEXP] = acc; }
    __syncthreads();
}

__device__ __forceinline__ void p7_combine(Frame& F) {
    const bf16_t* x1b = (const bf16_t*)(F.ws + WS_X1B); const bf16_t* Y = (const bf16_t*)(F.ws + WS_Y); bf16_t* x2b = (bf16_t*)(F.ws + WS_X2B); float* r3 = (float*)(F.ws + WS_R3); const int* tok = (const int*)(F.ws + WS_TOK);
    const int gw = F.vcu * NWAVES + F.wave, NGW = F.G * NWAVES;
    for (int t = gw; t < T; t += 2 * NGW) {
        const int tb_ = (t + NGW < T) ? t + NGW : t; const bool two = tb_ != t;
        const f32x2 wa = *(const f32x2*)(tok + (size_t)t * 8 + 4), wb = *(const f32x2*)(tok + (size_t)tb_ * 8 + 4);
        u32x2 xa[2][4], ya[2][4], yb[2][4];
#pragma unroll
        for (int k = 0; k < 2; ++k) { const int tt = k ? tb_ : t;
            const GAS u32x2* xr = (const GAS u32x2*)(x1b + (size_t)tt * DM) + F.lane;
            const GAS u32x2* y0 = (const GAS u32x2*)(Y + (size_t)(2 * tt) * DM) + F.lane; const GAS u32x2* y1 = (const GAS u32x2*)(Y + (size_t)(2 * tt + 1) * DM) + F.lane;
#pragma unroll
            for (int j = 0; j < 4; ++j) { xa[k][j] = xr[64 * j]; ya[k][j] = y0[64 * j]; yb[k][j] = y1[64 * j]; } }
#pragma unroll
        for (int k = 0; k < 2; ++k) { const int tt = k ? tb_ : t; const float w0 = k ? wb.x : wa.x, w1 = k ? wb.y : wa.y;
            GAS u32x2* ob = (GAS u32x2*)(x2b + (size_t)tt * DM) + F.lane; float s = 0.f;
#pragma unroll
            for (int j = 0; j < 4; ++j) { f32x4 v;
                v.x = bflo(xa[k][j].x) + (w0 * bflo(ya[k][j].x) + w1 * bflo(yb[k][j].x)); v.y = bfhi(xa[k][j].x) + (w0 * bfhi(ya[k][j].x) + w1 * bfhi(yb[k][j].x));
                v.z = bflo(xa[k][j].y) + (w0 * bflo(ya[k][j].y) + w1 * bflo(yb[k][j].y)); v.w = bfhi(xa[k][j].y) + (w0 * bfhi(ya[k][j].y) + w1 * bfhi(yb[k][j].y));
                u32x2 w; w.x = pk2(v.x, v.y); w.y = pk2(v.z, v.w); if (k == 0 || two) ob[64 * j] = w; s += (v.x * v.x + v.y * v.y) + (v.z * v.z + v.w * v.w); }
            s = wave_sum(s);
            if (F.lane == 0 && (k == 0 || two)) r3[tt] = 1.0f / sqrtf(s * (1.0f / DM) + EPS); }
    }
}

#define XB_TMO      128
#define XB_XCNT(j)  (256  + 64 * (j))
#define XB_XSUB(j)  (1280 + 64 * (j))
#define XB_XGEN(j)  (2304 + 64 * (j))
#define XB_TOP      3328
#define XB_TOPGEN   3392
#define XCD_BAR_WORDS 3456
#define XB_SPIN_CAP (1u << 18)
__device__ __forceinline__ unsigned xb_ld(unsigned* p)              { return __hip_atomic_load(p, __ATOMIC_RELAXED, __HIP_MEMORY_SCOPE_AGENT); }
__device__ __forceinline__ unsigned xb_add(unsigned* p, unsigned v) { return __hip_atomic_fetch_add(p, v, __ATOMIC_RELAXED, __HIP_MEMORY_SCOPE_AGENT); }
__device__ __forceinline__ unsigned xb_xcc_id() { return (unsigned)__builtin_amdgcn_s_getreg((3 << 11) | 20) & 0xFu; }
#define XB_SPIN(cond, bar) do { unsigned _sp = 0; while (cond) { __builtin_amdgcn_s_sleep(1); \
    if ((++_sp & 255u) == 0u) { if (xb_ld(&(bar)[XB_TMO])) break; if (_sp > XB_SPIN_CAP) { atomicAdd(&(bar)[XB_TMO], 1u); break; } } } } while (0)
struct XcdBarrier { unsigned* bar; unsigned x; volatile LAS unsigned* st; };
__device__ __forceinline__ XcdBarrier xcd_barrier_post(unsigned* bar, volatile LAS unsigned* st) {
    XcdBarrier b; b.bar = bar; b.x = xb_xcc_id(); b.st = st;
    if (threadIdx.x == 0) (void)xb_add(&bar[XB_XCNT(b.x)], 1u);
    return b;
}
__device__ __forceinline__ void xcd_barrier_complete(unsigned* bar, unsigned x, unsigned& nloc, unsigned& nx) {
    const unsigned G = gridDim.x * gridDim.y * gridDim.z;
    unsigned sum, cnt, mine, sp = 0u;
    for (;;) {
        sum = 0u; cnt = 0u; mine = 0u;
#pragma unroll
        for (unsigned j = 0; j < 16; ++j) { const unsigned c = xb_ld(&bar[XB_XCNT(j)]); sum += c; cnt += (c > 0u) ? 1u : 0u; mine = (j == x) ? c : mine; }
        if (sum == G) break;
        __builtin_amdgcn_s_sleep(1);
        if ((++sp & 255u) == 0u) { if (xb_ld(&bar[XB_TMO])) break; if (sp > XB_SPIN_CAP) { atomicAdd(&bar[XB_TMO], 1u); break; } }
    }
    nloc = mine > 0u ? mine : 1u; nx = cnt > 0u ? cnt : 1u;
}
__device__ __forceinline__ void xcd_barrier(const XcdBarrier& b) {
    asm volatile("s_waitcnt vmcnt(0)" ::: "memory");
    __syncthreads();
    if (threadIdx.x == 0) {
        unsigned* bar = b.bar;
        __builtin_amdgcn_s_waitcnt(0);
        unsigned nloc = b.st[0], nx = b.st[1];
        if (nloc == 0u) { xcd_barrier_complete(bar, b.x, nloc, nx); b.st[0] = nloc; b.st[1] = nx; }
        const unsigned old = xb_add(&bar[XB_XSUB(b.x)], 1u);
        const unsigned gen = old / nloc;
        if (old + 1u == (gen + 1u) * nloc) {
            __builtin_amdgcn_fence(__ATOMIC_RELEASE, "agent");
            asm volatile("s_waitcnt vmcnt(0)" ::: "memory");
            const unsigned og = xb_add(&bar[XB_TOP], 1u);
            const unsigned tg = og / nx;
            if (og + 1u == (tg + 1u) * nx) xb_add(&bar[XB_TOPGEN], 1u);
            else XB_SPIN(xb_ld(&bar[XB_TOPGEN]) == tg, bar);
            __builtin_amdgcn_fence(__ATOMIC_ACQUIRE, "agent");
            xb_add(&bar[XB_XGEN(b.x)], 1u);
            asm volatile("s_waitcnt vmcnt(0)" ::: "memory");
        } else {
            XB_SPIN(xb_ld(&bar[XB_XGEN(b.x)]) == gen, bar);
            __builtin_amdgcn_fence(__ATOMIC_ACQUIRE, "agent");
            asm volatile("s_waitcnt vmcnt(0)" ::: "memory");
        }
    }
    __syncthreads();
}

__global__ void __launch_bounds__(NTHREADS, 2) hymba_fwd(Args args) {
    extern __shared__ __attribute__((aligned(16))) unsigned char lds[];
    Frame F;
    F.lds = (LAS unsigned char*)lds; unsigned char* ws;
#define REFRESH_IDS() do { int t_ = threadIdx.x; asm volatile("" : "+v"(t_)); F.tid = t_; F.lane = t_ & 63; F.wave = __builtin_amdgcn_readfirstlane(t_ >> 6); \
        unsigned char* w_ = args.ws; const __attribute__((address_space(4))) char* k_ = (const __attribute__((address_space(4))) char*)__builtin_amdgcn_kernarg_segment_ptr(); float* o_ = args.out; asm volatile("" : "+s"(w_), "+s"(k_), "+s"(o_)); \
        F.ws = w_; F.ka = k_; F.out = o_; F.ctl = (GAS unsigned*)(w_ + WS_CTL); ws = w_; } while (0)
    REFRESH_IDS();
    F.G = gridDim.x; { const int bx = blockIdx.x; F.vcu = (F.G % 8 == 0) ? (bx % 8) * (F.G / 8) + bx / 8 : bx; }
    const int lo = args.ph_lo, hi = args.ph_hi;
#ifdef ONLY_PHASE
#define IN(k) ((k) == ONLY_PHASE && lo <= (k) && (k) < hi)
#else
#define IN(k) (lo <= (k) && (k) < hi)
#endif
    LAS int* tb = (LAS int*)(F.lds + MISC_OFF + 8192);
    LAS f32x2* rowtab = (LAS f32x2*)(F.lds + MISC_OFF + 4096);
    volatile LAS unsigned* bst = (volatile LAS unsigned*)(F.lds + MISC_OFF + 12288);
    if (F.tid < 2) bst[F.tid] = 0u;
    __syncthreads();
    XcdBarrier bar; bar.bar = (unsigned*)(F.ctl + CW_BAR); bar.x = 0; bar.st = bst;
    if (hi - lo > 1) bar = xcd_barrier_post((unsigned*)(F.ctl + CW_BAR), bst);
#define SEAM(k) do { if (IN(k) && IN((k) + 1)) xcd_barrier(bar); } while (0)

    for (int rep = 0; rep < 1 + ((REPEAT_MASK >> 0) & 1); ++rep) { if (rep) xcd_barrier(bar);
    if (IN(0)) { REFRESH_IDS(); p0_prologue(F); }
    }
    SEAM(0);
    for (int rep = 0; rep < 1 + ((REPEAT_MASK >> 1) & 1); ++rep) { if (rep) xcd_barrier(bar);
    if (IN(1)) {
        REFRESH_IDS();
        { pg8::DenseOrder S{(const char*)(ws + WS_XB), (const char*)(ws + WS_WIN), T / 256, INW / 256, DM, F.G, (int)blockIdx.x};
          EpiQKV E{(bf16_t*)(ws + WS_QKV), (const float*)(ws + WS_RS1), FIN(I_SWA_QN), FIN(I_SWA_KN), FIN(I_MOBA_QN), FIN(I_MOBA_KN), (float*)(ws + WS_KMP)};
          pg8::gemm_phase<EpiQKV, pg8::DenseOrder, true, false, false>(F.lds, DM, S, E); }
        { const int hg = F.G / 2; const bool second = (int)blockIdx.x >= hg;
          pg8::DenseOrder S{(const char*)(ws + WS_PB), (const char*)(ws + WS_WPP), T / 256, DM / 256, PLE, second ? hg : (1 << 30), second ? (int)blockIdx.x - hg : (1 << 30)};
          EpiProj E{(bf16_t*)(ws + WS_PRAW), (float*)(ws + WS_SSQP)};
          pg8::gemm_phase<EpiProj, pg8::DenseOrder, true, false, false>(F.lds, PLE, S, E); }
    }
    }
    SEAM(1);
    for (int rep = 0; rep < 1 + ((REPEAT_MASK >> 2) & 1); ++rep) { if (rep) xcd_barrier(bar);
    if (IN(2)) { REFRESH_IDS(); p2_attention(F); }
    }
    SEAM(2);
    for (int rep = 0; rep < 1 + ((REPEAT_MASK >> 3) & 1); ++rep) { if (rep) xcd_barrier(bar);
    if (IN(3)) {
        pg8::DenseOrder S{(const char*)(ws + WS_O), (const char*)(ws + WS_WOUT), T / 256, DM / 256, DM, F.G, (int)blockIdx.x};
        REFRESH_IDS();
        { pg8::Unit u0; if (S.next(0, u0) && F.tid < 256) {
              const f32x4* p = (const f32x4*)((const float*)(ws + WS_SSQ) + (size_t)(u0.pm * 256 + F.tid) * 16); const f32x4 a0 = p[0], a1 = p[1], b0 = p[2], b1 = p[3];
              const float qa = ((a0[0] + a0[1]) + (a0[2] + a0[3])) + ((a1[0] + a1[1]) + (a1[2] + a1[3])), qb = ((b0[0] + b0[1]) + (b0[2] + b0[3])) + ((b1[0] + b1[1]) + (b1[2] + b1[3]));
              rowtab[F.tid] = (f32x2){1.0f / sqrtf(qa * (1.0f / 512.f) + EPS), 1.0f / sqrtf(qb * (1.0f / 512.f) + EPS)}; }
          __syncthreads(); }
        EpiOut E{(bf16_t*)(ws + WS_X1B), (const LAS f32x2*)rowtab};
        pg8::gemm_phase<EpiOut, pg8::DenseOrder, false, false, true>(F.lds, DM, S, E);
    }
    }
    SEAM(3);
    if (IN(4)) { REFRESH_IDS(); p4_router(F); }
    SEAM(4);
    for (int rep = 0; rep < 1 + ((REPEAT_MASK >> 5) & 1); ++rep) { if (rep) xcd_barrier(bar);
    if (IN(5)) {
        REFRESH_IDS(); build_tile_table(F, tb);
        MoeOrder S{(const char*)(ws + WS_X1B), (const char*)(ws + WS_WGU), tb, (const unsigned*)(F.ctl + CW_CNT), (const unsigned*)(ws + WS_LIST), DM, (size_t)DM * DM * 2, (size_t)DM * 2, F.G, (int)blockIdx.x, true};
        EpiG1 E{(bf16_t*)(ws + WS_H), (const float*)(ws + WS_R2), (const unsigned*)(ws + WS_LIST)};
        pg8::gemm_phase<EpiG1, MoeOrder, true, true, false>(F.lds, DM, S, E);
        { REFRESH_IDS();
          const int nwg = tb[NEXP] * 4, G = F.G, c = (int)blockIdx.x;
          const int maxnu = (nwg + G - 1) / G, nu = (nwg - c + G - 1) / G;
          const int nfull = nwg - (maxnu - 1) * G;
          const bool all = (nfull >= G);
          const int W = all ? G : G - nfull, rank = all ? c : c - nfull;
          if (all || nu < maxnu) { LAS float* scr = (LAS float*)(F.lds + F.wave * 16384); tr_stream(F, scr, rank * NWAVES + F.wave, W * NWAVES, TI_DOWN, TI_DOWN_BASE); } }
    }
    }
    SEAM(5);
    for (int rep = 0; rep < 1 + ((REPEAT_MASK >> 6) & 1); ++rep) { if (rep) xcd_barrier(bar);
    if (IN(6)) {
        REFRESH_IDS(); build_tile_table(F, tb);
        MoeOrder S{(const char*)(ws + WS_H), (const char*)(ws + WS_WD), tb, (const unsigned*)(F.ctl + CW_CNT), (const unsigned*)(ws + WS_LIST), DEXP, (size_t)DM * DEXP * 2, (size_t)DEXP * 2, F.G, (int)blockIdx.x, false};
        EpiG2 E{(bf16_t*)(ws + WS_Y), (const unsigned*)(ws + WS_LIST)};
        pg8::gemm_phase<EpiG2, MoeOrder, true, false, false>(F.lds, DEXP, S, E);
    }
    }
    SEAM(6);
    if (IN(7)) { REFRESH_IDS(); p7_combine(F); }
    SEAM(7);
    if (IN(8)) {
        pg8::DenseOrder S{(const char*)(ws + WS_X2B), (const char*)(ws + WS_WPG), T / 256, DM / 256, DM, F.G, (int)blockIdx.x};
        REFRESH_IDS();
        { pg8::Unit u0; if (S.next(0, u0) && F.tid < 256) {
              const int row = u0.pm * 256 + F.tid; const f32x4* sp = (const f32x4*)((const float*)(ws + WS_SSQP) + (size_t)row * 16); const f32x4 s0 = sp[0], s1 = sp[1], s2 = sp[2], s3 = sp[3];
              const float q = (((s0[0] + s0[1]) + (s0[2] + s0[3])) + ((s1[0] + s1[1]) + (s1[2] + s1[3]))) + (((s2[0] + s2[1]) + (s2[2] + s2[3])) + ((s3[0] + s3[1]) + (s3[2] + s3[3])));
              rowtab[F.tid] = (f32x2){((const float*)(ws + WS_R3))[row], 1.0f / sqrtf(q * (1.0f / DM) + EPS)}; }
          __syncthreads(); }
        EpiFinal E{F.out, (const bf16_t*)(ws + WS_X2B), (const bf16_t*)(ws + WS_PRAW), FIN(I_PLE_ON), (const LAS f32x2*)rowtab};
        pg8::gemm_phase<EpiFinal, pg8::DenseOrder, false, false, false>(F.lds, DM, S, E);
    }
#undef IN
#undef SEAM
}

extern "C" void kernel_launch(void* const* d_in, const int* in_sizes, int n_in, void* d_out, int out_size, void* d_ws, size_t ws_size, hipStream_t stream) {
    static int grid = 0;
    if (grid == 0) {
        if (n_in != 25 || in_sizes[0] != T * DM || out_size != T * DM || ws_size < WS_END) { fprintf(stderr, "kernel_launch: unexpected shapes (n_in %d, in0 %d, out %d, ws %zu)\n", n_in, n_in > 0 ? in_sizes[0] : -1, out_size, ws_size); grid = -1; return; }
        int dev = 0, cus = 0, per_cu = 0;
        if (hipGetDevice(&dev) != hipSuccess || hipDeviceGetAttribute(&cus, hipDeviceAttributeMultiprocessorCount, dev) != hipSuccess) { grid = -1; return; }
        if (hipFuncSetAttribute((const void*)hymba_fwd, hipFuncAttributeMaxDynamicSharedMemorySize, LDS_BYTES) != hipSuccess) { fprintf(stderr, "kernel_launch: hipFuncSetAttribute failed\n"); grid = -1; return; }
        if (hipOccupancyMaxActiveBlocksPerMultiprocessor(&per_cu, (const void*)hymba_fwd, NTHREADS, LDS_BYTES) != hipSuccess || per_cu < 1) { fprintf(stderr, "kernel_launch: occupancy query says %d\n", per_cu); per_cu = 1; }
        (void)hipGetLastError();
        grid = cus;
        if (grid != 256) { fprintf(stderr, "kernel_launch: %d CUs; this kernel is built for 256 (one 256x256 tile per workgroup in the N=1024 GEMM phases)\n", grid); grid = -1; return; }
    }
    if (grid < 0) return;
    (void)hipMemsetAsync((char*)d_ws + WS_CTL, 0, CTL_ZERO_BYTES, stream);
    Args a{};
    for (int i = 0; i < 25; ++i) a.in[i] = (const float*)d_in[i];
    a.out = (float*)d_out; a.ws = (unsigned char*)d_ws;
    constexpr int NPH = 9;
    for (int li = 0; li < MK_N_LAUNCHES; ++li) {
        a.ph_lo = (MK_N_LAUNCHES == NPH) ? li : 0; a.ph_hi = (MK_N_LAUNCHES == NPH) ? li + 1 : NPH; a.li = li;
        hipLaunchKernelGGL(hymba_fwd, dim3(grid), dim3(NTHREADS), LDS_BYTES, stream, a);
    }
}
```

```cpp
#include <hip/hip_runtime.h>
#include <cstdio>
#include <cstdint>

#ifndef MK_N_LAUNCHES
#define MK_N_LAUNCHES 1
#endif

#ifndef REPEAT_MASK
#define REPEAT_MASK 0
#endif
#define LAS __attribute__((address_space(3)))
#define GAS __attribute__((address_space(1)))
typedef unsigned short bf16_t;
typedef short bf16x8 __attribute__((ext_vector_type(8)));
typedef float f32x4 __attribute__((ext_vector_type(4)));
typedef float f32x2 __attribute__((ext_vector_type(2)));
typedef unsigned u32x4 __attribute__((ext_vector_type(4)));
typedef unsigned u32x2 __attribute__((ext_vector_type(2)));

constexpr int BATCH = 8, SEQ = 2048, DM = 1024, T = BATCH * SEQ;
constexpr int INW = 1536, NHQ = 16, HD = 64;
constexpr int NEXP = 32, DEXP = 512, PLE = 256;
constexpr int MAXTILES = 160;
constexpr float EPS = 1e-6f;
constexpr float LOG2E = 1.4426950408889634f;
constexpr float QSCALE = 0.125f * LOG2E;
constexpr int NWAVES = 8, NTHREADS = 512;

constexpr int C_QA = 0, C_KA = 512, C_VA = 640, C_QB = 768, C_KB = 1280, C_VB = 1408;

constexpr size_t KiB = 1024, MiB = 1u << 20;
constexpr size_t WS_CTL = 0, CTL_ZERO_BYTES = 1 * MiB;
constexpr size_t WS_RS1 = 1 * MiB, WS_R2 = WS_RS1 + 64 * KiB, WS_R3 = WS_R2 + 64 * KiB, WS_KMP = WS_R3 + 64 * KiB;
constexpr size_t WS_WR = WS_KMP + 64 * KiB;
constexpr size_t WS_BIAS = WS_WR + 192 * KiB;
constexpr size_t WS_TOK = 1 * MiB + 512 * KiB;
constexpr size_t WS_SSQ = 2 * MiB;
constexpr size_t WS_SSQP = 3 * MiB;
constexpr size_t WS_LIST = 4 * MiB;
constexpr size_t WS_WIN = 8 * MiB, WS_WOUT = 11 * MiB, WS_WPG = 13 * MiB, WS_WPP = 15 * MiB;
constexpr size_t WS_WGU = 16 * MiB;
constexpr size_t WS_WD = 80 * MiB;
constexpr size_t WS_PRAW = 112 * MiB;
constexpr size_t WS_X1B = 144 * MiB;
constexpr size_t WS_X2B = WS_X1B;
constexpr size_t WS_H = 176 * MiB;
constexpr size_t WS_Y = 216 * MiB;
constexpr size_t WS_QKV = 176 * MiB;
constexpr size_t WS_O = 224 * MiB;
constexpr size_t WS_PB = 240 * MiB;
constexpr size_t WS_XB = WS_X1B;
constexpr size_t WS_END = 280 * MiB;
constexpr int CW_CNT = 64;
constexpr int CW_BAR = 4096;

constexpr int RING_BYTES = 131072;
constexpr int MISC_OFF = 147456;
constexpr int LDS_BYTES = 163840;

__device__ __forceinline__ unsigned f2bf(float f) { unsigned u = __builtin_bit_cast(unsigned, f); return (u + 0x7fffu + ((u >> 16) & 1u)) >> 16; }
__device__ __forceinline__ unsigned pk2(float lo, float hi) { return f2bf(lo) | (f2bf(hi) << 16); }
__device__ __forceinline__ float bf2f(unsigned short h) { return __builtin_bit_cast(float, (unsigned)h << 16); }
__device__ __forceinline__ float bflo(unsigned w) { return __builtin_bit_cast(float, w << 16); }
__device__ __forceinline__ float bfhi(unsigned w) { return __builtin_bit_cast(float, w & 0xffff0000u); }
__device__ __forceinline__ float wave_sum(float v) {
#pragma unroll
    for (int o = 1; o < 64; o <<= 1) v += __shfl_xor(v, o);
    return v;
}
__device__ __forceinline__ float wave_max(float v) {
#pragma unroll
    for (int o = 1; o < 64; o <<= 1) v = fmaxf(v, __shfl_xor(v, o));
    return v;
}
#define LDS_WAIT() asm volatile("s_waitcnt lgkmcnt(0)" ::: "memory")
#define VM_WAIT() asm volatile("s_waitcnt vmcnt(0)" ::: "memory")

namespace pg8 {
constexpr int BM = 256, BK = 64, HALF = 128, HTB = HALF * BK * 2, STAGE_BYTES = 8 * HTB, NXCD = 8, WGM = 8;
__host__ __device__ __forceinline__ int lds_byte(int r, int c) { const int st = (r >> 4) * 2 + (c >> 5), rr = r & 15, cc = c & 31, ob = rr * 64 + cc * 2; return st * 1024 + (ob ^ (((ob >> 9) & 1) << 5)); }
__host__ __device__ __forceinline__ void stage_rc(int b, int& R, int& C) { const int st = b / 1024, sb = b % 1024, swz = sb ^ (((sb >> 9) & 1) << 5); R = (st >> 1) * 16 + swz / 64; C = (st & 1) * 32 + (swz % 64) / 2; }
__host__ __device__ __forceinline__ int perm32(int rho) { const int n = rho >> 4, i = rho & 15; return 8 * (i >> 2) + 4 * n + (i & 3); }

struct Unit { const char* A; const char* B; int pm, pn, e, nvalid; };

__device__ __forceinline__ bool static_tile(int i, int G, int c, int nM, int nN, int& pm, int& pn) {
    const int nwg = nM * nN; const long L = (long)i * G + c; if (L >= nwg) return false;
    int wgid = (int)L; { const int q = nwg / NXCD, r = nwg % NXCD, xcd = wgid % NXCD, off = wgid / NXCD; wgid = (xcd < r ? xcd * (q + 1) : r * (q + 1) + (xcd - r) * q) + off; }
    const int nig = WGM * nN, gid = wgid / nig, fm = gid * WGM, gsz = (nM - fm) < WGM ? (nM - fm) : WGM;
    pm = fm + ((wgid % nig) % gsz); pn = (wgid % nig) / gsz; return true;
}
struct DenseOrder {
    const char* A; const char* Bt; int nM, nN, K, G, c;
    __device__ __forceinline__ bool next(int i, Unit& u) const {
        int pm, pn; if (!static_tile(i, G, c, nM, nN, pm, pn)) return false;
        u.pm = pm; u.pn = pn; u.e = 0; u.nvalid = 256; u.A = A + (size_t)pm * 256 * K * 2; u.B = Bt + (size_t)pn * 256 * K * 2; return true;
    }
    __device__ __forceinline__ unsigned row_off(const Unit&, int) const { return 0u; }
};

__device__ __forceinline__ unsigned cvt_pk_bf16(float lo, float hi) { unsigned r; asm volatile("v_cvt_pk_bf16_f32 %0, %1, %2" : "=v"(r) : "v"(lo), "v"(hi)); return r; }

template <class Epi, class Sched, bool ALIGN_EPI, bool GATHER, bool MID>
__device__ __forceinline__ void gemm_phase(LAS unsigned char* lds, const int K, const Sched& S, const Epi& E) {
    int tid_ = threadIdx.x; asm volatile("" : "+v"(tid_));
    const int tid = tid_, wid = __builtin_amdgcn_readfirstlane(tid >> 6), lane = tid & 63, wr = wid >> 2, wc = wid & 3, fr = lane & 15, fq = lane >> 4;
    const int nt = K / BK;
    int Rst[2], Cst[2]; unsigned voffB[2];
#pragma unroll
    for (int i = 0; i < 2; ++i) { int R, C; stage_rc(tid * 16 + i * 8192, R, C); Rst[i] = R; Cst[i] = C; const int Rb = Epi::PERM ? ((R & ~31) + perm32(R & 31)) : R; voffB[i] = (unsigned)(Rb * K + C) * 2u; }
    const size_t kstep = (size_t)(BK * 2);
    const size_t hstep = (size_t)HALF * K * 2;
    const unsigned ldsw = (unsigned)wid * 1024u;
    const int aoff = lds_byte(wr * 64 + fr, fq * 8), boff = lds_byte(wc * 32 + fr, fq * 8);
#define PG8_SA(b, h) (((b) * 2 + (h)) * HTB)
#define PG8_SB(b, h) ((4 + (b) * 2 + (h)) * HTB)
#define PG8_STAGE(bufoff, gbase, voff) do { _Pragma("unroll") for (int _i = 0; _i < 2; ++_i) \
        __builtin_amdgcn_global_load_lds((const unsigned*)((const char*)(gbase) + (voff)[_i]), (LAS unsigned*)(lds + (bufoff) + ldsw + _i * 8192), 16, 0, 0); } while (0)
#define PG8_LDA(dst, b, h) do { _Pragma("unroll") for (int m = 0; m < 4; ++m) _Pragma("unroll") for (int k = 0; k < 2; ++k) dst[m][k] = *(const LAS bf16x8*)(lds + PG8_SA(b, h) + aoff + m * 2048 + k * 1024); } while (0)
#define PG8_LDB(dst, b, h) do { _Pragma("unroll") for (int n = 0; n < 2; ++n) _Pragma("unroll") for (int k = 0; k < 2; ++k) dst[n][k] = *(const LAS bf16x8*)(lds + PG8_SB(b, h) + boff + n * 2048 + k * 1024); } while (0)
#define PG8_MMA(ai, bj, At, Bt) do { __builtin_amdgcn_s_setprio(1); _Pragma("unroll") for (int m = 0; m < 4; ++m) _Pragma("unroll") for (int n = 0; n < 2; ++n) _Pragma("unroll") for (int k = 0; k < 2; ++k) \
        acc[ai][bj][m][n] = __builtin_amdgcn_mfma_f32_16x16x32_bf16(Bt[n][k], At[m][k], acc[ai][bj][m][n], 0, 0, 0); __builtin_amdgcn_s_setprio(0); } while (0)
#define PG8_WAIT_V(n) asm volatile("s_waitcnt vmcnt(" #n ")" ::: "memory")
#define PG8_WAIT_L(n) asm volatile("s_waitcnt lgkmcnt(" #n ")" ::: "memory")
#define PG8_BAR __builtin_amdgcn_s_barrier()
#define PG8_SCHED __builtin_amdgcn_sched_barrier(0)
#define PG8_AOFFS(dst, u) do { _Pragma("unroll") for (int _h = 0; _h < 2; ++_h) _Pragma("unroll") for (int _i = 0; _i < 2; ++_i) { \
        if constexpr (GATHER) dst[_h][_i] = S.row_off(u, _h * HALF + Rst[_i]) + (unsigned)Cst[_i] * 2u; \
        else dst[_h][_i] = (unsigned)((_h * HALF + Rst[_i]) * K + Cst[_i]) * 2u; } \
        if constexpr (GATHER) { asm volatile("" : "+v"(dst[0][0]), "+v"(dst[0][1]), "+v"(dst[1][0]), "+v"(dst[1][1]) :: "memory"); } } while (0)
    Unit cur, nxt; int ui = 0;
    if (!S.next(0, cur)) return;
    bool has_next = S.next(1, nxt);
    unsigned vA[2][2], vN[2][2];
    PG8_AOFFS(vA, cur);
    if constexpr (GATHER) { if (has_next) { PG8_AOFFS(vN, nxt); } else {
#pragma unroll
        for (int h = 0; h < 2; ++h) { vN[h][0] = vA[h][0]; vN[h][1] = vA[h][1]; } } }
    f32x4 acc[2][2][4][2];
#pragma unroll
    for (int a = 0; a < 2; ++a)
#pragma unroll
        for (int b = 0; b < 2; ++b)
#pragma unroll
            for (int m = 0; m < 4; ++m)
#pragma unroll
                for (int n = 0; n < 2; ++n) acc[a][b][m][n] = (f32x4){0.f, 0.f, 0.f, 0.f};
    bf16x8 At[4][2], B0[2][2], B1[2][2];
    const char* cA = cur.A; const char* cB = cur.B;
    PG8_STAGE(PG8_SB(0, 0), cB, voffB); PG8_STAGE(PG8_SB(0, 1), cB + hstep, voffB); PG8_STAGE(PG8_SA(0, 0), cA, vA[0]); PG8_STAGE(PG8_SA(0, 1), cA, vA[1]);
    if (wr == 1) PG8_BAR;
    PG8_WAIT_V(2); PG8_BAR;
    PG8_STAGE(PG8_SB(1, 0), cB + kstep, voffB); PG8_STAGE(PG8_SA(1, 0), cA + kstep, vA[0]); PG8_STAGE(PG8_SB(1, 1), cB + hstep + kstep, voffB);
    PG8_WAIT_V(6); PG8_BAR;
    for (;;) {
        const char* nA = has_next ? nxt.A : cA; const char* nB = has_next ? nxt.B : cB;
#pragma unroll 1
        for (int t = 0; t < nt; t += 2) {
            const bool last = (t == nt - 2);
            if constexpr (MID) { if (t == nt / 2) { int frE = fr, fqE = fq; asm volatile("" : "+v"(frE), "+v"(fqE)); E.mid(acc, cur, wr, wc, frE, fqE); } }
            const char* a1 = cA + (size_t)(t + 1) * kstep;
            const char* a2 = last ? nA : cA + (size_t)(t + 2) * kstep; const char* b2 = last ? nB : cB + (size_t)(t + 2) * kstep;
            const char* a3 = a2 + kstep; const char* b3 = b2 + kstep;
            unsigned v2[2][2];
#pragma unroll
            for (int h = 0; h < 2; ++h) { if constexpr (GATHER) { v2[h][0] = last ? vN[h][0] : vA[h][0]; v2[h][1] = last ? vN[h][1] : vA[h][1]; } else { v2[h][0] = vA[h][0]; v2[h][1] = vA[h][1]; } }
            PG8_LDB(B0, 0, 0); PG8_LDB(B1, 0, 1); PG8_SCHED; PG8_LDA(At, 0, 0); PG8_STAGE(PG8_SA(1, 1), a1, vA[1]);
            PG8_WAIT_V(8); PG8_WAIT_L(0); PG8_BAR; PG8_MMA(0, 0, At, B0); PG8_MMA(0, 1, At, B1); PG8_BAR; PG8_SCHED;
            PG8_LDA(At, 0, 1); PG8_STAGE(PG8_SB(0, 0), b2, voffB); PG8_STAGE(PG8_SB(0, 1), b2 + hstep, voffB); PG8_STAGE(PG8_SA(0, 0), a2, v2[0]);
            PG8_WAIT_V(8); PG8_WAIT_L(0); PG8_BAR; PG8_MMA(1, 0, At, B0); PG8_MMA(1, 1, At, B1); PG8_BAR; PG8_SCHED;
            PG8_LDB(B0, 1, 0); PG8_LDB(B1, 1, 1); PG8_SCHED; PG8_LDA(At, 1, 0); PG8_STAGE(PG8_SA(0, 1), a2, v2[1]);
            PG8_WAIT_V(8); PG8_WAIT_L(0); PG8_BAR; PG8_MMA(0, 0, At, B0); PG8_MMA(0, 1, At, B1); PG8_BAR; PG8_SCHED;
            PG8_LDA(At, 1, 1); PG8_STAGE(PG8_SB(1, 0), b3, voffB); PG8_STAGE(PG8_SB(1, 1), b3 + hstep, voffB); PG8_STAGE(PG8_SA(1, 0), a3, v2[0]);
            PG8_WAIT_V(8); PG8_WAIT_L(0); PG8_BAR; PG8_MMA(1, 0, At, B0); PG8_MMA(1, 1, At, B1); PG8_BAR; PG8_SCHED;
        }
        if constexpr (ALIGN_EPI) { if (wr == 0) PG8_BAR; }
        { int frE = fr, fqE = fq; asm volatile("" : "+v"(frE), "+v"(fqE));
          E(acc, cur, wr, wc, frE, fqE); }
        if (!has_next) break;
#pragma unroll
        for (int a = 0; a < 2; ++a)
#pragma unroll
            for (int b = 0; b < 2; ++b)
#pragma unroll
                for (int m = 0; m < 4; ++m)
#pragma unroll
                    for (int n = 0; n < 2; ++n) acc[a][b][m][n] = (f32x4){0.f, 0.f, 0.f, 0.f};
        cur = nxt; cA = nA; cB = nB; ++ui;
        if constexpr (GATHER) {
#pragma unroll
            for (int h = 0; h < 2; ++h) { vA[h][0] = vN[h][0]; vA[h][1] = vN[h][1]; } }
        has_next = S.next(ui + 1, nxt);
        if constexpr (GATHER) { if (has_next) { PG8_AOFFS(vN, nxt); } }
        if constexpr (ALIGN_EPI) { if (wr == 1) PG8_BAR; }
    }
    PG8_WAIT_V(0);
    if constexpr (!ALIGN_EPI) { if (wr == 0) PG8_BAR; }
    PG8_BAR;
#undef PG8_SA
#undef PG8_SB
#undef PG8_STAGE
#undef PG8_LDA
#undef PG8_LDB
#undef PG8_MMA
#undef PG8_WAIT_V
#undef PG8_WAIT_L
#undef PG8_BAR
#undef PG8_SCHED
#undef PG8_AOFFS
}
}

struct Args { const float* in[25]; float* out; unsigned char* ws; int ph_lo, ph_hi, li, pad; };
struct Frame {
    LAS unsigned char* lds; unsigned char* ws; GAS unsigned* ctl;
    int tid, lane, wave, vcu, G;
    float* out; const __attribute__((address_space(4))) char* ka;
};
#define FIN(i) (((const float* const __attribute__((address_space(4)))*)F.ka)[i])
enum { I_X = 0, I_P, I_RELB, I_ATTN_NORM, I_W_IN, I_SWA_QN, I_SWA_KN, I_SINKS, I_MOBA_QN, I_MOBA_KN, I_SWA_ON, I_MOBA_ON, I_W_OUT, I_FFN_NORM,
       I_W_RG, I_B_RG, I_W_RE, I_B_RE, I_W_EG, I_W_EU, I_W_ED, I_PLE_NORM, I_W_PG, I_W_PP, I_PLE_ON };

struct TrItem { const float* src; bf16_t* dst; const float* gk; int N, K; };
__device__ __forceinline__ int map_in(int n0) { const int head = n0 >> 6, d = n0 & 63; return 256 * (head >> 2) + 128 * (d >> 5) + 32 * (head & 3) + (d & 31); }
__device__ __forceinline__ int map_gu(int n0, int up) { return 256 * (n0 >> 7) + 128 * up + (n0 & 127); }
constexpr int TI_IN = (DM / 64) * (INW / 32), TI_OUT = (DM / 64) * (DM / 32), TI_PG = TI_OUT, TI_PP = (PLE / 64) * (DM / 32);
constexpr int TI_G1 = (DM / 64) * (DEXP / 32), TI_D1 = (DEXP / 64) * (DM / 32);
constexpr int TI_TOTAL = TI_IN + TI_OUT + TI_PG + TI_PP + NEXP * (2 * TI_G1);
constexpr int TI_DOWN_BASE = 1 << 20, TI_DOWN = NEXP * TI_D1;
__device__ __forceinline__ void tr_decode(const Frame& F, int it, TrItem& d) {
    unsigned char* ws = F.ws;
    const float* W; bf16_t* WT; const float* g = nullptr; int K, N, mode = 0, up = 0; int r = it;
    if (it >= TI_DOWN_BASE) r = 1 << 28;
    if (r < TI_IN) { W = FIN(I_W_IN); WT = (bf16_t*)(ws + WS_WIN); K = DM; N = INW; g = FIN(I_ATTN_NORM); mode = 1; }
    else if ((r -= TI_IN) < TI_OUT) { W = FIN(I_W_OUT); WT = (bf16_t*)(ws + WS_WOUT); K = DM; N = DM; mode = 3; }
    else if ((r -= TI_OUT) < TI_PG) { W = FIN(I_W_PG); WT = (bf16_t*)(ws + WS_WPG); K = DM; N = DM; g = FIN(I_PLE_NORM); }
    else if ((r -= TI_PG) < TI_PP) { W = FIN(I_W_PP); WT = (bf16_t*)(ws + WS_WPP); K = PLE; N = DM; }
    else if (it >= TI_DOWN_BASE) { r = it - TI_DOWN_BASE; const int e = r / TI_D1; r -= e * TI_D1; W = FIN(I_W_ED) + (size_t)e * DEXP * DM; WT = (bf16_t*)(ws + WS_WD) + (size_t)e * DM * DEXP; K = DEXP; N = DM; }
    else { r -= TI_PP; const int e = r / (2 * TI_G1); r -= e * (2 * TI_G1);
        if (r < TI_G1) { W = FIN(I_W_EG) + (size_t)e * DM * DEXP; WT = (bf16_t*)(ws + WS_WGU) + (size_t)e * DM * DM; K = DM; N = DEXP; g = FIN(I_FFN_NORM); mode = 2; up = 0; }
        else { r -= TI_G1; W = FIN(I_W_EU) + (size_t)e * DM * DEXP; WT = (bf16_t*)(ws + WS_WGU) + (size_t)e * DM * DM; K = DM; N = DEXP; g = FIN(I_FFN_NORM); mode = 2; up = 1; } }
    const int nblk = N / 32, kb = r / nblk, nb = r % nblk, k0 = 64 * kb, n0 = 32 * nb;
    if (mode == 3) g = (k0 < 512) ? FIN(I_SWA_ON) : (FIN(I_MOBA_ON) - 512);
    const int drow0 = mode == 1 ? map_in(n0) : mode == 2 ? map_gu(n0, up) : n0;
    d.src = W + (size_t)k0 * N + n0; d.dst = WT + (size_t)drow0 * K + k0; d.gk = g ? g + k0 : nullptr; d.N = N; d.K = K;
}
__device__ __forceinline__ void tr_load(const TrItem& d, int lane, float (&v)[32], f32x4 (&gv)[2]) {
    const float* p = d.src + (size_t)(lane >> 5) * d.N + (lane & 31);
#pragma unroll
    for (int i = 0; i < 32; ++i) v[i] = p[(size_t)(2 * i) * d.N];
    const int c = lane & 7;
    if (d.gk) { gv[0] = *(const f32x4*)(d.gk + 8 * c); gv[1] = *(const f32x4*)(d.gk + 8 * c + 4); } else { gv[0] = (f32x4){1.f, 1.f, 1.f, 1.f}; gv[1] = gv[0]; }
}
__device__ __forceinline__ void tr_process(const TrItem& d, int lane, const float (&v)[32], const f32x4 (&gv)[2], LAS float* scr) {
#pragma unroll
    for (int i = 0; i < 32; ++i) scr[(2 * i + (lane >> 5)) * 33 + (lane & 31)] = v[i];
    LDS_WAIT(); asm volatile("" ::: "memory");
    const int c = lane & 7;
#pragma unroll
    for (int j = 0; j < 4; ++j) { const int n = (lane >> 3) + 8 * j; const LAS float* sp = scr + (8 * c) * 33 + n;
        u32x4 o; o.x = pk2(sp[0 * 33] * gv[0][0], sp[1 * 33] * gv[0][1]); o.y = pk2(sp[2 * 33] * gv[0][2], sp[3 * 33] * gv[0][3]); o.z = pk2(sp[4 * 33] * gv[1][0], sp[5 * 33] * gv[1][1]); o.w = pk2(sp[6 * 33] * gv[1][2], sp[7 * 33] * gv[1][3]);
        *(GAS u32x4*)(d.dst + (size_t)n * d.K + 8 * c) = o; }
    LDS_WAIT(); asm volatile("" ::: "memory");
}

__constant__ unsigned char c_bucket[128] = {0,1,2,3,4,5,6,7,8,9,10,11,12,13,14,15,16,16,16,17,17,18,18,18,19,19,19,20,20,20,20,21,21,21,21,22,22,22,22,22,23,23,23,23,23,23,24,24,24,24,24,24,25,25,25,25,25,25,25,26,26,26,26,26,26,26,26,27,27,27,27,27,27,27,27,27,27,28,28,28,28,28,28,28,28,28,28,29,29,29,29,29,29,29,29,29,29,29,29,30,30,30,30,30,30,30,30,30,30,30,30,30,30,31,31,31,31,31,31,31,31,31,31,31,31,31,31,31};

__device__ __forceinline__ void tr_stream(Frame& F, LAS float* scr, int first, int step, int count, int base) {
    TrItem cur, nxt; float v[32], vn[32]; f32x4 gv[2], gn[2];
    int it = first; bool have = it < count;
    if (have) { tr_decode(F, base + it, cur); tr_load(cur, F.lane, v, gv); }
    while (have) {
        const int itn = it + step; const bool hn = itn < count;
        if (hn) { tr_decode(F, base + itn, nxt); tr_load(nxt, F.lane, vn, gn); }
        tr_process(cur, F.lane, v, gv, scr);
        cur = nxt; gv[0] = gn[0]; gv[1] = gn[1];
#pragma unroll
        for (int i = 0; i < 32; ++i) v[i] = vn[i];
        it = itn; have = hn;
    }
}
__device__ __forceinline__ void p0_prologue(Frame& F) {
    LAS float* scr = (LAS float*)(F.lds + F.wave * 16384);
    const int gw = F.vcu * NWAVES + F.wave, NGW = F.G * NWAVES;
    tr_stream(F, scr, gw, NGW, TI_TOTAL, 0);
    const float* x = FIN(I_X); bf16_t* xb = (bf16_t*)(F.ws + WS_XB); float* rs1 = (float*)(F.ws + WS_RS1);
    for (int m = gw; m < T; m += 2 * NGW) {
        const int m2 = m + NGW; const bool h2 = m2 < T;
        const GAS f32x4* xr = (const GAS f32x4*)(x + (size_t)m * DM) + F.lane; const GAS f32x4* xr2 = (const GAS f32x4*)(x + (size_t)(h2 ? m2 : m) * DM) + F.lane;
        f32x4 v[4], u[4]; float s = 0.f, s2 = 0.f;
#pragma unroll
        for (int j = 0; j < 4; ++j) { v[j] = xr[64 * j]; u[j] = xr2[64 * j]; }
#pragma unroll
        for (int j = 0; j < 4; ++j) { s += (v[j].x * v[j].x + v[j].y * v[j].y) + (v[j].z * v[j].z + v[j].w * v[j].w); s2 += (u[j].x * u[j].x + u[j].y * u[j].y) + (u[j].z * u[j].z + u[j].w * u[j].w); }
        s = wave_sum(s); s2 = wave_sum(s2);
        GAS u32x2* o8 = (GAS u32x2*)(xb + (size_t)m * DM) + F.lane;
#pragma unroll
        for (int j = 0; j < 4; ++j) { u32x2 w; w.x = pk2(v[j].x, v[j].y); w.y = pk2(v[j].z, v[j].w); o8[64 * j] = w; }
        if (F.lane == 0) rs1[m] = 1.0f / sqrtf(s * (1.0f / DM) + EPS);
        if (h2) { GAS u32x2* o9 = (GAS u32x2*)(xb + (size_t)m2 * DM) + F.lane;
#pragma unroll
            for (int j = 0; j < 4; ++j) { u32x2 w; w.x = pk2(u[j].x, u[j].y); w.y = pk2(u[j].z, u[j].w); o9[64 * j] = w; }
            if (F.lane == 0) rs1[m2] = 1.0f / sqrtf(s2 * (1.0f / DM) + EPS); }
    }
    { const GAS f32x4* p4 = (const GAS f32x4*)FIN(I_P); GAS u32x2* o = (GAS u32x2*)(F.ws + WS_PB); const int n4 = T * PLE / 4;
      for (int i = (F.vcu * NTHREADS + F.tid); i < n4; i += F.G * NTHREADS) { const f32x4 v = p4[i]; u32x2 w; w.x = pk2(v.x, v.y); w.y = pk2(v.z, v.w); o[i] = w; } }
    { bf16_t* Wt = (bf16_t*)(F.ws + WS_WR); const float* g = FIN(I_FFN_NORM); const float* wrg = FIN(I_W_RG); const float* wre = FIN(I_W_RE);
      for (int i = (F.vcu * NTHREADS + F.tid); i < 96 * DM; i += F.G * NTHREADS) { const int n = i / DM, c = i % DM; int o = -1; bool lo = false;
          if (n < 32) o = n; else if (n < 64) { o = n - 32; lo = true; } else if (n < 68) o = 32 + (n - 64); else if (n < 72) { o = 32 + (n - 68); lo = true; }
          unsigned short r = 0;
          if (o >= 0) { const float w = g[c] * ((o < 4) ? wrg[c * 4 + o] : wre[c * 32 + (o - 4)]); const unsigned h = f2bf(w); r = (unsigned short)h;
              if (lo) r = (unsigned short)f2bf(w - bf2f((unsigned short)h)); }
          Wt[i] = r; } }
    { float* tab = (float*)(F.ws + WS_BIAS);
      for (int i = (F.vcu * NTHREADS + F.tid); i < 16 * 132; i += F.G * NTHREADS) { const int hh = i / 132, dd = i % 132; const int bk = dd < 128 ? (int)c_bucket[dd] : 31;
          tab[i] = FIN(I_RELB)[bk * NHQ + hh] * LOG2E; } }
}

using pg8::Unit;
struct EpiQKV {
    static constexpr bool PERM = true;
    bf16_t* qkv; const float* rs1; const float* gq_a; const float* gk_a; const float* gq_b; const float* gk_b; float* kmp;
    __device__ __forceinline__ void operator()(const f32x4 (&acc)[2][2][4][2], const Unit& u, int wr, int wc, int fr, int fq) const {
        const int head = 4 * u.pn + wc;
        const float* gain = nullptr; float qs = 1.f; bool kmean = false;
        if (head < 8) { gain = gq_a; qs = QSCALE; } else if (head < 10) { gain = gk_a; } else if (head < 12) {} else if (head < 20) { gain = gq_b; qs = QSCALE; } else if (head < 22) { gain = gk_b; kmean = true; }
        f32x4 gv[2][2];
#pragma unroll
        for (int bj = 0; bj < 2; ++bj)
#pragma unroll
            for (int n = 0; n < 2; ++n) { if (gain) { gv[bj][n] = *(const f32x4*)(gain + 32 * bj + 8 * fq + 4 * n) * qs; } else gv[bj][n] = (f32x4){1.f, 1.f, 1.f, 1.f}; }
        f32x4 ks[2][2];
#pragma unroll
        for (int bj = 0; bj < 2; ++bj)
#pragma unroll
            for (int n = 0; n < 2; ++n) ks[bj][n] = (f32x4){0.f, 0.f, 0.f, 0.f};
        float rsv[2][4];
#pragma unroll
        for (int ai = 0; ai < 2; ++ai)
#pragma unroll
            for (int m = 0; m < 4; ++m) rsv[ai][m] = rs1[u.pm * 256 + ai * 128 + wr * 64 + m * 16 + fr];
        asm volatile("" ::: "memory");
#pragma unroll
        for (int ai = 0; ai < 2; ++ai)
#pragma unroll
            for (int m = 0; m < 4; ++m) {
                const int row = u.pm * 256 + ai * 128 + wr * 64 + m * 16 + fr; const float rs = rsv[ai][m];
                f32x4 v[2][2]; float ss = 0.f;
#pragma unroll
                for (int bj = 0; bj < 2; ++bj)
#pragma unroll
                    for (int n = 0; n < 2; ++n) { v[bj][n] = acc[ai][bj][m][n] * rs; const f32x4 q = v[bj][n] * v[bj][n]; ss += (q[0] + q[1]) + (q[2] + q[3]); }
                float rn = 1.f;
                if (gain) { ss += __shfl_xor(ss, 16); ss += __shfl_xor(ss, 32); rn = 1.0f / sqrtf(ss * (1.0f / HD) + EPS); }
                bf16_t* rowp = qkv + (size_t)row * INW + 64 * head + 8 * fq;
#pragma unroll
                for (int bj = 0; bj < 2; ++bj) { const f32x4 v0 = v[bj][0] * rn * gv[bj][0], v1 = v[bj][1] * rn * gv[bj][1];
                    if (kmean) { ks[bj][0] += v0; ks[bj][1] += v1; }
                    u32x4 w; w.x = pg8::cvt_pk_bf16(v0[0], v0[1]); w.y = pg8::cvt_pk_bf16(v0[2], v0[3]); w.z = pg8::cvt_pk_bf16(v1[0], v1[1]); w.w = pg8::cvt_pk_bf16(v1[2], v1[3]);
                    *(u32x4*)(rowp + 32 * bj) = w; }
            }
        if (kmean) {
#pragma unroll
            for (int bj = 0; bj < 2; ++bj)
#pragma unroll
                for (int n = 0; n < 2; ++n)
#pragma unroll
                    for (int i = 0; i < 4; ++i) { float s = ks[bj][n][i]; s += __shfl_xor(s, 1); s += __shfl_xor(s, 2); s += __shfl_xor(s, 4); s += __shfl_xor(s, 8);
                        if (fr == 0) kmp[((u.pm * 2 + wr) * 2 + (head - 20)) * 64 + 32 * bj + 8 * fq + 4 * n + i] = s; }
        }
    }
};
struct EpiProj {
    static constexpr bool PERM = true;
    bf16_t* praw; float* ssqp;
    __device__ __forceinline__ void operator()(const f32x4 (&acc)[2][2][4][2], const Unit& u, int wr, int wc, int fr, int fq) const {
#pragma unroll
        for (int ai = 0; ai < 2; ++ai)
#pragma unroll
            for (int m = 0; m < 4; ++m) {
                const int row = u.pm * 256 + ai * 128 + wr * 64 + m * 16 + fr; float ss = 0.f;
                bf16_t* rowp = praw + (size_t)row * DM + u.pn * 256 + wc * 32 + 8 * fq;
#pragma unroll
                for (int bj = 0; bj < 2; ++bj) { const f32x4 v0 = acc[ai][bj][m][0], v1 = acc[ai][bj][m][1];
                    const f32x4 q = v0 * v0 + v1 * v1; ss += (q[0] + q[1]) + (q[2] + q[3]);
                    u32x4 w; w.x = pg8::cvt_pk_bf16(v0[0], v0[1]); w.y = pg8::cvt_pk_bf16(v0[2], v0[3]); w.z = pg8::cvt_pk_bf16(v1[0], v1[1]); w.w = pg8::cvt_pk_bf16(v1[2], v1[3]);
                    *(u32x4*)(rowp + 128 * bj) = w; }
                ss += __shfl_xor(ss, 16); ss += __shfl_xor(ss, 32);
                if (fq == 0) ssqp[(size_t)row * 16 + u.pn * 4 + wc] = ss;
            }
    }
};
struct EpiOut {
    static constexpr bool PERM = true;
    bf16_t* x1b; const LAS f32x2* tab;
    __device__ __forceinline__ void mid(f32x4 (&acc)[2][2][4][2], const Unit& u, int wr, int wc, int fr, int fq) const {
#pragma unroll
        for (int ai = 0; ai < 2; ++ai)
#pragma unroll
            for (int m = 0; m < 4; ++m) { const f32x2 sc = tab[ai * 128 + wr * 64 + m * 16 + fr]; const float r = sc.x / sc.y;
#pragma unroll
                for (int bj = 0; bj < 2; ++bj)
#pragma unroll
                    for (int n = 0; n < 2; ++n) acc[ai][bj][m][n] *= r; }
    }
    __device__ __forceinline__ void operator()(const f32x4 (&acc)[2][2][4][2], const Unit& u, int wr, int wc, int fr, int fq) const {
        const int col0 = u.pn * 256 + wc * 32 + 8 * fq;
#pragma unroll
        for (int ai = 0; ai < 2; ++ai) {
            u32x4 xv[4][2];
#pragma unroll
            for (int m = 0; m < 4; ++m) { const size_t off = (size_t)(u.pm * 256 + ai * 128 + wr * 64 + m * 16 + fr) * DM + col0;
#pragma unroll
                for (int bj = 0; bj < 2; ++bj) xv[m][bj] = *(const u32x4*)(x1b + off + bj * 128); }
            asm volatile("" ::: "memory");
#pragma unroll
            for (int m = 0; m < 4; ++m) { const int r = ai * 128 + wr * 64 + m * 16 + fr; const float sb = tab[r].y; const size_t off = (size_t)(u.pm * 256 + r) * DM + col0;
#pragma unroll
                for (int bj = 0; bj < 2; ++bj) { const u32x4 xw = xv[m][bj];
                    const f32x4 o0 = (f32x4){bflo(xw.x), bfhi(xw.x), bflo(xw.y), bfhi(xw.y)} + acc[ai][bj][m][0] * sb, o1 = (f32x4){bflo(xw.z), bfhi(xw.z), bflo(xw.w), bfhi(xw.w)} + acc[ai][bj][m][1] * sb;
                    u32x4 w; w.x = pg8::cvt_pk_bf16(o0[0], o0[1]); w.y = pg8::cvt_pk_bf16(o0[2], o0[3]); w.z = pg8::cvt_pk_bf16(o1[0], o1[1]); w.w = pg8::cvt_pk_bf16(o1[2], o1[3]);
                    *(u32x4*)(x1b + off + bj * 128) = w; } }
            asm volatile("" ::: "memory");
        }
    }
};
struct MoeOrder {
    const char* A; const char* Bt; const LAS int* tb; const unsigned* cnt; const unsigned* list; int K; size_t wstride; size_t arow_bytes; int G, c; bool gather;
    __device__ __forceinline__ bool next(int i, Unit& u) const {
        const int NT = tb[NEXP]; const int nwg = NT * 4; const long L = (long)i * G + c; if (L >= nwg) return false;
        int wgid = (int)L; { const int q = nwg / 8, r = nwg % 8, xcd = wgid % 8, off = wgid / 8; wgid = (xcd < r ? xcd * (q + 1) : r * (q + 1) + (xcd - r) * q) + off; }
        const int gt = wgid >> 2, pn = wgid & 3; int e = 0;
#pragma unroll 1
        while (e < NEXP - 1 && gt >= tb[e + 1]) ++e;
        const int lt = gt - tb[e]; const int nv = (int)cnt[e] - lt * 256;
        u.pm = gt; u.pn = pn; u.e = e * 16384 + lt * 256; u.nvalid = nv < 256 ? nv : 256;
        u.A = gather ? A : A + (size_t)gt * 256 * arow_bytes; u.B = Bt + (size_t)e * wstride + (size_t)pn * 256 * K * 2; return true;
    }
    __device__ __forceinline__ unsigned row_off(const Unit& u, int r) const {
        const unsigned ent = (r < u.nvalid) ? list[u.e + r] : 0u; return (ent >> 1) * (unsigned)arow_bytes;
    }
};
struct EpiG1 {
    static constexpr bool PERM = true;
    bf16_t* H; const float* r2; const unsigned* list;
    __device__ __forceinline__ void operator()(const f32x4 (&acc)[2][2][4][2], const Unit& u, int wr, int wc, int fr, int fq) const {
        unsigned entv[2][4]; float rsv[2][4];
#pragma unroll
        for (int ai = 0; ai < 2; ++ai)
#pragma unroll
            for (int m = 0; m < 4; ++m) { const int r = ai * 128 + wr * 64 + m * 16 + fr; entv[ai][m] = (r < u.nvalid) ? list[u.e + r] : 0u; }
#pragma unroll
        for (int ai = 0; ai < 2; ++ai)
#pragma unroll
            for (int m = 0; m < 4; ++m) rsv[ai][m] = r2[entv[ai][m] >> 1];
        asm volatile("" ::: "memory");
#pragma unroll
        for (int ai = 0; ai < 2; ++ai)
#pragma unroll
            for (int m = 0; m < 4; ++m) { const int r = ai * 128 + wr * 64 + m * 16 + fr; const float rs = rsv[ai][m];
                float h[8];
#pragma unroll
                for (int n = 0; n < 2; ++n)
#pragma unroll
                    for (int i = 0; i < 4; ++i) { const float g = acc[ai][0][m][n][i] * rs, up = acc[ai][1][m][n][i] * rs; h[4 * n + i] = g / (1.0f + __builtin_amdgcn_exp2f(-g * LOG2E)) * up; }
                u32x4 w; w.x = pg8::cvt_pk_bf16(h[0], h[1]); w.y = pg8::cvt_pk_bf16(h[2], h[3]); w.z = pg8::cvt_pk_bf16(h[4], h[5]); w.w = pg8::cvt_pk_bf16(h[6], h[7]);
                *(u32x4*)(H + (size_t)(u.pm * 256 + r) * DEXP + u.pn * 128 + wc * 32 + 8 * fq) = w; }
    }
};
struct EpiG2 {
    static constexpr bool PERM = true;
    bf16_t* Y; const unsigned* list;
    __device__ __forceinline__ void operator()(const f32x4 (&acc)[2][2][4][2], const Unit& u, int wr, int wc, int fr, int fq) const {
        unsigned entv[2][4];
#pragma unroll
        for (int ai = 0; ai < 2; ++ai)
#pragma unroll
            for (int m = 0; m < 4; ++m) { const int r = ai * 128 + wr * 64 + m * 16 + fr; entv[ai][m] = (r < u.nvalid) ? list[u.e + r] : 0u; }
        asm volatile("" ::: "memory");
#pragma unroll
        for (int ai = 0; ai < 2; ++ai)
#pragma unroll
            for (int m = 0; m < 4; ++m) { const int r = ai * 128 + wr * 64 + m * 16 + fr;
                if (r < u.nvalid) { const unsigned ent = entv[ai][m]; bf16_t* rowp = Y + (size_t)ent * DM + u.pn * 256 + wc * 32 + 8 * fq;
#pragma unroll
                    for (int bj = 0; bj < 2; ++bj) { const f32x4 v0 = acc[ai][bj][m][0], v1 = acc[ai][bj][m][1];
                        u32x4 w; w.x = pg8::cvt_pk_bf16(v0[0], v0[1]); w.y = pg8::cvt_pk_bf16(v0[2], v0[3]); w.z = pg8::cvt_pk_bf16(v1[0], v1[1]); w.w = pg8::cvt_pk_bf16(v1[2], v1[3]);
                        *(u32x4*)(rowp + 128 * bj) = w; } } }
    }
};
struct EpiFinal {
    static constexpr bool PERM = false;
    float* out; const bf16_t* x2b; const bf16_t* praw; const float* gout; const LAS f32x2* tab;
    __device__ __forceinline__ void operator()(const f32x4 (&acc)[2][2][4][2], const Unit& u, int wr, int wc, int fr, int fq) const {
        const int col0 = u.pn * 256 + wc * 32 + 4 * fq;
        f32x4 gv[2][2];
#pragma unroll
        for (int bj = 0; bj < 2; ++bj)
#pragma unroll
            for (int n = 0; n < 2; ++n) gv[bj][n] = *(const f32x4*)(gout + col0 + bj * 128 + n * 16);
#pragma unroll
        for (int am = 0; am < 4; ++am) { const int ai = am >> 1, mb = 2 * (am & 1);
            u32x2 xw[2][2][2], pw[2][2][2];
#pragma unroll
            for (int mm = 0; mm < 2; ++mm) { const size_t off = (size_t)(u.pm * 256 + ai * 128 + wr * 64 + (mb + mm) * 16 + fr) * DM + col0;
#pragma unroll
                for (int bj = 0; bj < 2; ++bj)
#pragma unroll
                    for (int n = 0; n < 2; ++n) { xw[mm][bj][n] = *(const u32x2*)(x2b + off + bj * 128 + n * 16); pw[mm][bj][n] = *(const u32x2*)(praw + off + bj * 128 + n * 16); } }
            asm volatile("" ::: "memory");
#pragma unroll
            for (int mm = 0; mm < 2; ++mm) { const int m = mb + mm; const int r = ai * 128 + wr * 64 + m * 16 + fr; const f32x2 sc = tab[r]; const size_t off = (size_t)(u.pm * 256 + r) * DM + col0;
#pragma unroll
                for (int bj = 0; bj < 2; ++bj)
#pragma unroll
                    for (int n = 0; n < 2; ++n) { const u32x2 a = xw[mm][bj][n], p = pw[mm][bj][n];
                        const f32x4 xv = (f32x4){bflo(a.x), bfhi(a.x), bflo(a.y), bfhi(a.y)}, pv = (f32x4){bflo(p.x), bfhi(p.x), bflo(p.y), bfhi(p.y)}; f32x4 o;
#pragma unroll
                        for (int i = 0; i < 4; ++i) { const float z = acc[ai][bj][m][n][i] * sc.x; const float sg = 1.0f / (1.0f + __builtin_amdgcn_exp2f(-z * LOG2E)); o[i] = xv[i] + sg * (pv[i] * sc.y * gv[bj][n][i]); }
                        *(f32x4*)(out + off + bj * 128 + n * 16) = o; }
                asm volatile("" ::: "memory"); }
        }
    }
};

namespace att {
typedef float f32x16 __attribute__((ext_vector_type(16)));
typedef short s16x4 __attribute__((ext_vector_type(4)));
constexpr int NSLOT = 6, KBUF = 0, VBUF = NSLOT * 8192, LUT_OFF = 2 * NSLOT * 8192, KM_OFF = LUT_OFF + 2048;
constexpr float NEGBIG = -1e30f, MFLOOR = -1e20f;
__device__ __forceinline__ s16x4 vtr(const LAS unsigned char* p) { return __builtin_bit_cast(s16x4, __builtin_amdgcn_ds_read_tr16_b64_v4i16((LAS s16x4*)p)); }
__device__ __forceinline__ unsigned pkbf(float lo, float hi) { f32x2 v = {lo, hi}; typedef __bf16 bf2 __attribute__((ext_vector_type(2))); bf2 b = __builtin_convertvector(v, bf2); return __builtin_bit_cast(unsigned, b); }

template <int TYPE>
__device__ __forceinline__ void attn_unit(Frame& F, int b, int hlp, int n) {
    const int tid = F.tid, lane = F.lane, w = F.wave, r32 = lane & 31, hi = lane >> 5;
    const int hl = TYPE ? hlp : 2 * hlp + (w >> 2);
    const int hh = TYPE * 8 + hl, g = hl >> 2;
    const int colQ = (TYPE ? C_QB : C_QA) + 64 * hl, colK = (TYPE ? C_KB : C_KA) + 64 * g, colV = (TYPE ? C_VB : C_VA) + 64 * g;
    const bf16_t* qkv = (const bf16_t*)(F.ws + WS_QKV); bf16_t* O = (bf16_t*)(F.ws + WS_O); float* ssq = (float*)(F.ws + WS_SSQ);
    const float* tab = (const float*)(F.ws + WS_BIAS); const float* kmp = (const float*)(F.ws + WS_KMP);
    const size_t rowb = (size_t)b * SEQ;
    LAS unsigned char* L = F.lds; LAS float* lut = (LAS float*)(L + LUT_OFF) + (TYPE ? 0 : 316 * (w >> 2)); LAS float* kml = (LAS float*)(L + KM_OFF);
    const int q0w = TYPE ? 256 * n + 32 * w : 128 * n + 32 * (w & 3);
    const int t_lo = TYPE ? 0 : (2 * n - 2 > 0 ? 2 * n - 2 : 0), t_hi = TYPE ? 4 * n + 3 : 2 * n + 1;
    __syncthreads();
    for (int e = tid; e < (TYPE ? 316 : 632); e += NTHREADS) { const int ti = TYPE ? e : e % 316, hx = TYPE ? hh : 2 * hlp + e / 316; const int dist = 221 - ti; float v;
        if (dist < 0) v = NEGBIG; else if (dist < 128) v = tab[hx * 132 + dist] - (TYPE ? tab[hx * 132 + 128] : 0.f); else v = TYPE ? 0.f : NEGBIG;
        ((LAS float*)(L + LUT_OFF))[e] = v; }
    if (TYPE) { const int nb = tid >> 6, d = tid & 63; float v = 0.f;
        if (nb < n) { const int pm = b * 8 + nb; v = kmp[((pm * 2 + 0) * 2 + g) * 64 + d] + kmp[((pm * 2 + 1) * 2 + g) * 64 + d]; }
        kml[tid] = v; }
    bf16x8 qf[4];
    { const bf16_t* qp = qkv + (rowb + q0w + r32) * INW + colQ + 8 * hi;
#pragma unroll
      for (int d0 = 0; d0 < 4; ++d0) qf[d0] = *(const bf16x8*)(qp + 16 * d0); }
    const int srow = 8 * w + (lane >> 3);
    const bf16_t* kg = qkv + (rowb + srow) * INW + colK + 8 * ((lane & 7) ^ ((srow >> 1) & 7));
    const bf16_t* vg = qkv + (rowb + srow) * INW + colV + 8 * ((lane & 7) ^ (((srow >> 1) & 1) << 2));
    const int ntl = t_hi - t_lo + 1;
#define TILE_OF(i) (TYPE ? ((i) < 4 ? 4 * n + (i) : (i) - 4) : t_lo + (i))
#define STAGE(ti, slot) do { const int ti_ = (ti) < ntl ? (ti) : ntl - 1; const size_t go_ = (size_t)TILE_OF(ti_) * 64 * INW; \
        __builtin_amdgcn_global_load_lds((const unsigned*)(kg + go_), (LAS unsigned*)(L + KBUF + (slot) * 8192 + w * 1024), 16, 0, 0); \
        __builtin_amdgcn_global_load_lds((const unsigned*)(vg + go_), (LAS unsigned*)(L + VBUF + (slot) * 8192 + w * 1024), 16, 0, 0); } while (0)
    STAGE(0, 0); STAGE(1, 1); STAGE(2, 2); STAGE(3, 3);
    asm volatile("s_waitcnt vmcnt(4)" ::: "memory");
    asm volatile("s_waitcnt lgkmcnt(0)" ::: "memory"); __builtin_amdgcn_s_barrier(); asm volatile("" ::: "memory");
    unsigned sel = 0u;
    if (TYPE) {
        float gate[8];
#pragma unroll
        for (int nb = 0; nb < 8; ++nb) gate[nb] = 0.f;
#pragma unroll
        for (int d0 = 0; d0 < 4; ++d0) { float q8[8];
#pragma unroll
            for (int j = 0; j < 8; ++j) q8[j] = bf2f((unsigned short)qf[d0][j]);
#pragma unroll
            for (int nb = 0; nb < 7; ++nb) if (nb < n) { const f32x4 k0 = *(const LAS f32x4*)(kml + nb * 64 + 16 * d0 + 8 * hi), k1 = *(const LAS f32x4*)(kml + nb * 64 + 16 * d0 + 8 * hi + 4);
                gate[nb] += (q8[0] * k0[0] + q8[1] * k0[1]) + (q8[2] * k0[2] + q8[3] * k0[3]) + (q8[4] * k1[0] + q8[5] * k1[1]) + (q8[6] * k1[2] + q8[7] * k1[3]); } }
#pragma unroll
        for (int nb = 0; nb < 7; ++nb) gate[nb] += __shfl_xor(gate[nb], 32);
        const int nsel = n < 3 ? n : 3;
        for (int k = 0; k < nsel; ++k) { float best = -3e38f; int bi = 0;
#pragma unroll
            for (int nb = 0; nb < 7; ++nb) { const bool ok = (nb < n) && !((sel >> nb) & 1u) && (gate[nb] > best); if (ok) { best = gate[nb]; bi = nb; } }
            sel |= 1u << bi; }
    }
    float m = TYPE ? 0.f : FIN(I_SINKS)[hl] * LOG2E, l = (TYPE == 0 && hi == 0) ? 1.f : 0.f;
    f32x16 negm;
#pragma unroll
    for (int r = 0; r < 16; ++r) negm[r] = -m;
    f32x16 o0 = {}, o1 = {};
    const int qpos = q0w + r32;
    const int kroff = r32 * 128;  const int ksw = (r32 >> 1) & 7;
    const int q_ = (lane & 15) >> 2, p_ = lane & 3, sw = (q_ >> 1) & 1, clow = 2 * ((lane >> 4) & 1) + (p_ >> 1);
    const int vrow = (4 * hi + q_) * 128 + (p_ & 1) * 8;
    const int vb0 = vrow + ((4 * (0 ^ sw) + clow) << 4), vb1 = vrow + ((4 * (1 ^ sw) + clow) << 4);
    const int vaddr0 = (int)(unsigned)(unsigned long)(L + VBUF) + vb0, vaddr1 = (int)(unsigned)(unsigned long)(L + VBUF) + vb1;
    constexpr float THR = 8.0f;
#define ATT_STEP(IDX, SLOT) do { const int i = (IDX);         const int kt = TILE_OF(i); const int cur = (SLOT); \
        const int k0 = 64 * kt; const int dmax = q0w + 31 - k0, dmin = q0w - k0 - 63; \
        bool active, near, mine = true; \
        if (TYPE == 0) { active = (dmax >= 0) && (dmin <= 127); near = true; } \
        else if (kt >= 4 * n) { active = dmax >= 0; near = dmin < 128; } \
        else { mine = (sel >> (kt >> 2)) & 1u; active = __ballot(mine) != 0ull; near = dmin < 128; } \
        if (active) { \
            const LAS unsigned char* Kb = L + KBUF + cur * 8192; const LAS unsigned char* Vb = L + VBUF + cur * 8192; \
            f32x16 p0, p1, c = negm; \
            if (TYPE && kt < 4 * n) { \
        _Pragma("unroll") \
                for (int r = 0; r < 16; ++r) c[r] = mine ? negm[r] : NEGBIG; } \
            { const int co = ((0 + hi) ^ ksw) << 4; const bf16x8 ka = *(const LAS bf16x8*)(Kb + kroff + co), kb2 = *(const LAS bf16x8*)(Kb + 4096 + kroff + co); \
              p0 = __builtin_amdgcn_mfma_f32_32x32x16_bf16(ka, qf[0], c, 0, 0, 0); p1 = __builtin_amdgcn_mfma_f32_32x32x16_bf16(kb2, qf[0], c, 0, 0, 0); } \
        _Pragma("unroll") \
            for (int d0 = 1; d0 < 4; ++d0) { const int co = ((2 * d0 + hi) ^ ksw) << 4; \
                const bf16x8 ka = *(const LAS bf16x8*)(Kb + kroff + co), kb2 = *(const LAS bf16x8*)(Kb + 4096 + kroff + co); \
                p0 = __builtin_amdgcn_mfma_f32_32x32x16_bf16(ka, qf[d0], p0, 0, 0, 0); p1 = __builtin_amdgcn_mfma_f32_32x32x16_bf16(kb2, qf[d0], p1, 0, 0, 0); } \
            if (near) { const LAS float* lp = lut + (221 - (qpos - k0 - 4 * hi)); \
        _Pragma("unroll") \
                for (int r = 0; r < 16; ++r) { const int ko = (r & 3) + 8 * (r >> 2); p0[r] += lp[ko]; p1[r] += lp[32 + ko]; } } \
            float mx = __builtin_fmaxf(__builtin_fmaxf(p0[0], p1[0]), p0[1]); \
        _Pragma("unroll") \
            for (int r = 1; r < 16; ++r) mx = (r == 1) ? __builtin_fmaxf(mx, p1[1]) : __builtin_fmaxf(__builtin_fmaxf(mx, p0[r]), p1[r]); \
            mx = __builtin_fmaxf(mx, __shfl_xor(mx, 32)); \
            const bool first = (TYPE == 1) && (i == 0); \
            const float delta = first ? mx : (mx > THR ? mx : 0.f); \
            if (__ballot(delta != 0.f) != 0ull) { \
                m += delta; const float alpha = __builtin_amdgcn_exp2f(-delta); l *= alpha; \
        _Pragma("unroll") \
                for (int r = 0; r < 16; ++r) { o0[r] *= alpha; o1[r] *= alpha; negm[r] = -m; p0[r] -= delta; p1[r] -= delta; } \
            } \
            float ps = 0.f; \
        _Pragma("unroll") \
            for (int r = 0; r < 16; ++r) { p0[r] = __builtin_amdgcn_exp2f(p0[r]); p1[r] = __builtin_amdgcn_exp2f(p1[r]); ps += p0[r] + p1[r]; } \
            l += ps; \
            s16x4 ta[4][2], tc[4][2];                                    \
        _Pragma("unroll") \
            for (int s = 0; s < 4; ++s) { \
                asm volatile("ds_read_b64_tr_b16 %0, %1 offset:%c2" : "=&v"(ta[s][0]) : "v"(vaddr0 + cur * 8192), "i"(s * 2048) : "memory"); \
                asm volatile("ds_read_b64_tr_b16 %0, %1 offset:%c2" : "=&v"(ta[s][1]) : "v"(vaddr0 + cur * 8192), "i"(s * 2048 + 1024) : "memory"); \
                asm volatile("ds_read_b64_tr_b16 %0, %1 offset:%c2" : "=&v"(tc[s][0]) : "v"(vaddr1 + cur * 8192), "i"(s * 2048) : "memory"); \
                asm volatile("ds_read_b64_tr_b16 %0, %1 offset:%c2" : "=&v"(tc[s][1]) : "v"(vaddr1 + cur * 8192), "i"(s * 2048 + 1024) : "memory"); } \
            asm volatile("s_waitcnt lgkmcnt(0)" ::: "memory"); __builtin_amdgcn_sched_barrier(0); \
        _Pragma("unroll") \
            for (int s = 0; s < 4; ++s) { \
                u32x4 pw; \
                if (s < 2) { pw.x = pkbf(p0[8 * s + 0], p0[8 * s + 1]); pw.y = pkbf(p0[8 * s + 2], p0[8 * s + 3]); pw.z = pkbf(p0[8 * s + 4], p0[8 * s + 5]); pw.w = pkbf(p0[8 * s + 6], p0[8 * s + 7]); } \
                else { const int s2 = s - 2; pw.x = pkbf(p1[8 * s2 + 0], p1[8 * s2 + 1]); pw.y = pkbf(p1[8 * s2 + 2], p1[8 * s2 + 3]); pw.z = pkbf(p1[8 * s2 + 4], p1[8 * s2 + 5]); pw.w = pkbf(p1[8 * s2 + 6], p1[8 * s2 + 7]); } \
                const bf16x8 pb = __builtin_bit_cast(bf16x8, pw); \
                const s16x4 a0 = ta[s][0], a1 = ta[s][1], c0 = tc[s][0], c1 = tc[s][1]; \
                const bf16x8 va = (bf16x8){a0[0], a0[1], a0[2], a0[3], a1[0], a1[1], a1[2], a1[3]}, vc = (bf16x8){c0[0], c0[1], c0[2], c0[3], c1[0], c1[1], c1[2], c1[3]}; \
                o0 = __builtin_amdgcn_mfma_f32_32x32x16_bf16(va, pb, o0, 0, 0, 0); o1 = __builtin_amdgcn_mfma_f32_32x32x16_bf16(vc, pb, o1, 0, 0, 0); \
            } \
        } \
    } while (0)
    { int sc = 0;
      for (int i2 = 0; i2 < ntl; i2 += 2) {
          const int s4 = (sc + 4 >= NSLOT) ? sc + 4 - NSLOT : sc + 4, s5 = (sc + 5 >= NSLOT) ? sc + 5 - NSLOT : sc + 5, sn = sc + 1;
          STAGE(i2 + 4, s4); STAGE(i2 + 5, s5);
          ATT_STEP(i2, sc); ATT_STEP(i2 + 1, sn);
          asm volatile("s_waitcnt vmcnt(4)" ::: "memory");
          asm volatile("s_waitcnt lgkmcnt(0)" ::: "memory"); __builtin_amdgcn_s_barrier(); asm volatile("" ::: "memory");
          sc = (sc + 2 >= NSLOT) ? sc + 2 - NSLOT : sc + 2; } }
    asm volatile("s_waitcnt vmcnt(0)" ::: "memory");
#undef ATT_STEP
#undef STAGE
#undef TILE_OF
    l += __shfl_xor(l, 32);
    const float rl = 1.0f / l; float q2 = 0.f;
    const size_t t = rowb + qpos; bf16_t* op = O + t * DM + 64 * hh + 4 * hi;
#pragma unroll
    for (int c4 = 0; c4 < 4; ++c4) {
        const float a0 = o0[4 * c4 + 0] * rl, a1 = o0[4 * c4 + 1] * rl, a2 = o0[4 * c4 + 2] * rl, a3 = o0[4 * c4 + 3] * rl;
        const float b0 = o1[4 * c4 + 0] * rl, b1 = o1[4 * c4 + 1] * rl, b2 = o1[4 * c4 + 2] * rl, b3 = o1[4 * c4 + 3] * rl;
        q2 += (a0 * a0 + a1 * a1) + (a2 * a2 + a3 * a3) + (b0 * b0 + b1 * b1) + (b2 * b2 + b3 * b3);
        u32x2 wa; wa.x = pkbf(a0, a1); wa.y = pkbf(a2, a3); *(u32x2*)(op + 8 * c4) = wa;
        u32x2 wb; wb.x = pkbf(b0, b1); wb.y = pkbf(b2, b3); *(u32x2*)(op + 32 + 8 * c4) = wb;
    }
    q2 += __shfl_xor(q2, 32);
    if (hi == 0) ssq[t * 16 + hh] = q2;
}
}
__device__ __forceinline__ void p2_attention(Frame& F) {
    for (int j = F.vcu; j < 512; j += F.G) {
        if (j < 256) { const int b = j >> 5, hm = (j >> 2) & 7, pi = j & 3; att::attn_unit<1>(F, b, hm, 7 - pi); att::attn_unit<1>(F, b, hm, pi); }
        else { const int id = 2 * (j - 256);
#pragma unroll 1
            for (int k = 0; k < 2; ++k) { const int u = id + k; att::attn_unit<0>(F, u >> 6, (u >> 4) & 3, u & 15); } }
    }
    __syncthreads();
}

__device__ __forceinline__ void p4_router(Frame& F) {
    typedef float f32x16 __attribute__((ext_vector_type(16)));
    const bf16_t* x1b = (const bf16_t*)(F.ws + WS_X1B); float* r2 = (float*)(F.ws + WS_R2); const bf16_t* Wt = (const bf16_t*)(F.ws + WS_WR);
    LAS float* part = (LAS float*)F.lds;
    LAS float* sspart = (LAS float*)(F.lds + 98304);
    LAS int* lcnt = (LAS int*)(F.lds + MISC_OFF);
    LAS int* trec = (LAS int*)(F.lds + MISC_OFF + 512);
    unsigned* cnt = (unsigned*)(F.ctl + CW_CNT); unsigned* list = (unsigned*)(F.ws + WS_LIST); int* tok = (int*)(F.ws + WS_TOK);
    if (F.tid < 64) lcnt[F.tid] = 0;
    const int per = T / F.G;
    const int t0 = F.vcu * per;
    {
        const int tg = F.wave >> 2, kq = F.wave & 3, r32 = F.lane & 31, hi = F.lane >> 5;
        const bf16_t* ap = x1b + (size_t)(t0 + 32 * tg + r32) * DM + 256 * kq + 8 * hi;
        const bf16_t* bp = Wt + (size_t)r32 * DM + 256 * kq + 8 * hi;
        f32x16 a0 = {}, a1 = {}, a2 = {}; float ss = 0.f;
#pragma unroll 4
        for (int s = 0; s < 16; ++s) {
            const bf16x8 a = *(const bf16x8*)(ap + 16 * s);
            const bf16x8 b0 = *(const bf16x8*)(bp + 16 * s), b1 = *(const bf16x8*)(bp + (size_t)32 * DM + 16 * s), b2 = *(const bf16x8*)(bp + (size_t)64 * DM + 16 * s);
            a0 = __builtin_amdgcn_mfma_f32_32x32x16_bf16(a, b0, a0, 0, 0, 0); a1 = __builtin_amdgcn_mfma_f32_32x32x16_bf16(a, b1, a1, 0, 0, 0); a2 = __builtin_amdgcn_mfma_f32_32x32x16_bf16(a, b2, a2, 0, 0, 0);
#pragma unroll
            for (int j = 0; j < 8; ++j) { const float v = bf2f((unsigned short)a[j]); ss += v * v; }
        }
        LAS float* pp = part + ((tg * 4 + kq) * 32) * 96 + r32;
#pragma unroll
        for (int r = 0; r < 16; ++r) { const int tk = (r & 3) + 8 * (r >> 2) + 4 * hi; pp[tk * 96] = a0[r]; pp[tk * 96 + 32] = a1[r]; pp[tk * 96 + 64] = a2[r]; }
        sspart[((tg * 4 + kq) * 2 + hi) * 32 + r32] = ss;
    }
    __syncthreads();
    if (F.tid < per) {
        const int lt = F.tid, tg = lt >> 5, tk = lt & 31, t = t0 + lt;
        float lg[36]; float ssq = 0.f;
#pragma unroll
        for (int o = 0; o < 36; ++o) lg[o] = 0.f;
#pragma unroll
        for (int kq = 0; kq < 4; ++kq) { const LAS float* pr = part + ((tg * 4 + kq) * 32 + tk) * 96;
#pragma unroll
            for (int o = 0; o < 32; ++o) lg[o] += pr[o] + pr[32 + o];
#pragma unroll
            for (int o = 0; o < 4; ++o) lg[32 + o] += pr[64 + o] + pr[68 + o];
            ssq += sspart[((tg * 4 + kq) * 2 + 0) * 32 + tk] + sspart[((tg * 4 + kq) * 2 + 1) * 32 + tk]; }
        const float rs = 1.0f / sqrtf(ssq * (1.0f / DM) + EPS);
#pragma unroll
        for (int o = 0; o < 36; ++o) lg[o] *= rs;
        const float* brg = FIN(I_B_RG); const float* bre = FIN(I_B_RE);
        lg[0] += brg[0]; lg[1] += brg[1]; lg[2] += brg[2]; lg[3] += brg[3];
        int gsel = 0; float gm = lg[0];
#pragma unroll
        for (int o = 1; o < 4; ++o) if (lg[o] > gm) { gm = lg[o]; gsel = o; }
        float den = 0.f;
#pragma unroll
        for (int o = 0; o < 4; ++o) den += __expf(lg[o] - gm);
        const float gwt = 1.0f / den;
        float el[8];
#pragma unroll
        for (int j = 0; j < 8; ++j) { float a = lg[4 + j];
#pragma unroll
            for (int gq = 1; gq < 4; ++gq) a = (gsel == gq) ? lg[4 + 8 * gq + j] : a;
            el[j] = a + bre[gsel * 8 + j]; }
        int i0 = 0; float v0 = el[0];
#pragma unroll
        for (int j = 1; j < 8; ++j) if (el[j] > v0) { v0 = el[j]; i0 = j; }
        int i1 = -1; float v1 = -3e38f;
#pragma unroll
        for (int j = 0; j < 8; ++j) if (j != i0 && el[j] > v1) { v1 = el[j]; i1 = j; }
        const float e1 = __expf(v1 - v0); const float w0 = gwt / (1.0f + e1), w1 = gwt * e1 / (1.0f + e1);
        const int e0 = gsel * 8 + i0, e1i = gsel * 8 + i1;
        const int lr0 = __hip_atomic_fetch_add(&lcnt[e0], 1, __ATOMIC_RELAXED, __HIP_MEMORY_SCOPE_WORKGROUP);
        const int lr1 = __hip_atomic_fetch_add(&lcnt[e1i], 1, __ATOMIC_RELAXED, __HIP_MEMORY_SCOPE_WORKGROUP);
        trec[lt * 8 + 0] = e0; trec[lt * 8 + 1] = e1i; trec[lt * 8 + 2] = lr0; trec[lt * 8 + 3] = lr1;
        trec[lt * 8 + 4] = __builtin_bit_cast(int, w0); trec[lt * 8 + 5] = __builtin_bit_cast(int, w1);
        r2[t] = rs;
    }
    __syncthreads();
    if (F.tid < 32) { const int c = lcnt[F.tid]; int base = 0; if (c > 0) base = (int)__hip_atomic_fetch_add(&cnt[F.tid], (unsigned)c, __ATOMIC_RELAXED, __HIP_MEMORY_SCOPE_AGENT); lcnt[32 + F.tid] = base; }
    __syncthreads();
    for (int lt = F.tid; lt < per; lt += NTHREADS) {
        const int t = t0 + lt; const int e0 = trec[lt * 8 + 0], e1 = trec[lt * 8 + 1];
        const int rk0 = lcnt[32 + e0] + trec[lt * 8 + 2], rk1 = lcnt[32 + e1] + trec[lt * 8 + 3];
        list[e0 * 16384 + rk0] = (unsigned)(t * 2); list[e1 * 16384 + rk1] = (unsigned)(t * 2 + 1);
        int* tr = tok + (size_t)t * 8; tr[0] = e0; tr[1] = e1; tr[2] = rk0; tr[3] = rk1; tr[4] = trec[lt * 8 + 4]; tr[5] = trec[lt * 8 + 5];
    }
    __syncthreads();
}

__device__ __forceinline__ void build_tile_table(Frame& F, LAS int* tb) {
    if (F.tid < 64) {
        const unsigned* cnt = (const unsigned*)(F.ctl + CW_CNT);
        const int nt = (F.lane < NEXP) ? (int)((__hip_atomic_load(&cnt[F.lane & 31], __ATOMIC_RELAXED, __HIP_MEMORY_SCOPE_AGENT) + 255u) >> 8) : 0;
        int inc = nt;
#pragma unroll
        for (int o = 1; o < 32; o <<= 1) { const int v = __shfl_up(inc, o); if ((F.lane & 31) >= o) inc += v; }
        if (F.lane < NEXP) { tb[F.lane] = inc - nt; if (F.lane == NEXP - 1) tb[NEXP] = inc; }
    }
    __syncthreads();
}

__device__ __forceinline__ void p7_combine(Frame& F) {
    const bf16_t* x1b = (const bf16_t*)(F.ws + WS_X1B); const bf16_t* Y = (const bf16_t*)(F.ws + WS_Y); bf16_t* x2b = (bf16_t*)(F.ws + WS_X2B); float* r3 = (float*)(F.ws + WS_R3); const int* tok = (const int*)(F.ws + WS_TOK);
    const int gw = F.vcu * NWAVES + F.wave, NGW = F.G * NWAVES;
    for (int t = gw; t < T; t += 2 * NGW) {
        const int tb_ = (t + NGW < T) ? t + NGW : t; const bool two = tb_ != t;
        const f32x2 wa = *(const f32x2*)(tok + (size_t)t * 8 + 4), wb = *(const f32x2*)(tok + (size_t)tb_ * 8 + 4);
        u32x2 xa[2][4], ya[2][4], yb[2][4];
#pragma unroll
        for (int k = 0; k < 2; ++k) { const int tt = k ? tb_ : t;
            const GAS u32x2* xr = (const GAS u32x2*)(x1b + (size_t)tt * DM) + F.lane;
            const GAS u32x2* y0 = (const GAS u32x2*)(Y + (size_t)(2 * tt) * DM) + F.lane; const GAS u32x2* y1 = (const GAS u32x2*)(Y + (size_t)(2 * tt + 1) * DM) + F.lane;
#pragma unroll
            for (int j = 0; j < 4; ++j) { xa[k][j] = xr[64 * j]; ya[k][j] = y0[64 * j]; yb[k][j] = y1[64 * j]; } }
#pragma unroll
        for (int k = 0; k < 2; ++k) { const int tt = k ? tb_ : t; const float w0 = k ? wb.x : wa.x, w1 = k ? wb.y : wa.y;
            GAS u32x2* ob = (GAS u32x2*)(x2b + (size_t)tt * DM) + F.lane; float s = 0.f;
#pragma unroll
            for (int j = 0; j < 4; ++j) { f32x4 v;
                v.x = bflo(xa[k][j].x) + (w0 * bflo(ya[k][j].x) + w1 * bflo(yb[k][j].x)); v.y = bfhi(xa[k][j].x) + (w0 * bfhi(ya[k][j].x) + w1 * bfhi(yb[k][j].x));
                v.z = bflo(xa[k][j].y) + (w0 * bflo(ya[k][j].y) + w1 * bflo(yb[k][j].y)); v.w = bfhi(xa[k][j].y) + (w0 * bfhi(ya[k][j].y) + w1 * bfhi(yb[k][j].y));
                u32x2 w; w.x = pk2(v.x, v.y); w.y = pk2(v.z, v.w); if (k == 0 || two) ob[64 * j] = w; s += (v.x * v.x + v.y * v.y) + (v.z * v.z + v.w * v.w); }
            s = wave_sum(s);
            if (F.lane == 0 && (k == 0 || two)) r3[tt] = 1.0f / sqrtf(s * (1.0f / DM) + EPS); }
    }
}

#define XB_TMO      128
#define XB_XCNT(j)  (256  + 64 * (j))
#define XB_XSUB(j)  (1280 + 64 * (j))
#define XB_XGEN(j)  (2304 + 64 * (j))
#define XB_TOP      3328
#define XB_TOPGEN   3392
#define XCD_BAR_WORDS 3456
#define XB_SPIN_CAP (1u << 18)
__device__ __forceinline__ unsigned xb_ld(unsigned* p)              { return __hip_atomic_load(p, __ATOMIC_RELAXED, __HIP_MEMORY_SCOPE_AGENT); }
__device__ __forceinline__ unsigned xb_add(unsigned* p, unsigned v) { return __hip_atomic_fetch_add(p, v, __ATOMIC_RELAXED, __HIP_MEMORY_SCOPE_AGENT); }
__device__ __forceinline__ unsigned xb_xcc_id() { return (unsigned)__builtin_amdgcn_s_getreg((3 << 11) | 20) & 0xFu; }
#define XB_SPIN(cond, bar) do { unsigned _sp = 0; while (cond) { __builtin_amdgcn_s_sleep(1); \
    if ((++_sp & 255u) == 0u) { if (xb_ld(&(bar)[XB_TMO])) break; if (_sp > XB_SPIN_CAP) { atomicAdd(&(bar)[XB_TMO], 1u); break; } } } } while (0)
struct XcdBarrier { unsigned* bar; unsigned x; volatile LAS unsigned* st; };
__device__ __forceinline__ XcdBarrier xcd_barrier_post(unsigned* bar, volatile LAS unsigned* st) {
    XcdBarrier b; b.bar = bar; b.x = xb_xcc_id(); b.st = st;
    if (threadIdx.x == 0) (void)xb_add(&bar[XB_XCNT(b.x)], 1u);
    return b;
}
__device__ __forceinline__ void xcd_barrier_complete(unsigned* bar, unsigned x, unsigned& nloc, unsigned& nx) {
    const unsigned G = gridDim.x * gridDim.y * gridDim.z;
    unsigned sum, cnt, mine, sp = 0u;
    for (;;) {
        sum = 0u; cnt = 0u; mine = 0u;
#pragma unroll
        for (unsigned j = 0; j < 16; ++j) { const unsigned c = xb_ld(&bar[XB_XCNT(j)]); sum += c; cnt += (c > 0u) ? 1u : 0u; mine = (j == x) ? c : mine; }
        if (sum == G) break;
        __builtin_amdgcn_s_sleep(1);
        if ((++sp & 255u) == 0u) { if (xb_ld(&bar[XB_TMO])) break; if (sp > XB_SPIN_CAP) { atomicAdd(&bar[XB_TMO], 1u); break; } }
    }
    nloc = mine > 0u ? mine : 1u; nx = cnt > 0u ? cnt : 1u;
}
__device__ __forceinline__ void xcd_barrier(const XcdBarrier& b) {
    asm volatile("s_waitcnt vmcnt(0)" ::: "memory");
    __syncthreads();
    if (threadIdx.x == 0) {
        unsigned* bar = b.bar;
        __builtin_amdgcn_s_waitcnt(0);
        unsigned nloc = b.st[0], nx = b.st[1];
        if (nloc == 0u) { xcd_barrier_complete(bar, b.x, nloc, nx); b.st[0] = nloc; b.st[1] = nx; }
        const unsigned old = xb_add(&bar[XB_XSUB(b.x)], 1u);
        const unsigned gen = old / nloc;
        if (old + 1u == (gen + 1u) * nloc) {
            __builtin_amdgcn_fence(__ATOMIC_RELEASE, "agent");
            asm volatile("s_waitcnt vmcnt(0)" ::: "memory");
            const unsigned og = xb_add(&bar[XB_TOP], 1u);
            const unsigned tg = og / nx;
            if (og + 1u == (tg + 1u) * nx) xb_add(&bar[XB_TOPGEN], 1u);
            else XB_SPIN(xb_ld(&bar[XB_TOPGEN]) == tg, bar);
            __builtin_amdgcn_fence(__ATOMIC_ACQUIRE, "agent");
            xb_add(&bar[XB_XGEN(b.x)], 1u);
            asm volatile("s_waitcnt vmcnt(0)" ::: "memory");
        } else {
            XB_SPIN(xb_ld(&bar[XB_XGEN(b.x)]) == gen, bar);
            __builtin_amdgcn_fence(__ATOMIC_ACQUIRE, "agent");
            asm volatile("s_waitcnt vmcnt(0)" ::: "memory");
        }
    }
    __syncthreads();
}

__global__ void __launch_bounds__(NTHREADS, 2) hymba_fwd(Args args) {
    extern __shared__ __attribute__((aligned(16))) unsigned char lds[];
    Frame F;
    F.lds = (LAS unsigned char*)lds; unsigned char* ws;
#define REFRESH_IDS() do { int t_ = threadIdx.x; asm volatile("" : "+v"(t_)); F.tid = t_; F.lane = t_ & 63; F.wave = __builtin_amdgcn_readfirstlane(t_ >> 6); \
        unsigned char* w_ = args.ws; const __attribute__((address_space(4))) char* k_ = (const __attribute__((address_space(4))) char*)__builtin_amdgcn_kernarg_segment_ptr(); float* o_ = args.out; asm volatile("" : "+s"(w_), "+s"(k_), "+s"(o_)); \
        F.ws = w_; F.ka = k_; F.out = o_; F.ctl = (GAS unsigned*)(w_ + WS_CTL); ws = w_; } while (0)
    REFRESH_IDS();
    F.G = gridDim.x; { const int bx = blockIdx.x; F.vcu = (F.G % 8 == 0) ? (bx % 8) * (F.G / 8) + bx / 8 : bx; }
    const int lo = args.ph_lo, hi = args.ph_hi;
#ifdef ONLY_PHASE
#define IN(k) ((k) == ONLY_PHASE && lo <= (k) && (k) < hi)
#else
#define IN(k) (lo <= (k) && (k) < hi)
#endif
    LAS int* tb = (LAS int*)(F.lds + MISC_OFF + 8192);
    LAS f32x2* rowtab = (LAS f32x2*)(F.lds + MISC_OFF + 4096);
    volatile LAS unsigned* bst = (volatile LAS unsigned*)(F.lds + MISC_OFF + 12288);
    if (F.tid < 2) bst[F.tid] = 0u;
    __syncthreads();
    XcdBarrier bar; bar.bar = (unsigned*)(F.ctl + CW_BAR); bar.x = 0; bar.st = bst;
    if (hi - lo > 1) bar = xcd_barrier_post((unsigned*)(F.ctl + CW_BAR), bst);
#define SEAM(k) do { if (IN(k) && IN((k) + 1)) xcd_barrier(bar); } while (0)

    for (int rep = 0; rep < 1 + ((REPEAT_MASK >> 0) & 1); ++rep) { if (rep) xcd_barrier(bar);
    if (IN(0)) { REFRESH_IDS(); p0_prologue(F); }
    }
    SEAM(0);
    for (int rep = 0; rep < 1 + ((REPEAT_MASK >> 1) & 1); ++rep) { if (rep) xcd_barrier(bar);
    if (IN(1)) {
        REFRESH_IDS();
        { pg8::DenseOrder S{(const char*)(ws + WS_XB), (const char*)(ws + WS_WIN), T / 256, INW / 256, DM, F.G, (int)blockIdx.x};
          EpiQKV E{(bf16_t*)(ws + WS_QKV), (const float*)(ws + WS_RS1), FIN(I_SWA_QN), FIN(I_SWA_KN), FIN(I_MOBA_QN), FIN(I_MOBA_KN), (float*)(ws + WS_KMP)};
          pg8::gemm_phase<EpiQKV, pg8::DenseOrder, true, false, false>(F.lds, DM, S, E); }
        { const int hg = F.G / 2; const bool second = (int)blockIdx.x >= hg;
          pg8::DenseOrder S{(const char*)(ws + WS_PB), (const char*)(ws + WS_WPP), T / 256, DM / 256, PLE, second ? hg : (1 << 30), second ? (int)blockIdx.x - hg : (1 << 30)};
          EpiProj E{(bf16_t*)(ws + WS_PRAW), (float*)(ws + WS_SSQP)};
          pg8::gemm_phase<EpiProj, pg8::DenseOrder, true, false, false>(F.lds, PLE, S, E); }
    }
    }
    SEAM(1);
    for (int rep = 0; rep < 1 + ((REPEAT_MASK >> 2) & 1); ++rep) { if (rep) xcd_barrier(bar);
    if (IN(2)) { REFRESH_IDS(); p2_attention(F); }
    }
    SEAM(2);
    for (int rep = 0; rep < 1 + ((REPEAT_MASK >> 3) & 1); ++rep) { if (rep) xcd_barrier(bar);
    if (IN(3)) {
        pg8::DenseOrder S{(const char*)(ws + WS_O), (const char*)(ws + WS_WOUT), T / 256, DM / 256, DM, F.G, (int)blockIdx.x};
        REFRESH_IDS();
        { pg8::Unit u0; if (S.next(0, u0) && F.tid < 256) {
              const f32x4* p = (const f32x4*)((const float*)(ws + WS_SSQ) + (size_t)(u0.pm * 256 + F.tid) * 16); const f32x4 a0 = p[0], a1 = p[1], b0 = p[2], b1 = p[3];
              const float qa = ((a0[0] + a0[1]) + (a0[2] + a0[3])) + ((a1[0] + a1[1]) + (a1[2] + a1[3])), qb = ((b0[0] + b0[1]) + (b0[2] + b0[3])) + ((b1[0] + b1[1]) + (b1[2] + b1[3]));
              rowtab[F.tid] = (f32x2){1.0f / sqrtf(qa * (1.0f / 512.f) + EPS), 1.0f / sqrtf(qb * (1.0f / 512.f) + EPS)}; }
          __syncthreads(); }
        EpiOut E{(bf16_t*)(ws + WS_X1B), (const LAS f32x2*)rowtab};
        pg8::gemm_phase<EpiOut, pg8::DenseOrder, false, false, true>(F.lds, DM, S, E);
    }
    }
    SEAM(3);
    if (IN(4)) { REFRESH_IDS(); p4_router(F); }
    SEAM(4);
    for (int rep = 0; rep < 1 + ((REPEAT_MASK >> 5) & 1); ++rep) { if (rep) xcd_barrier(bar);
    if (IN(5)) {
        REFRESH_IDS(); build_tile_table(F, tb);
        MoeOrder S{(const char*)(ws + WS_X1B), (const char*)(ws + WS_WGU), tb, (const unsigned*)(F.ctl + CW_CNT), (const unsigned*)(ws + WS_LIST), DM, (size_t)DM * DM * 2, (size_t)DM * 2, F.G, (int)blockIdx.x, true};
        EpiG1 E{(bf16_t*)(ws + WS_H), (const float*)(ws + WS_R2), (const unsigned*)(ws + WS_LIST)};
        pg8::gemm_phase<EpiG1, MoeOrder, true, true, false>(F.lds, DM, S, E);
        { REFRESH_IDS();
          const int nwg = tb[NEXP] * 4, G = F.G, c = (int)blockIdx.x;
          const int maxnu = (nwg + G - 1) / G, nu = (nwg - c + G - 1) / G;
          const int nfull = nwg - (maxnu - 1) * G;
          const bool all = (nfull >= G);
          const int W = all ? G : G - nfull, rank = all ? c : c - nfull;
          if (all || nu < maxnu) { LAS float* scr = (LAS float*)(F.lds + F.wave * 16384); tr_stream(F, scr, rank * NWAVES + F.wave, W * NWAVES, TI_DOWN, TI_DOWN_BASE); } }
    }
    }
    SEAM(5);
    for (int rep = 0; rep < 1 + ((REPEAT_MASK >> 6) & 1); ++rep) { if (rep) xcd_barrier(bar);
    if (IN(6)) {
        REFRESH_IDS(); build_tile_table(F, tb);
        MoeOrder S{(const char*)(ws + WS_H), (const char*)(ws + WS_WD), tb, (const unsigned*)(F.ctl + CW_CNT), (const unsigned*)(ws + WS_LIST), DEXP, (size_t)DM * DEXP * 2, (size_t)DEXP * 2, F.G, (int)blockIdx.x, false};
        EpiG2 E{(bf16_t*)(ws + WS_Y), (const unsigned*)(ws + WS_LIST)};
        pg8::gemm_phase<EpiG2, MoeOrder, true, false, false>(F.lds, DEXP, S, E);
    }
    }
    SEAM(6);
    if (IN(7)) { REFRESH_IDS(); p7_combine(F); }
    SEAM(7);
    if (IN(8)) {
        pg8::DenseOrder S{(const char*)(ws + WS_X2B), (const char*)(ws + WS_WPG), T / 256, DM / 256, DM, F.G, (int)blockIdx.x};
        REFRESH_IDS();
        { pg8::Unit u0; if (S.next(0, u0) && F.tid < 256) {
              const int row = u0.pm * 256 + F.tid; const f32x4* sp = (const f32x4*)((const float*)(ws + WS_SSQP) + (size_t)row * 16); const f32x4 s0 = sp[0], s1 = sp[1], s2 = sp[2], s3 = sp[3];
              const float q = (((s0[0] + s0[1]) + (s0[2] + s0[3])) + ((s1[0] + s1[1]) + (s1[2] + s1[3]))) + (((s2[0] + s2[1]) + (s2[2] + s2[3])) + ((s3[0] + s3[1]) + (s3[2] + s3[3])));
              rowtab[F.tid] = (f32x2){((const float*)(ws + WS_R3))[row], 1.0f / sqrtf(q * (1.0f / DM) + EPS)}; }
          __syncthreads(); }
        EpiFinal E{F.out, (const bf16_t*)(ws + WS_X2B), (const bf16_t*)(ws + WS_PRAW), FIN(I_PLE_ON), (const LAS f32x2*)rowtab};
        pg8::gemm_phase<EpiFinal, pg8::DenseOrder, false, false, false>(F.lds, DM, S, E);
    }
#undef IN
#undef SEAM
}

extern "C" void kernel_launch(void* const* d_in, const int* in_sizes, int n_in, void* d_out, int out_size, void* d_ws, size_t ws_size, hipStream_t stream) {
    static int grid = 0;
    if (grid == 0) {
        if (n_in != 25 || in_sizes[0] != T * DM || out_size != T * DM || ws_size < WS_END) { fprintf(stderr, "kernel_launch: unexpected shapes (n_in %d, in0 %d, out %d, ws %zu)\n", n_in, n_in > 0 ? in_sizes[0] : -1, out_size, ws_size); grid = -1; return; }
        int dev = 0, cus = 0, per_cu = 0;
        if (hipGetDevice(&dev) != hipSuccess || hipDeviceGetAttribute(&cus, hipDeviceAttributeMultiprocessorCount, dev) != hipSuccess) { grid = -1; return; }
        if (hipFuncSetAttribute((const void*)hymba_fwd, hipFuncAttributeMaxDynamicSharedMemorySize, LDS_BYTES) != hipSuccess) { fprintf(stderr, "kernel_launch: hipFuncSetAttribute failed\n"); grid = -1; return; }
        if (hipOccupancyMaxActiveBlocksPerMultiprocessor(&per_cu, (const void*)hymba_fwd, NTHREADS, LDS_BYTES) != hipSuccess || per_cu < 1) { fprintf(stderr, "kernel_launch: occupancy query says %d\n", per_cu); per_cu = 1; }
        (void)hipGetLastError();
        grid = cus;
        if (grid != 256) { fprintf(stderr, "kernel_launch: %d CUs; this kernel is built for 256 (one 256x256 tile per workgroup in the N=1024 GEMM phases)\n", grid); grid = -1; return; }
    }
    if (grid < 0) return;
    (void)hipMemsetAsync((char*)d_ws + WS_CTL, 0, CTL_ZERO_BYTES, stream);
    Args a{};
    for (int i = 0; i < 25; ++i) a.in[i] = (const float*)d_in[i];
    a.out = (float*)d_out; a.ws = (unsigned char*)d_ws;
    constexpr int NPH = 9;
    for (int li = 0; li < MK_N_LAUNCHES; ++li) {
        a.ph_lo = (MK_N_LAUNCHES == NPH) ? li : 0; a.ph_hi = (MK_N_LAUNCHES == NPH) ? li + 1 : NPH; a.li = li;
        hipLaunchKernelGGL(hymba_fwd, dim3(grid), dim3(NTHREADS), LDS_BYTES, stream, a);
    }
}
```

```cpp
#include <hip/hip_runtime.h>
#include <cstdio>
#include <cstdint>

#ifndef MK_N_LAUNCHES
#define MK_N_LAUNCHES 1
#endif

#ifndef REPEAT_MASK
#define REPEAT_MASK 0
#endif
#define LAS __attribute__((address_space(3)))
#define GAS __attribute__((address_space(1)))
typedef unsigned short bf16_t;
typedef short bf16x8 __attribute__((ext_vector_type(8)));
typedef float f32x4 __attribute__((ext_vector_type(4)));
typedef float f32x2 __attribute__((ext_vector_type(2)));
typedef unsigned u32x4 __attribute__((ext_vector_type(4)));
typedef unsigned u32x2 __attribute__((ext_vector_type(2)));

constexpr int BATCH = 8, SEQ = 2048, DM = 1024, T = BATCH * SEQ;
constexpr int INW = 1536, NHQ = 16, HD = 64;
constexpr int NEXP = 32, DEXP = 512, PLE = 256;
constexpr int MAXTILES = 160;
constexpr float EPS = 1e-6f;
constexpr float LOG2E = 1.4426950408889634f;
constexpr float QSCALE = 0.125f * LOG2E;
constexpr int NWAVES = 8, NTHREADS = 512;

constexpr int C_QA = 0, C_KA = 512, C_VA = 640, C_QB = 768, C_KB = 1280, C_VB = 1408;

constexpr size_t KiB = 1024, MiB = 1u << 20;
constexpr size_t WS_CTL = 0, CTL_ZERO_BYTES = 1 * MiB;
constexpr size_t WS_RS1 = 1 * MiB, WS_R2 = WS_RS1 + 64 * KiB, WS_R3 = WS_R2 + 64 * KiB, WS_KMP = WS_R3 + 64 * KiB;
constexpr size_t WS_WR = WS_KMP + 64 * KiB;
constexpr size_t WS_BIAS = WS_WR + 192 * KiB;
constexpr size_t WS_TOK = 1 * MiB + 512 * KiB;
constexpr size_t WS_SSQ = 2 * MiB;
constexpr size_t WS_SSQP = 3 * MiB;
constexpr size_t WS_LIST = 4 * MiB;
constexpr size_t WS_WIN = 8 * MiB, WS_WOUT = 11 * MiB, WS_WPG = 13 * MiB, WS_WPP = 15 * MiB;
constexpr size_t WS_WGU = 16 * MiB;
constexpr size_t WS_WD = 80 * MiB;
constexpr size_t WS_PRAW = 112 * MiB;
constexpr size_t WS_X1B = 144 * MiB;
constexpr size_t WS_X2B = WS_X1B;
constexpr size_t WS_H = 176 * MiB;
constexpr size_t WS_Y = 216 * MiB;
constexpr size_t WS_QKV = 176 * MiB;
constexpr size_t WS_O = 224 * MiB;
constexpr size_t WS_PB = 240 * MiB;
constexpr size_t WS_XB = WS_X1B;
constexpr size_t WS_END = 280 * MiB;
constexpr int CW_CNT = 64;
constexpr int CW_BAR = 4096;

constexpr int RING_BYTES = 131072;
constexpr int MISC_OFF = 147456;
constexpr int LDS_BYTES = 163840;

__device__ __forceinline__ unsigned f2bf(float f) { unsigned u = __builtin_bit_cast(unsigned, f); return (u + 0x7fffu + ((u >> 16) & 1u)) >> 16; }
__device__ __forceinline__ unsigned pk2(float lo, float hi) { return f2bf(lo) | (f2bf(hi) << 16); }
__device__ __forceinline__ float bf2f(unsigned short h) { return __builtin_bit_cast(float, (unsigned)h << 16); }
__device__ __forceinline__ float bflo(unsigned w) { return __builtin_bit_cast(float, w << 16); }
__device__ __forceinline__ float bfhi(unsigned w) { return __builtin_bit_cast(float, w & 0xffff0000u); }
__device__ __forceinline__ float wave_sum(float v) {
#pragma unroll
    for (int o = 1; o < 64; o <<= 1) v += __shfl_xor(v, o);
    return v;
}
__device__ __forceinline__ float wave_max(float v) {
#pragma unroll
    for (int o = 1; o < 64; o <<= 1) v = fmaxf(v, __shfl_xor(v, o));
    return v;
}
#define LDS_WAIT() asm volatile("s_waitcnt lgkmcnt(0)" ::: "memory")
#define VM_WAIT() asm volatile("s_waitcnt vmcnt(0)" ::: "memory")

namespace pg8 {
constexpr int BM = 256, BK = 64, HALF = 128, HTB = HALF * BK * 2, STAGE_BYTES = 8 * HTB, NXCD = 8, WGM = 8;
__host__ __device__ __forceinline__ int lds_byte(int r, int c) { const int st = (r >> 4) * 2 + (c >> 5), rr = r & 15, cc = c & 31, ob = rr * 64 + cc * 2; return st * 1024 + (ob ^ (((ob >> 9) & 1) << 5)); }
__host__ __device__ __forceinline__ void stage_rc(int b, int& R, int& C) { const int st = b / 1024, sb = b % 1024, swz = sb ^ (((sb >> 9) & 1) << 5); R = (st >> 1) * 16 + swz / 64; C = (st & 1) * 32 + (swz % 64) / 2; }
__host__ __device__ __forceinline__ int perm32(int rho) { const int n = rho >> 4, i = rho & 15; return 8 * (i >> 2) + 4 * n + (i & 3); }

struct Unit { const char* A; const char* B; int pm, pn, e, nvalid; };

__device__ __forceinline__ bool static_tile(int i, int G, int c, int nM, int nN, int& pm, int& pn) {
    const int nwg = nM * nN; const long L = (long)i * G + c; if (L >= nwg) return false;
    int wgid = (int)L; { const int q = nwg / NXCD, r = nwg % NXCD, xcd = wgid % NXCD, off = wgid / NXCD; wgid = (xcd < r ? xcd * (q + 1) : r * (q + 1) + (xcd - r) * q) + off; }
    const int nig = WGM * nN, gid = wgid / nig, fm = gid * WGM, gsz = (nM - fm) < WGM ? (nM - fm) : WGM;
    pm = fm + ((wgid % nig) % gsz); pn = (wgid % nig) / gsz; return true;
}
struct DenseOrder {
    const char* A; const char* Bt; int nM, nN, K, G, c;
    __device__ __forceinline__ bool next(int i, Unit& u) const {
        int pm, pn; if (!static_tile(i, G, c, nM, nN, pm, pn)) return false;
        u.pm = pm; u.pn = pn; u.e = 0; u.nvalid = 256; u.A = A + (size_t)pm * 256 * K * 2; u.B = Bt + (size_t)pn * 256 * K * 2; return true;
    }
    __device__ __forceinline__ unsigned row_off(const Unit&, int) const { return 0u; }
};

__device__ __forceinline__ unsigned cvt_pk_bf16(float lo, float hi) { unsigned r; asm volatile("v_cvt_pk_bf16_f32 %0, %1, %2" : "=v"(r) : "v"(lo), "v"(hi)); return r; }

template <class Epi, class Sched, bool ALIGN_EPI, bool GATHER, bool MID>
__device__ __forceinline__ void gemm_phase(LAS unsigned char* lds, const int K, const Sched& S, const Epi& E) {
    int tid_ = threadIdx.x; asm volatile("" : "+v"(tid_));
    const int tid = tid_, wid = __builtin_amdgcn_readfirstlane(tid >> 6), lane = tid & 63, wr = wid >> 2, wc = wid & 3, fr = lane & 15, fq = lane >> 4;
    const int nt = K / BK;
    int Rst[2], Cst[2]; unsigned voffB[2];
#pragma unroll
    for (int i = 0; i < 2; ++i) { int R, C; stage_rc(tid * 16 + i * 8192, R, C); Rst[i] = R; Cst[i] = C; const int Rb = Epi::PERM ? ((R & ~31) + perm32(R & 31)) : R; voffB[i] = (unsigned)(Rb * K + C) * 2u; }
    const size_t kstep = (size_t)(BK * 2);
    const size_t hstep = (size_t)HALF * K * 2;
    const unsigned ldsw = (unsigned)wid * 1024u;
    const int aoff = lds_byte(wr * 64 + fr, fq * 8), boff = lds_byte(wc * 32 + fr, fq * 8);
#define PG8_SA(b, h) (((b) * 2 + (h)) * HTB)
#define PG8_SB(b, h) ((4 + (b) * 2 + (h)) * HTB)
#define PG8_STAGE(bufoff, gbase, voff) do { _Pragma("unroll") for (int _i = 0; _i < 2; ++_i) \
        __builtin_amdgcn_global_load_lds((const unsigned*)((const char*)(gbase) + (voff)[_i]), (LAS unsigned*)(lds + (bufoff) + ldsw + _i * 8192), 16, 0, 0); } while (0)
#define PG8_LDA(dst, b, h) do { _Pragma("unroll") for (int m = 0; m < 4; ++m) _Pragma("unroll") for (int k = 0; k < 2; ++k) dst[m][k] = *(const LAS bf16x8*)(lds + PG8_SA(b, h) + aoff + m * 2048 + k * 1024); } while (0)
#define PG8_LDB(dst, b, h) do { _Pragma("unroll") for (int n = 0; n < 2; ++n) _Pragma("unroll") for (int k = 0; k < 2; ++k) dst[n][k] = *(const LAS bf16x8*)(lds + PG8_SB(b, h) + boff + n * 2048 + k * 1024); } while (0)
#define PG8_MMA(ai, bj, At, Bt) do { __builtin_amdgcn_s_setprio(1); _Pragma("unroll") for (int m = 0; m < 4; ++m) _Pragma("unroll") for (int n = 0; n < 2; ++n) _Pragma("unroll") for (int k = 0; k < 2; ++k) \
        acc[ai][bj][m][n] = __builtin_amdgcn_mfma_f32_16x16x32_bf16(Bt[n][k], At[m][k], acc[ai][bj][m][n], 0, 0, 0); __builtin_amdgcn_s_setprio(0); } while (0)
#define PG8_WAIT_V(n) asm volatile("s_waitcnt vmcnt(" #n ")" ::: "memory")
#define PG8_WAIT_L(n) asm volatile("s_waitcnt lgkmcnt(" #n ")" ::: "memory")
#define PG8_BAR __builtin_amdgcn_s_barrier()
#define PG8_SCHED __builtin_amdgcn_sched_barrier(0)
#define PG8_AOFFS(dst, u) do { _Pragma("unroll") for (int _h = 0; _h < 2; ++_h) _Pragma("unroll") for (int _i = 0; _i < 2; ++_i) { \
        if constexpr (GATHER) dst[_h][_i] = S.row_off(u, _h * HALF + Rst[_i]) + (unsigned)Cst[_i] * 2u; \
        else dst[_h][_i] = (unsigned)((_h * HALF + Rst[_i]) * K + Cst[_i]) * 2u; } \
        if constexpr (GATHER) { asm volatile("" : "+v"(dst[0][0]), "+v"(dst[0][1]), "+v"(dst[1][0]), "+v"(dst[1][1]) :: "memory"); } } while (0)
    Unit cur, nxt; int ui = 0;
    if (!S.next(0, cur)) return;
    bool has_next = S.next(1, nxt);
    unsigned vA[2][2], vN[2][2];
    PG8_AOFFS(vA, cur);
    if constexpr (GATHER) { if (has_next) { PG8_AOFFS(vN, nxt); } else {
#pragma unroll
        for (int h = 0; h < 2; ++h) { vN[h][0] = vA[h][0]; vN[h][1] = vA[h][1]; } } }
    f32x4 acc[2][2][4][2];
#pragma unroll
    for (int a = 0; a < 2; ++a)
#pragma unroll
        for (int b = 0; b < 2; ++b)
#pragma unroll
            for (int m = 0; m < 4; ++m)
#pragma unroll
                for (int n = 0; n < 2; ++n) acc[a][b][m][n] = (f32x4){0.f, 0.f, 0.f, 0.f};
    bf16x8 At[4][2], B0[2][2], B1[2][2];
    const char* cA = cur.A; const char* cB = cur.B;
    PG8_STAGE(PG8_SB(0, 0), cB, voffB); PG8_STAGE(PG8_SB(0, 1), cB + hstep, voffB); PG8_STAGE(PG8_SA(0, 0), cA, vA[0]); PG8_STAGE(PG8_SA(0, 1), cA, vA[1]);
    if (wr == 1) PG8_BAR;
    PG8_WAIT_V(2); PG8_BAR;
    PG8_STAGE(PG8_SB(1, 0), cB + kstep, voffB); PG8_STAGE(PG8_SA(1, 0), cA + kstep, vA[0]); PG8_STAGE(PG8_SB(1, 1), cB + hstep + kstep, voffB);
    PG8_WAIT_V(6); PG8_BAR;
    for (;;) {
        const char* nA = has_next ? nxt.A : cA; const char* nB = has_next ? nxt.B : cB;
#pragma unroll 1
        for (int t = 0; t < nt; t += 2) {
            const bool last = (t == nt - 2);
            if constexpr (MID) { if (t == nt / 2) { int frE = fr, fqE = fq; asm volatile("" : "+v"(frE), "+v"(fqE)); E.mid(acc, cur, wr, wc, frE, fqE); } }
            const char* a1 = cA + (size_t)(t + 1) * kstep;
            const char* a2 = last ? nA : cA + (size_t)(t + 2) * kstep; const char* b2 = last ? nB : cB + (size_t)(t + 2) * kstep;
            const char* a3 = a2 + kstep; const char* b3 = b2 + kstep;
            unsigned v2[2][2];
#pragma unroll
            for (int h = 0; h < 2; ++h) { if constexpr (GATHER) { v2[h][0] = last ? vN[h][0] : vA[h][0]; v2[h][1] = last ? vN[h][1] : vA[h][1]; } else { v2[h][0] = vA[h][0]; v2[h][1] = vA[h][1]; } }
            PG8_LDB(B0, 0, 0); PG8_LDB(B1, 0, 1); PG8_SCHED; PG8_LDA(At, 0, 0); PG8_STAGE(PG8_SA(1, 1), a1, vA[1]);
            PG8_WAIT_V(8); PG8_WAIT_L(0); PG8_BAR; PG8_MMA(0, 0, At, B0); PG8_MMA(0, 1, At, B1); PG8_BAR; PG8_SCHED;
            PG8_LDA(At, 0, 1); PG8_STAGE(PG8_SB(0, 0), b2, voffB); PG8_STAGE(PG8_SB(0, 1), b2 + hstep, voffB); PG8_STAGE(PG8_SA(0, 0), a2, v2[0]);
            PG8_WAIT_V(8); PG8_WAIT_L(0); PG8_BAR; PG8_MMA(1, 0, At, B0); PG8_MMA(1, 1, At, B1); PG8_BAR; PG8_SCHED;
            PG8_LDB(B0, 1, 0); PG8_LDB(B1, 1, 1); PG8_SCHED; PG8_LDA(At, 1, 0); PG8_STAGE(PG8_SA(0, 1), a2, v2[1]);
            PG8_WAIT_V(8); PG8_WAIT_L(0); PG8_BAR; PG8_MMA(0, 0, At, B0); PG8_MMA(0, 1, At, B1); PG8_BAR; PG8_SCHED;
            PG8_LDA(At, 1, 1); PG8_STAGE(PG8_SB(1, 0), b3, voffB); PG8_STAGE(PG8_SB(1, 1), b3 + hstep, voffB); PG8_STAGE(PG8_SA(1, 0), a3, v2[0]);
            PG8_WAIT_V(8); PG8_WAIT_L(0); PG8_BAR; PG8_MMA(1, 0, At, B0); PG8_MMA(1, 1, At, B1); PG8_BAR; PG8_SCHED;
        }
        if constexpr (ALIGN_EPI) { if (wr == 0) PG8_BAR; }
        { int frE = fr, fqE = fq; asm volatile("" : "+v"(frE), "+v"(fqE));
          E(acc, cur, wr, wc, frE, fqE); }
        if (!has_next) break;
#pragma unroll
        for (int a = 0; a < 2; ++a)
#pragma unroll
            for (int b = 0; b < 2; ++b)
#pragma unroll
                for (int m = 0; m < 4; ++m)
#pragma unroll
                    for (int n = 0; n < 2; ++n) acc[a][b][m][n] = (f32x4){0.f, 0.f, 0.f, 0.f};
        cur = nxt; cA = nA; cB = nB; ++ui;
        if constexpr (GATHER) {
#pragma unroll
            for (int h = 0; h < 2; ++h) { vA[h][0] = vN[h][0]; vA[h][1] = vN[h][1]; } }
        has_next = S.next(ui + 1, nxt);
        if constexpr (GATHER) { if (has_next) { PG8_AOFFS(vN, nxt); } }
        if constexpr (ALIGN_EPI) { if (wr == 1) PG8_BAR; }
    }
    PG8_WAIT_V(0);
    if constexpr (!ALIGN_EPI) { if (wr == 0) PG8_BAR; }
    PG8_BAR;
#undef PG8_SA
#undef PG8_SB
#undef PG8_STAGE
#undef PG8_LDA
#undef PG8_LDB
#undef PG8_MMA
#undef PG8_WAIT_V
#undef PG8_WAIT_L
#undef PG8_BAR
#undef PG8_SCHED
#undef PG8_AOFFS
}
}

struct Args { const float* in[25]; float* out; unsigned char* ws; int ph_lo, ph_hi, li, pad; };
struct Frame {
    LAS unsigned char* lds; unsigned char* ws; GAS unsigned* ctl;
    int tid, lane, wave, vcu, G;
    float* out; const __attribute__((address_space(4))) char* ka;
};
#define FIN(i) (((const float* const __attribute__((address_space(4)))*)F.ka)[i])
enum { I_X = 0, I_P, I_RELB, I_ATTN_NORM, I_W_IN, I_SWA_QN, I_SWA_KN, I_SINKS, I_MOBA_QN, I_MOBA_KN, I_SWA_ON, I_MOBA_ON, I_W_OUT, I_FFN_NORM,
       I_W_RG, I_B_RG, I_W_RE, I_B_RE, I_W_EG, I_W_EU, I_W_ED, I_PLE_NORM, I_W_PG, I_W_PP, I_PLE_ON };

struct TrItem { const float* src; bf16_t* dst; const float* gk; int N, K; };
__device__ __forceinline__ int map_in(int n0) { const int head = n0 >> 6, d = n0 & 63; return 256 * (head >> 2) + 128 * (d >> 5) + 32 * (head & 3) + (d & 31); }
__device__ __forceinline__ int map_gu(int n0, int up) { return 256 * (n0 >> 7) + 128 * up + (n0 & 127); }
constexpr int TI_IN = (DM / 64) * (INW / 32), TI_OUT = (DM / 64) * (DM / 32), TI_PG = TI_OUT, TI_PP = (PLE / 64) * (DM / 32);
constexpr int TI_G1 = (DM / 64) * (DEXP / 32), TI_D1 = (DEXP / 64) * (DM / 32);
constexpr int TI_TOTAL = TI_IN + TI_OUT + TI_PG + TI_PP + NEXP * (2 * TI_G1);
constexpr int TI_DOWN_BASE = 1 << 20, TI_DOWN = NEXP * TI_D1;
__device__ __forceinline__ void tr_decode(const Frame& F, int it, TrItem& d) {
    unsigned char* ws = F.ws;
    const float* W; bf16_t* WT; const float* g = nullptr; int K, N, mode = 0, up = 0; int r = it;
    if (it >= TI_DOWN_BASE) r = 1 << 28;
    if (r < TI_IN) { W = FIN(I_W_IN); WT = (bf16_t*)(ws + WS_WIN); K = DM; N = INW; g = FIN(I_ATTN_NORM); mode = 1; }
    else if ((r -= TI_IN) < TI_OUT) { W = FIN(I_W_OUT); WT = (bf16_t*)(ws + WS_WOUT); K = DM; N = DM; mode = 3; }
    else if ((r -= TI_OUT) < TI_PG) { W = FIN(I_W_PG); WT = (bf16_t*)(ws + WS_WPG); K = DM; N = DM; g = FIN(I_PLE_NORM); }
    else if ((r -= TI_PG) < TI_PP) { W = FIN(I_W_PP); WT = (bf16_t*)(ws + WS_WPP); K = PLE; N = DM; }
    else if (it >= TI_DOWN_BASE) { r = it - TI_DOWN_BASE; const int e = r / TI_D1; r -= e * TI_D1; W = FIN(I_W_ED) + (size_t)e * DEXP * DM; WT = (bf16_t*)(ws + WS_WD) + (size_t)e * DM * DEXP; K = DEXP; N = DM; }
    else { r -= TI_PP; const int e = r / (2 * TI_G1); r -= e * (2 * TI_G1);
        if (r < TI_G1) { W = FIN(I_W_EG) + (size_t)e * DM * DEXP; WT = (bf16_t*)(ws + WS_WGU) + (size_t)e * DM * DM; K = DM; N = DEXP; g = FIN(I_FFN_NORM); mode = 2; up = 0; }
        else { r -= TI_G1; W = FIN(I_W_EU) + (size_t)e * DM * DEXP; WT = (bf16_t*)(ws + WS_WGU) + (size_t)e * DM * DM; K = DM; N = DEXP; g = FIN(I_FFN_NORM); mode = 2; up = 1; } }
    const int nblk = N / 32, kb = r / nblk, nb = r % nblk, k0 = 64 * kb, n0 = 32 * nb;
    if (mode == 3) g = (k0 < 512) ? FIN(I_SWA_ON) : (FIN(I_MOBA_ON) - 512);
    const int drow0 = mode == 1 ? map_in(n0) : mode == 2 ? map_gu(n0, up) : n0;
    d.src = W + (size_t)k0 * N + n0; d.dst = WT + (size_t)drow0 * K + k0; d.gk = g ? g + k0 : nullptr; d.N = N; d.K = K;
}
__device__ __forceinline__ void tr_load(const TrItem& d, int lane, float (&v)[32], f32x4 (&gv)[2]) {
    const float* p = d.src + (size_t)(lane >> 5) * d.N + (lane & 31);
#pragma unroll
    for (int i = 0; i < 32; ++i) v[i] = p[(size_t)(2 * i) * d.N];
    const int c = lane & 7;
    if (d.gk) { gv[0] = *(const f32x4*)(d.gk + 8 * c); gv[1] = *(const f32x4*)(d.gk + 8 * c + 4); } else { gv[0] = (f32x4){1.f, 1.f, 1.f, 1.f}; gv[1] = gv[0]; }
}
__device__ __forceinline__ void tr_process(const TrItem& d, int lane, const float (&v)[32], const f32x4 (&gv)[2], LAS float* scr) {
#pragma unroll
    for (int i = 0; i < 32; ++i) scr[(2 * i + (lane >> 5)) * 33 + (lane & 31)] = v[i];
    LDS_WAIT(); asm volatile("" ::: "memory");
    const int c = lane & 7;
#pragma unroll
    for (int j = 0; j < 4; ++j) { const int n = (lane >> 3) + 8 * j; const LAS float* sp = scr + (8 * c) * 33 + n;
        u32x4 o; o.x = pk2(sp[0 * 33] * gv[0][0], sp[1 * 33] * gv[0][1]); o.y = pk2(sp[2 * 33] * gv[0][2], sp[3 * 33] * gv[0][3]); o.z = pk2(sp[4 * 33] * gv[1][0], sp[5 * 33] * gv[1][1]); o.w = pk2(sp[6 * 33] * gv[1][2], sp[7 * 33] * gv[1][3]);
        *(GAS u32x4*)(d.dst + (size_t)n * d.K + 8 * c) = o; }
    LDS_WAIT(); asm volatile("" ::: "memory");
}

__constant__ unsigned char c_bucket[128] = {0,1,2,3,4,5,6,7,8,9,10,11,12,13,14,15,16,16,16,17,17,18,18,18,19,19,19,20,20,20,20,21,21,21,21,22,22,22,22,22,23,23,23,23,23,23,24,24,24,24,24,24,25,25,25,25,25,25,25,26,26,26,26,26,26,26,26,27,27,27,27,27,27,27,27,27,27,28,28,28,28,28,28,28,28,28,28,29,29,29,29,29,29,29,29,29,29,29,29,30,30,30,30,30,30,30,30,30,30,30,30,30,30,31,31,31,31,31,31,31,31,31,31,31,31,31,31,31};

__device__ __forceinline__ void tr_stream(Frame& F, LAS float* scr, int first, int step, int count, int base) {
    TrItem cur, nxt; float v[32], vn[32]; f32x4 gv[2], gn[2];
    int it = first; bool have = it < count;
    if (have) { tr_decode(F, base + it, cur); tr_load(cur, F.lane, v, gv); }
    while (have) {
        const int itn = it + step; const bool hn = itn < count;
        if (hn) { tr_decode(F, base + itn, nxt); tr_load(nxt, F.lane, vn, gn); }
        tr_process(cur, F.lane, v, gv, scr);
        cur = nxt; gv[0] = gn[0]; gv[1] = gn[1];
#pragma unroll
        for (int i = 0; i < 32; ++i) v[i] = vn[i];
        it = itn; have = hn;
    }
}
__device__ __forceinline__ void p0_prologue(Frame& F) {
    LAS float* scr = (LAS float*)(F.lds + F.wave * 16384);
    const int gw = F.vcu * NWAVES + F.wave, NGW = F.G * NWAVES;
    tr_stream(F, scr, gw, NGW, TI_TOTAL, 0);
    const float* x = FIN(I_X); bf16_t* xb = (bf16_t*)(F.ws + WS_XB); float* rs1 = (float*)(F.ws + WS_RS1);
    for (int m = gw; m < T; m += 2 * NGW) {
        const int m2 = m + NGW; const bool h2 = m2 < T;
        const GAS f32x4* xr = (const GAS f32x4*)(x + (size_t)m * DM) + F.lane; const GAS f32x4* xr2 = (const GAS f32x4*)(x + (size_t)(h2 ? m2 : m) * DM) + F.lane;
        f32x4 v[4], u[4]; float s = 0.f, s2 = 0.f;
#pragma unroll
        for (int j = 0; j < 4; ++j) { v[j] = xr[64 * j]; u[j] = xr2[64 * j]; }
#pragma unroll
        for (int j = 0; j < 4; ++j) { s += (v[j].x * v[j].x + v[j].y * v[j].y) + (v[j].z * v[j].z + v[j].w * v[j].w); s2 += (u[j].x * u[j].x + u[j].y * u[j].y) + (u[j].z * u[j].z + u[j].w * u[j].w); }
        s = wave_sum(s); s2 = wave_sum(s2);
        GAS u32x2* o8 = (GAS u32x2*)(xb + (size_t)m * DM) + F.lane;
#pragma unroll
        for (int j = 0; j < 4; ++j) { u32x2 w; w.x = pk2(v[j].x, v[j].y); w.y = pk2(v[j].z, v[j].w); o8[64 * j] = w; }
        if (F.lane == 0) rs1[m] = 1.0f / sqrtf(s * (1.0f / DM) + EPS);
        if (h2) { GAS u32x2* o9 = (GAS u32x2*)(xb + (size_t)m2 * DM) + F.lane;
#pragma unroll
            for (int j = 0; j < 4; ++j) { u32x2 w; w.x = pk2(u[j].x, u[j].y); w.y = pk2(u[j].z, u[j].w); o9[64 * j] = w; }
            if (F.lane == 0) rs1[m2] = 1.0f / sqrtf(s2 * (1.0f / DM) + EPS); }
    }
    { const GAS f32x4* p4 = (const GAS f32x4*)FIN(I_P); GAS u32x2* o = (GAS u32x2*)(F.ws + WS_PB); const int n4 = T * PLE / 4;
      for (int i = (F.vcu * NTHREADS + F.tid); i < n4; i += F.G * NTHREADS) { const f32x4 v = p4[i]; u32x2 w; w.x = pk2(v.x, v.y); w.y = pk2(v.z, v.w); o[i] = w; } }
    { bf16_t* Wt = (bf16_t*)(F.ws + WS_WR); const float* g = FIN(I_FFN_NORM); const float* wrg = FIN(I_W_RG); const float* wre = FIN(I_W_RE);
      for (int i = (F.vcu * NTHREADS + F.tid); i < 96 * DM; i += F.G * NTHREADS) { const int n = i / DM, c = i % DM; int o = -1; bool lo = false;
          if (n < 32) o = n; else if (n < 64) { o = n - 32; lo = true; } else if (n < 68) o = 32 + (n - 64); else if (n < 72) { o = 32 + (n - 68); lo = true; }
          unsigned short r = 0;
          if (o >= 0) { const float w = g[c] * ((o < 4) ? wrg[c * 4 + o] : wre[c * 32 + (o - 4)]); const unsigned h = f2bf(w); r = (unsigned short)h;
              if (lo) r = (unsigned short)f2bf(w - bf2f((unsigned short)h)); }
          Wt[i] = r; } }
    { float* tab = (float*)(F.ws + WS_BIAS);
      for (int i = (F.vcu * NTHREADS + F.tid); i < 16 * 132; i += F.G * NTHREADS) { const int hh = i / 132, dd = i % 132; const int bk = dd < 128 ? (int)c_bucket[dd] : 31;
          tab[i] = FIN(I_RELB)[bk * NHQ + hh] * LOG2E; } }
}

using pg8::Unit;
struct EpiQKV {
    static constexpr bool PERM = true;
    bf16_t* qkv; const float* rs1; const float* gq_a; const float* gk_a; const float* gq_b; const float* gk_b; float* kmp;
    __device__ __forceinline__ void operator()(const f32x4 (&acc)[2][2][4][2], const Unit& u, int wr, int wc, int fr, int fq) const {
        const int head = 4 * u.pn + wc;
        const float* gain = nullptr; float qs = 1.f; bool kmean = false;
        if (head < 8) { gain = gq_a; qs = QSCALE; } else if (head < 10) { gain = gk_a; } else if (head < 12) {} else if (head < 20) { gain = gq_b; qs = QSCALE; } else if (head < 22) { gain = gk_b; kmean = true; }
        f32x4 gv[2][2];
#pragma unroll
        for (int bj = 0; bj < 2; ++bj)
#pragma unroll
            for (int n = 0; n < 2; ++n) { if (gain) { gv[bj][n] = *(const f32x4*)(gain + 32 * bj + 8 * fq + 4 * n) * qs; } else gv[bj][n] = (f32x4){1.f, 1.f, 1.f, 1.f}; }
        f32x4 ks[2][2];
#pragma unroll
        for (int bj = 0; bj < 2; ++bj)
#pragma unroll
            for (int n = 0; n < 2; ++n) ks[bj][n] = (f32x4){0.f, 0.f, 0.f, 0.f};
        float rsv[2][4];
#pragma unroll
        for (int ai = 0; ai < 2; ++ai)
#pragma unroll
            for (int m = 0; m < 4; ++m) rsv[ai][m] = rs1[u.pm * 256 + ai * 128 + wr * 64 + m * 16 + fr];
        asm volatile("" ::: "memory");
#pragma unroll
        for (int ai = 0; ai < 2; ++ai)
#pragma unroll
            for (int m = 0; m < 4; ++m) {
                const int row = u.pm * 256 + ai * 128 + wr * 64 + m * 16 + fr; const float rs = rsv[ai][m];
                f32x4 v[2][2]; float ss = 0.f;
#pragma unroll
                for (int bj = 0; bj < 2; ++bj)
#pragma unroll
                    for (int n = 0; n < 2; ++n) { v[bj][n] = acc[ai][bj][m][n] * rs; const f32x4 q = v[bj][n] * v[bj][n]; ss += (q[0] + q[1]) + (q[2] + q[3]); }
                float rn = 1.f;
                if (gain) { ss += __shfl_xor(ss, 16); ss += __shfl_xor(ss, 32); rn = 1.0f / sqrtf(ss * (1.0f / HD) + EPS); }
                bf16_t* rowp = qkv + (size_t)row * INW + 64 * head + 8 * fq;
#pragma unroll
                for (int bj = 0; bj < 2; ++bj) { const f32x4 v0 = v[bj][0] * rn * gv[bj][0], v1 = v[bj][1] * rn * gv[bj][1];
                    if (kmean) { ks[bj][0] += v0; ks[bj][1] += v1; }
                    u32x4 w; w.x = pg8::cvt_pk_bf16(v0[0], v0[1]); w.y = pg8::cvt_pk_bf16(v0[2], v0[3]); w.z = pg8::cvt_pk_bf16(v1[0], v1[1]); w.w = pg8::cvt_pk_bf16(v1[2], v1[3]);
                    *(u32x4*)(rowp + 32 * bj) = w; }
            }
        if (kmean) {
#pragma unroll
            for (int bj = 0; bj < 2; ++bj)
#pragma unroll
                for (int n = 0; n < 2; ++n)
#pragma unroll
                    for (int i = 0; i < 4; ++i) { float s = ks[bj][n][i]; s += __shfl_xor(s, 1); s += __shfl_xor(s, 2); s += __shfl_xor(s, 4); s += __shfl_xor(s, 8);
                        if (fr == 0) kmp[((u.pm * 2 + wr) * 2 + (head - 20)) * 64 + 32 * bj + 8 * fq + 4 * n + i] = s; }
        }
    }
};
struct EpiProj {
    static constexpr bool PERM = true;
    bf16_t* praw; float* ssqp;
    __device__ __forceinline__ void operator()(const f32x4 (&acc)[2][2][4][2], const Unit& u, int wr, int wc, int fr, int fq) const {
#pragma unroll
        for (int ai = 0; ai < 2; ++ai)
#pragma unroll
            for (int m = 0; m < 4; ++m) {
                const int row = u.pm * 256 + ai * 128 + wr * 64 + m * 16 + fr; float ss = 0.f;
                bf16_t* rowp = praw + (size_t)row * DM + u.pn * 256 + wc * 32 + 8 * fq;
#pragma unroll
                for (int bj = 0; bj < 2; ++bj) { const f32x4 v0 = acc[ai][bj][m][0], v1 = acc[ai][bj][m][1];
                    const f32x4 q = v0 * v0 + v1 * v1; ss += (q[0] + q[1]) + (q[2] + q[3]);
                    u32x4 w; w.x = pg8::cvt_pk_bf16(v0[0], v0[1]); w.y = pg8::cvt_pk_bf16(v0[2], v0[3]); w.z = pg8::cvt_pk_bf16(v1[0], v1[1]); w.w = pg8::cvt_pk_bf16(v1[2], v1[3]);
                    *(u32x4*)(rowp + 128 * bj) = w; }
                ss += __shfl_xor(ss, 16); ss += __shfl_xor(ss, 32);
                if (fq == 0) ssqp[(size_t)row * 16 + u.pn * 4 + wc] = ss;
            }
    }
};
struct EpiOut {
    static constexpr bool PERM = true;
    bf16_t* x1b; const LAS f32x2* tab;
    __device__ __forceinline__ void mid(f32x4 (&acc)[2][2][4][2], const Unit& u, int wr, int wc, int fr, int fq) const {
#pragma unroll
        for (int ai = 0; ai < 2; ++ai)
#pragma unroll
            for (int m = 0; m < 4; ++m) { const f32x2 sc = tab[ai * 128 + wr * 64 + m * 16 + fr]; const float r = sc.x / sc.y;
#pragma unroll
                for (int bj = 0; bj < 2; ++bj)
#pragma unroll
                    for (int n = 0; n < 2; ++n) acc[ai][bj][m][n] *= r; }
    }
    __device__ __forceinline__ void operator()(const f32x4 (&acc)[2][2][4][2], const Unit& u, int wr, int wc, int fr, int fq) const {
        const int col0 = u.pn * 256 + wc * 32 + 8 * fq;
#pragma unroll
        for (int ai = 0; ai < 2; ++ai) {
            u32x4 xv[4][2];
#pragma unroll
            for (int m = 0; m < 4; ++m) { const size_t off = (size_t)(u.pm * 256 + ai * 128 + wr * 64 + m * 16 + fr) * DM + col0;
#pragma unroll
                for (int bj = 0; bj < 2; ++bj) xv[m][bj] = *(const u32x4*)(x1b + off + bj * 128); }
            asm volatile("" ::: "memory");
#pragma unroll
            for (int m = 0; m < 4; ++m) { const int r = ai * 128 + wr * 64 + m * 16 + fr; const float sb = tab[r].y; const size_t off = (size_t)(u.pm * 256 + r) * DM + col0;
#pragma unroll
                for (int bj = 0; bj < 2; ++bj) { const u32x4 xw = xv[m][bj];
                    const f32x4 o0 = (f32x4){bflo(xw.x), bfhi(xw.x), bflo(xw.y), bfhi(xw.y)} + acc[ai][bj][m][0] * sb, o1 = (f32x4){bflo(xw.z), bfhi(xw.z), bflo(xw.w), bfhi(xw.w)} + acc[ai][bj][m][1] * sb;
                    u32x4 w; w.x = pg8::cvt_pk_bf16(o0[0], o0[1]); w.y = pg8::cvt_pk_bf16(o0[2], o0[3]); w.z = pg8::cvt_pk_bf16(o1[0], o1[1]); w.w = pg8::cvt_pk_bf16(o1[2], o1[3]);
                    *(u32x4*)(x1b + off + bj * 128) = w; } }
            asm volatile("" ::: "memory");
        }
    }
};
struct MoeOrder {
    const char* A; const char* Bt; const LAS int* tb; const unsigned* cnt; const unsigned* list; int K; size_t wstride; size_t arow_bytes; int G, c; bool gather;
    __device__ __forceinline__ bool next(int i, Unit& u) const {
        const int NT = tb[NEXP]; const int nwg = NT * 4; const long L = (long)i * G + c; if (L >= nwg) return false;
        int wgid = (int)L; { const int q = nwg / 8, r = nwg % 8, xcd = wgid % 8, off = wgid / 8; wgid = (xcd < r ? xcd * (q + 1) : r * (q + 1) + (xcd - r) * q) + off; }
        const int gt = wgid >> 2, pn = wgid & 3; int e = 0;
#pragma unroll 1
        while (e < NEXP - 1 && gt >= tb[e + 1]) ++e;
        const int lt = gt - tb[e]; const int nv = (int)cnt[e] - lt * 256;
        u.pm = gt; u.pn = pn; u.e = e * 16384 + lt * 256; u.nvalid = nv < 256 ? nv : 256;
        u.A = gather ? A : A + (size_t)gt * 256 * arow_bytes; u.B = Bt + (size_t)e * wstride + (size_t)pn * 256 * K * 2; return true;
    }
    __device__ __forceinline__ unsigned row_off(const Unit& u, int r) const {
        const unsigned ent = (r < u.nvalid) ? list[u.e + r] : 0u; return (ent >> 1) * (unsigned)arow_bytes;
    }
};
struct EpiG1 {
    static constexpr bool PERM = true;
    bf16_t* H; const float* r2; const unsigned* list;
    __device__ __forceinline__ void operator()(const f32x4 (&acc)[2][2][4][2], const Unit& u, int wr, int wc, int fr, int fq) const {
        unsigned entv[2][4]; float rsv[2][4];
#pragma unroll
        for (int ai = 0; ai < 2; ++ai)
#pragma unroll
            for (int m = 0; m < 4; ++m) { const int r = ai * 128 + wr * 64 + m * 16 + fr; entv[ai][m] = (r < u.nvalid) ? list[u.e + r] : 0u; }
#pragma unroll
        for (int ai = 0; ai < 2; ++ai)
#pragma unroll
            for (int m = 0; m < 4; ++m) rsv[ai][m] = r2[entv[ai][m] >> 1];
        asm volatile("" ::: "memory");
#pragma unroll
        for (int ai = 0; ai < 2; ++ai)
#pragma unroll
            for (int m = 0; m < 4; ++m) { const int r = ai * 128 + wr * 64 + m * 16 + fr; const float rs = rsv[ai][m];
                float h[8];
#pragma unroll
                for (int n = 0; n < 2; ++n)
#pragma unroll
                    for (int i = 0; i < 4; ++i) { const float g = acc[ai][0][m][n][i] * rs, up = acc[ai][1][m][n][i] * rs; h[4 * n + i] = g / (1.0f + __builtin_amdgcn_exp2f(-g * LOG2E)) * up; }
                u32x4 w; w.x = pg8::cvt_pk_bf16(h[0], h[1]); w.y = pg8::cvt_pk_bf16(h[2], h[3]); w.z = pg8::cvt_pk_bf16(h[4], h[5]); w.w = pg8::cvt_pk_bf16(h[6], h[7]);
                *(u32x4*)(H + (size_t)(u.pm * 256 + r) * DEXP + u.pn * 128 + wc * 32 + 8 * fq) = w; }
    }
};
struct EpiG2 {
    static constexpr bool PERM = true;
    bf16_t* Y; const unsigned* list;
    __device__ __forceinline__ void operator()(const f32x4 (&acc)[2][2][4][2], const Unit& u, int wr, int wc, int fr, int fq) const {
        unsigned entv[2][4];
#pragma unroll
        for (int ai = 0; ai < 2; ++ai)
#pragma unroll
            for (int m = 0; m < 4; ++m) { const int r = ai * 128 + wr * 64 + m * 16 + fr; entv[ai][m] = (r < u.nvalid) ? list[u.e + r] : 0u; }
        asm volatile("" ::: "memory");
#pragma unroll
        for (int ai = 0; ai < 2; ++ai)
#pragma unroll
            for (int m = 0; m < 4; ++m) { const int r = ai * 128 + wr * 64 + m * 16 + fr;
                if (r < u.nvalid) { const unsigned ent = entv[ai][m]; bf16_t* rowp = Y + (size_t)ent * DM + u.pn * 256 + wc * 32 + 8 * fq;
#pragma unroll
                    for (int bj = 0; bj < 2; ++bj) { const f32x4 v0 = acc[ai][bj][m][0], v1 = acc[ai][bj][m][1];
                        u32x4 w; w.x = pg8::cvt_pk_bf16(v0[0], v0[1]); w.y = pg8::cvt_pk_bf16(v0[2], v0[3]); w.z = pg8::cvt_pk_bf16(v1[0], v1[1]); w.w = pg8::cvt_pk_bf16(v1[2], v1[3]);
                        *(u32x4*)(rowp + 128 * bj) = w; } } }
    }
};
struct EpiFinal {
    static constexpr bool PERM = false;
    float* out; const bf16_t* x2b; const bf16_t* praw; const float* gout; const LAS f32x2* tab;
    __device__ __forceinline__ void operator()(const f32x4 (&acc)[2][2][4][2], const Unit& u, int wr, int wc, int fr, int fq) const {
        const int col0 = u.pn * 256 + wc * 32 + 4 * fq;
        f32x4 gv[2][2];
#pragma unroll
        for (int bj = 0; bj < 2; ++bj)
#pragma unroll
            for (int n = 0; n < 2; ++n) gv[bj][n] = *(const f32x4*)(gout + col0 + bj * 128 + n * 16);
#pragma unroll
        for (int am = 0; am < 4; ++am) { const int ai = am >> 1, mb = 2 * (am & 1);
            u32x2 xw[2][2][2], pw[2][2][2];
#pragma unroll
            for (int mm = 0; mm < 2; ++mm) { const size_t off = (size_t)(u.pm * 256 + ai * 128 + wr * 64 + (mb + mm) * 16 + fr) * DM + col0;
#pragma unroll
                for (int bj = 0; bj < 2; ++bj)
#pragma unroll
                    for (int n = 0; n < 2; ++n) { xw[mm][bj][n] = *(const u32x2*)(x2b + off + bj * 128 + n * 16); pw[mm][bj][n] = *(const u32x2*)(praw + off + bj * 128 + n * 16); } }
            asm volatile("" ::: "memory");
#pragma unroll
            for (int mm = 0; mm < 2; ++mm) { const int m = mb + mm; const int r = ai * 128 + wr * 64 + m * 16 + fr; const f32x2 sc = tab[r]; const size_t off = (size_t)(u.pm * 256 + r) * DM + col0;
#pragma unroll
                for (int bj = 0; bj < 2; ++bj)
#pragma unroll
                    for (int n = 0; n < 2; ++n) { const u32x2 a = xw[mm][bj][n], p = pw[mm][bj][n];
                        const f32x4 xv = (f32x4){bflo(a.x), bfhi(a.x), bflo(a.y), bfhi(a.y)}, pv = (f32x4){bflo(p.x), bfhi(p.x), bflo(p.y), bfhi(p.y)}; f32x4 o;
#pragma unroll
                        for (int i = 0; i < 4; ++i) { const float z = acc[ai][bj][m][n][i] * sc.x; const float sg = 1.0f / (1.0f + __builtin_amdgcn_exp2f(-z * LOG2E)); o[i] = xv[i] + sg * (pv[i] * sc.y * gv[bj][n][i]); }
                        *(f32x4*)(out + off + bj * 128 + n * 16) = o; }
                asm volatile("" ::: "memory"); }
        }
    }
};

namespace att {
typedef float f32x16 __attribute__((ext_vector_type(16)));
typedef short s16x4 __attribute__((ext_vector_type(4)));
constexpr int NSLOT = 6, KBUF = 0, VBUF = NSLOT * 8192, LUT_OFF = 2 * NSLOT * 8192, KM_OFF = LUT_OFF + 2048;
constexpr float NEGBIG = -1e30f, MFLOOR = -1e20f;
__device__ __forceinline__ s16x4 vtr(const LAS unsigned char* p) { return __builtin_bit_cast(s16x4, __builtin_amdgcn_ds_read_tr16_b64_v4i16((LAS s16x4*)p)); }
__device__ __forceinline__ unsigned pkbf(float lo, float hi) { f32x2 v = {lo, hi}; typedef __bf16 bf2 __attribute__((ext_vector_type(2))); bf2 b = __builtin_convertvector(v, bf2); return __builtin_bit_cast(unsigned, b); }

template <int TYPE>
__device__ __forceinline__ void attn_unit(Frame& F, int b, int hlp, int n) {
    const int tid = F.tid, lane = F.lane, w = F.wave, r32 = lane & 31, hi = lane >> 5;
    const int hl = TYPE ? hlp : 2 * hlp + (w >> 2);
    const int hh = TYPE * 8 + hl, g = hl >> 2;
    const int colQ = (TYPE ? C_QB : C_QA) + 64 * hl, colK = (TYPE ? C_KB : C_KA) + 64 * g, colV = (TYPE ? C_VB : C_VA) + 64 * g;
    const bf16_t* qkv = (const bf16_t*)(F.ws + WS_QKV); bf16_t* O = (bf16_t*)(F.ws + WS_O); float* ssq = (float*)(F.ws + WS_SSQ);
    const float* tab = (const float*)(F.ws + WS_BIAS); const float* kmp = (const float*)(F.ws + WS_KMP);
    const size_t rowb = (size_t)b * SEQ;
    LAS unsigned char* L = F.lds; LAS float* lut = (LAS float*)(L + LUT_OFF) + (TYPE ? 0 : 316 * (w >> 2)); LAS float* kml = (LAS float*)(L + KM_OFF);
    const int q0w = TYPE ? 256 * n + 32 * w : 128 * n + 32 * (w & 3);
    const int t_lo = TYPE ? 0 : (2 * n - 2 > 0 ? 2 * n - 2 : 0), t_hi = TYPE ? 4 * n + 3 : 2 * n + 1;
    __syncthreads();
    for (int e = tid; e < (TYPE ? 316 : 632); e += NTHREADS) { const int ti = TYPE ? e : e % 316, hx = TYPE ? hh : 2 * hlp + e / 316; const int dist = 221 - ti; float v;
        if (dist < 0) v = NEGBIG; else if (dist < 128) v = tab[hx * 132 + dist] - (TYPE ? tab[hx * 132 + 128] : 0.f); else v = TYPE ? 0.f : NEGBIG;
        ((LAS float*)(L + LUT_OFF))[e] = v; }
    if (TYPE) { const int nb = tid >> 6, d = tid & 63; float v = 0.f;
        if (nb < n) { const int pm = b * 8 + nb; v = kmp[((pm * 2 + 0) * 2 + g) * 64 + d] + kmp[((pm * 2 + 1) * 2 + g) * 64 + d]; }
        kml[tid] = v; }
    bf16x8 qf[4];
    { const bf16_t* qp = qkv + (rowb + q0w + r32) * INW + colQ + 8 * hi;
#pragma unroll
      for (int d0 = 0; d0 < 4; ++d0) qf[d0] = *(const bf16x8*)(qp + 16 * d0); }
    const int srow = 8 * w + (lane >> 3);
    const bf16_t* kg = qkv + (rowb + srow) * INW + colK + 8 * ((lane & 7) ^ ((srow >> 1) & 7));
    const bf16_t* vg = qkv + (rowb + srow) * INW + colV + 8 * ((lane & 7) ^ (((srow >> 1) & 1) << 2));
    const int ntl = t_hi - t_lo + 1;
#define TILE_OF(i) (TYPE ? ((i) < 4 ? 4 * n + (i) : (i) - 4) : t_lo + (i))
#define STAGE(ti, slot) do { const int ti_ = (ti) < ntl ? (ti) : ntl - 1; const size_t go_ = (size_t)TILE_OF(ti_) * 64 * INW; \
        __builtin_amdgcn_global_load_lds((const unsigned*)(kg + go_), (LAS unsigned*)(L + KBUF + (slot) * 8192 + w * 1024), 16, 0, 0); \
        __builtin_amdgcn_global_load_lds((const unsigned*)(vg + go_), (LAS unsigned*)(L + VBUF + (slot) * 8192 + w * 1024), 16, 0, 0); } while (0)
    STAGE(0, 0); STAGE(1, 1); STAGE(2, 2); STAGE(3, 3);
    asm volatile("s_waitcnt vmcnt(4)" ::: "memory");
    asm volatile("s_waitcnt lgkmcnt(0)" ::: "memory"); __builtin_amdgcn_s_barrier(); asm volatile("" ::: "memory");
    unsigned sel = 0u;
    if (TYPE) {
        float gate[8];
#pragma unroll
        for (int nb = 0; nb < 8; ++nb) gate[nb] = 0.f;
#pragma unroll
        for (int d0 = 0; d0 < 4; ++d0) { float q8[8];
#pragma unroll
            for (int j = 0; j < 8; ++j) q8[j] = bf2f((unsigned short)qf[d0][j]);
#pragma unroll
            for (int nb = 0; nb < 7; ++nb) if (nb < n) { const f32x4 k0 = *(const LAS f32x4*)(kml + nb * 64 + 16 * d0 + 8 * hi), k1 = *(const LAS f32x4*)(kml + nb * 64 + 16 * d0 + 8 * hi + 4);
                gate[nb] += (q8[0] * k0[0] + q8[1] * k0[1]) + (q8[2] * k0[2] + q8[3] * k0[3]) + (q8[4] * k1[0] + q8[5] * k1[1]) + (q8[6] * k1[2] + q8[7] * k1[3]); } }
#pragma unroll
        for (int nb = 0; nb < 7; ++nb) gate[nb] += __shfl_xor(gate[nb], 32);
        const int nsel = n < 3 ? n : 3;
        for (int k = 0; k < nsel; ++k) { float best = -3e38f; int bi = 0;
#pragma unroll
            for (int nb = 0; nb < 7; ++nb) { const bool ok = (nb < n) && !((sel >> nb) & 1u) && (gate[nb] > best); if (ok) { best = gate[nb]; bi = nb; } }
            sel |= 1u << bi; }
    }
    float m = TYPE ? 0.f : FIN(I_SINKS)[hl] * LOG2E, l = (TYPE == 0 && hi == 0) ? 1.f : 0.f;
    f32x16 negm;
#pragma unroll
    for (int r = 0; r < 16; ++r) negm[r] = -m;
    f32x16 o0 = {}, o1 = {};
    const int qpos = q0w + r32;
    const int kroff = r32 * 128;  const int ksw = (r32 >> 1) & 7;
    const int q_ = (lane & 15) >> 2, p_ = lane & 3, sw = (q_ >> 1) & 1, clow = 2 * ((lane >> 4) & 1) + (p_ >> 1);
    const int vrow = (4 * hi + q_) * 128 + (p_ & 1) * 8;
    const int vb0 = vrow + ((4 * (0 ^ sw) + clow) << 4), vb1 = vrow + ((4 * (1 ^ sw) + clow) << 4);
    const int vaddr0 = (int)(unsigned)(unsigned long)(L + VBUF) + vb0, vaddr1 = (int)(unsigned)(unsigned long)(L + VBUF) + vb1;
    constexpr float THR = 8.0f;
#define ATT_STEP(IDX, SLOT) do { const int i = (IDX);         const int kt = TILE_OF(i); const int cur = (SLOT); \
        const int k0 = 64 * kt; const int dmax = q0w + 31 - k0, dmin = q0w - k0 - 63; \
        bool active, near, mine = true; \
        if (TYPE == 0) { active = (dmax >= 0) && (dmin <= 127); near = true; } \
        else if (kt >= 4 * n) { active = dmax >= 0; near = dmin < 128; } \
        else { mine = (sel >> (kt >> 2)) & 1u; active = __ballot(mine) != 0ull; near = dmin < 128; } \
        if (active) { \
            const LAS unsigned char* Kb = L + KBUF + cur * 8192; const LAS unsigned char* Vb = L + VBUF + cur * 8192; \
            f32x16 p0, p1, c = negm; \
            if (TYPE && kt < 4 * n) { \
        _Pragma("unroll") \
                for (int r = 0; r < 16; ++r) c[r] = mine ? negm[r] : NEGBIG; } \
            { const int co = ((0 + hi) ^ ksw) << 4; const bf16x8 ka = *(const LAS bf16x8*)(Kb + kroff + co), kb2 = *(const LAS bf16x8*)(Kb + 4096 + kroff + co); \
              p0 = __builtin_amdgcn_mfma_f32_32x32x16_bf16(ka, qf[0], c, 0, 0, 0); p1 = __builtin_amdgcn_mfma_f32_32x32x16_bf16(kb2, qf[0], c, 0, 0, 0); } \
        _Pragma("unroll") \
            for (int d0 = 1; d0 < 4; ++d0) { const int co = ((2 * d0 + hi) ^ ksw) << 4; \
                const bf16x8 ka = *(const LAS bf16x8*)(Kb + kroff + co), kb2 = *(const LAS bf16x8*)(Kb + 4096 + kroff + co); \
                p0 = __builtin_amdgcn_mfma_f32_32x32x16_bf16(ka, qf[d0], p0, 0, 0, 0); p1 = __builtin_amdgcn_mfma_f32_32x32x16_bf16(kb2, qf[d0], p1, 0, 0, 0); } \
            if (near) { const LAS float* lp = lut + (221 - (qpos - k0 - 4 * hi)); \
        _Pragma("unroll") \
                for (int r = 0; r < 16; ++r) { const int ko = (r & 3) + 8 * (r >> 2); p0[r] += lp[ko]; p1[r] += lp[32 + ko]; } } \
            float mx = __builtin_fmaxf(__builtin_fmaxf(p0[0], p1[0]), p0[1]); \
        _Pragma("unroll") \
            for (int r = 1; r < 16; ++r) mx = (r == 1) ? __builtin_fmaxf(mx, p1[1]) : __builtin_fmaxf(__builtin_fmaxf(mx, p0[r]), p1[r]); \
            mx = __builtin_fmaxf(mx, __shfl_xor(mx, 32)); \
            const bool first = (TYPE == 1) && (i == 0); \
            const float delta = first ? mx : (mx > THR ? mx : 0.f); \
            if (__ballot(delta != 0.f) != 0ull) { \
                m += delta; const float alpha = __builtin_amdgcn_exp2f(-delta); l *= alpha; \
        _Pragma("unroll") \
                for (int r = 0; r < 16; ++r) { o0[r] *= alpha; o1[r] *= alpha; negm[r] = -m; p0[r] -= delta; p1[r] -= delta; } \
            } \
            float ps = 0.f; \
        _Pragma("unroll") \
            for (int r = 0; r < 16; ++r) { p0[r] = __builtin_amdgcn_exp2f(p0[r]); p1[r] = __builtin_amdgcn_exp2f(p1[r]); ps += p0[r] + p1[r]; } \
            l += ps; \
            s16x4 ta[4][2], tc[4][2];                                    \
        _Pragma("unroll") \
            for (int s = 0; s < 4; ++s) { \
                asm volatile("ds_read_b64_tr_b16 %0, %1 offset:%c2" : "=&v"(ta[s][0]) : "v"(vaddr0 + cur * 8192), "i"(s * 2048) : "memory"); \
                asm volatile("ds_read_b64_tr_b16 %0, %1 offset:%c2" : "=&v"(ta[s][1]) : "v"(vaddr0 + cur * 8192), "i"(s * 2048 + 1024) : "memory"); \
                asm volatile("ds_read_b64_tr_b16 %0, %1 offset:%c2" : "=&v"(tc[s][0]) : "v"(vaddr1 + cur * 8192), "i"(s * 2048) : "memory"); \
                asm volatile("ds_read_b64_tr_b16 %0, %1 offset:%c2" : "=&v"(tc[s][1]) : "v"(vaddr1 + cur * 8192), "i"(s * 2048 + 1024) : "memory"); } \
            asm volatile("s_waitcnt lgkmcnt(0)" ::: "memory"); __builtin_amdgcn_sched_barrier(0); \
        _Pragma("unroll") \
            for (int s = 0; s < 4; ++s) { \
                u32x4 pw; \
                if (s < 2) { pw.x = pkbf(p0[8 * s + 0], p0[8 * s + 1]); pw.y = pkbf(p0[8 * s + 2], p0[8 * s + 3]); pw.z = pkbf(p0[8 * s + 4], p0[8 * s + 5]); pw.w = pkbf(p0[8 * s + 6], p0[8 * s + 7]); } \
                else { const int s2 = s - 2; pw.x = pkbf(p1[8 * s2 + 0], p1[8 * s2 + 1]); pw.y = pkbf(p1[8 * s2 + 2], p1[8 * s2 + 3]); pw.z = pkbf(p1[8 * s2 + 4], p1[8 * s2 + 5]); pw.w = pkbf(p1[8 * s2 + 6], p1[8 * s2 + 7]); } \
                const bf16x8 pb = __builtin_bit_cast(bf16x8, pw); \
                const s16x4 a0 = ta[s][0], a1 = ta[s][1], c0 = tc[s][0], c1 = tc[s][1]; \
                const bf16x8 va = (bf16x8){a0[0], a0[1], a0[2], a0[3], a1[0], a1[1], a1[2], a1[3]}, vc = (bf16x8){c0[0], c0[1], c0[2], c0[3], c1[0], c1[1], c1[2], c1[3]}; \
                o0 = __builtin_amdgcn_mfma_f32_32x32x16_bf16(va, pb, o0, 0, 0, 0); o1 = __builtin_amdgcn_mfma_f32_32x32x16_bf16(vc, pb, o1, 0, 0, 0); \
            } \
        } \
    } while (0)
    { int sc = 0;
      for (int i2 = 0; i2 < ntl; i2 += 2) {
          const int s4 = (sc + 4 >= NSLOT) ? sc + 4 - NSLOT : sc + 4, s5 = (sc + 5 >= NSLOT) ? sc + 5 - NSLOT : sc + 5, sn = sc + 1;
          STAGE(i2 + 4, s4); STAGE(i2 + 5, s5);
          ATT_STEP(i2, sc); ATT_STEP(i2 + 1, sn);
          asm volatile("s_waitcnt vmcnt(4)" ::: "memory");
          asm volatile("s_waitcnt lgkmcnt(0)" ::: "memory"); __builtin_amdgcn_s_barrier(); asm volatile("" ::: "memory");
          sc = (sc + 2 >= NSLOT) ? sc + 2 - NSLOT : sc + 2; } }
    asm volatile("s_waitcnt vmcnt(0)" ::: "memory");
#undef ATT_STEP
#undef STAGE
#undef TILE_OF
    l += __shfl_xor(l, 32);
    const float rl = 1.0f / l; float q2 = 0.f;
    const size_t t = rowb + qpos; bf16_t* op = O + t * DM + 64 * hh + 4 * hi;
#pragma unroll
    for (int c4 = 0; c4 < 4; ++c4) {
        const float a0 = o0[4 * c4 + 0] * rl, a1 = o0[4 * c4 + 1] * rl, a2 = o0[4 * c4 + 2] * rl, a3 = o0[4 * c4 + 3] * rl;
        const float b0 = o1[4 * c4 + 0] * rl, b1 = o1[4 * c4 + 1] * rl, b2 = o1[4 * c4 + 2] * rl, b3 = o1[4 * c4 + 3] * rl;
        q2 += (a0 * a0 + a1 * a1) + (a2 * a2 + a3 * a3) + (b0 * b0 + b1 * b1) + (b2 * b2 + b3 * b3);
        u32x2 wa; wa.x = pkbf(a0, a1); wa.y = pkbf(a2, a3); *(u32x2*)(op + 8 * c4) = wa;
        u32x2 wb; wb.x = pkbf(b0, b1); wb.y = pkbf(b2, b3); *(u32x2*)(op + 32 + 8 * c4) = wb;
    }
    q2 += __shfl_xor(q2, 32);
    if (hi == 0) ssq[t * 16 + hh] = q2;
}
}
namespace att2 {
typedef float f32x16 __attribute__((ext_vector_type(16)));
typedef short s16x4 __attribute__((ext_vector_type(4)));
typedef short v4i16_t __attribute__((ext_vector_type(4)));
typedef LAS const unsigned char* lds_cptr;
constexpr int NW = 8, QBLK = 32, QB = 256, KVBLK = 64, NSLOT = 3, SLOTB = 8192;
constexpr int LDS_K = 0, LDS_V = NSLOT * SLOTB, LDS_WS = 2 * NSLOT * SLOTB, LDS_OST = LDS_WS + NW * 64 * 4, LDS_LUT = LDS_OST + NW * 4096, LDS_KM = LDS_LUT + 2560, LDS_END = LDS_KM + 2048;
constexpr int DMAXT = 383, NLUT = 639;
constexpr float NEGBIG = -1e30f;
__device__ __forceinline__ int crow(int r, int hi) { return (r & 3) + 8 * (r >> 2) + 4 * hi; }
#define SBAR() __builtin_amdgcn_sched_barrier(0)
__device__ __forceinline__ void glds16(const void* gsrc, unsigned lds_dst) { unsigned keep;
    asm volatile("s_mov_b32 %0, m0\n\ts_mov_b32 m0, %2\n\ts_nop 0\n\tglobal_load_lds_dwordx4 %1, off\n\ts_mov_b32 m0, %0" : "=&s"(keep) : "v"(gsrc), "s"(lds_dst) : "memory"); }
__device__ __forceinline__ float fadd_s(float a, float b) { float r; asm("v_add_f32_e32 %0, %1, %2" : "=v"(r) : "v"(a), "v"(b)); return r; }
__device__ __forceinline__ float fsub_s(float a, float b) { float r; asm("v_sub_f32_e32 %0, %1, %2" : "=v"(r) : "v"(a), "v"(b)); return r; }
__device__ __forceinline__ unsigned cvtpk_s(float lo, float hi) { f32x2 v = {lo, hi}; typedef __bf16 bf2 __attribute__((ext_vector_type(2))); bf2 b = __builtin_convertvector(v, bf2); return __builtin_bit_cast(unsigned, b); }
#define WAIT_BAR(N) asm volatile("s_waitcnt vmcnt(" #N ") lgkmcnt(0)\n\ts_barrier" ::: "memory")
__device__ __forceinline__ void qkt(f32x16& p0, f32x16& p1, lds_cptr Kslot, const bf16x8* qr, const f32x16& negm, int r32, int hi) {
    lds_cptr kb = Kslot + hi * 1024 + r32 * 16;
#pragma unroll
    for (int d0 = 0; d0 < 4; ++d0) {
        const bf16x8 b0 = *(const LAS bf16x8*)(kb + d0 * 2048), b1 = *(const LAS bf16x8*)(kb + d0 * 2048 + 512);
        if (d0 == 0) { p0 = __builtin_amdgcn_mfma_f32_32x32x16_bf16(b0, qr[0], negm, 0, 0, 0); p1 = __builtin_amdgcn_mfma_f32_32x32x16_bf16(b1, qr[0], negm, 0, 0, 0); }
        else { p0 = __builtin_amdgcn_mfma_f32_32x32x16_bf16(b0, qr[d0], p0, 0, 0, 0); p1 = __builtin_amdgcn_mfma_f32_32x32x16_bf16(b1, qr[d0], p1, 0, 0, 0); } }
}
__device__ __forceinline__ void kload8(bf16x8* kf, lds_cptr kp) {
    kf[0] = *(const LAS bf16x8*)(kp);        kf[1] = *(const LAS bf16x8*)(kp + 512);
    kf[2] = *(const LAS bf16x8*)(kp + 2048); kf[3] = *(const LAS bf16x8*)(kp + 2560);
    kf[4] = *(const LAS bf16x8*)(kp + 4096); kf[5] = *(const LAS bf16x8*)(kp + 4608);
    kf[6] = *(const LAS bf16x8*)(kp + 6144); kf[7] = *(const LAS bf16x8*)(kp + 6656);
}
__device__ __forceinline__ void kload2(bf16x8* kf, lds_cptr kp, int j) { kf[2 * j] = *(const LAS bf16x8*)(kp + j * 2048); kf[2 * j + 1] = *(const LAS bf16x8*)(kp + j * 2048 + 512); }
__device__ __forceinline__ s16x4 vtr(lds_cptr p) { return __builtin_bit_cast(s16x4, __builtin_amdgcn_ds_read_tr16_b64_v4i16((LAS v4i16_t*)p)); }
__device__ __forceinline__ float rowmax(const f32x16& p0, const f32x16& p1) {
    float a = __builtin_fmaxf(__builtin_fmaxf(p0[0], p0[1]), p1[0]), b = __builtin_fmaxf(__builtin_fmaxf(p0[2], p0[3]), p1[1]); a = __builtin_fmaxf(__builtin_fmaxf(a, p1[2]), p1[3]);
#pragma unroll
    for (int r = 4; r < 16; r += 4) { a = __builtin_fmaxf(__builtin_fmaxf(a, p0[r]), p0[r + 1]); b = __builtin_fmaxf(__builtin_fmaxf(b, p0[r + 2]), p0[r + 3]); a = __builtin_fmaxf(__builtin_fmaxf(a, p1[r]), p1[r + 1]); b = __builtin_fmaxf(__builtin_fmaxf(b, p1[r + 2]), p1[r + 3]); }
    const float m = __builtin_fmaxf(a, b);
    auto rr = __builtin_amdgcn_permlane32_swap(__float_as_uint(m), __float_as_uint(m), false, false);
    return __builtin_fmaxf(__uint_as_float(rr[0]), __uint_as_float(rr[1]));
}
__device__ __forceinline__ float xsum(float v) { auto rr = __builtin_amdgcn_permlane32_swap(__float_as_uint(v), __float_as_uint(v), false, false); return __uint_as_float(rr[0]) + __uint_as_float(rr[1]); }
__device__ __forceinline__ void pv(f32x16* o, int vb, bf16x8 pa0, bf16x8 pa1, bf16x8 pa2, bf16x8 pa3) {
#pragma unroll
    for (int d0 = 0; d0 < 2; ++d0) { s16x4 lo[4], hi[4];
#pragma unroll
        for (int ks = 0; ks < 4; ++ks) {
            asm volatile("ds_read_b64_tr_b16 %0,%1 offset:%c2" : "=&v"(lo[ks]) : "v"(vb), "i"(d0 * 4096 + ks * 1024) : "memory");
            asm volatile("ds_read_b64_tr_b16 %0,%1 offset:%c2" : "=&v"(hi[ks]) : "v"(vb), "i"(d0 * 4096 + ks * 1024 + 512) : "memory"); }
        asm volatile("s_waitcnt lgkmcnt(0)" ::: "memory"); SBAR();
#define PK(k) (bf16x8){lo[k][0], lo[k][1], lo[k][2], lo[k][3], hi[k][0], hi[k][1], hi[k][2], hi[k][3]}
        o[d0] = __builtin_amdgcn_mfma_f32_32x32x16_bf16(pa0, PK(0), o[d0], 0, 0, 0);
        o[d0] = __builtin_amdgcn_mfma_f32_32x32x16_bf16(pa1, PK(1), o[d0], 0, 0, 0);
        o[d0] = __builtin_amdgcn_mfma_f32_32x32x16_bf16(pa2, PK(2), o[d0], 0, 0, 0);
        o[d0] = __builtin_amdgcn_mfma_f32_32x32x16_bf16(pa3, PK(3), o[d0], 0, 0, 0);
#undef PK
    }
}

template <int TYPE, int THRL>
__device__ __forceinline__ void attn_unit(Frame& F, int b, int hl, int n) {
    int tid_ = F.tid; asm volatile("" : "+v"(tid_));
    const int tid = tid_, lane = tid & 63, r32 = lane & 31, hi = lane >> 5; const int wid = F.wave;
    const int hh = TYPE * 8 + hl, g = hl >> 2;
    const int colQ = (TYPE ? C_QB : C_QA) + 64 * hl, colK = (TYPE ? C_KB : C_KA) + 64 * g, colV = (TYPE ? C_VB : C_VA) + 64 * g;
    const bf16_t* qkv = (const bf16_t*)(F.ws + WS_QKV); bf16_t* O = (bf16_t*)(F.ws + WS_O); float* ssq = (float*)(F.ws + WS_SSQ);
    const float* tab = (const float*)(F.ws + WS_BIAS); const float* kmp = (const float*)(F.ws + WS_KMP);
    const long rowbase = (long)b * SEQ; const int q0 = n * QB;
    const lds_cptr shm3 = (lds_cptr)F.lds; LAS unsigned char* shmw = F.lds;
    const unsigned lds0 = (unsigned)(unsigned long)F.lds;
    LAS float* wsf = (LAS float*)(shmw + LDS_WS) + wid * 64;
    LAS float* lut = (LAS float*)(shmw + LDS_LUT); LAS float* kml = (LAS float*)(shmw + LDS_KM);
    const int t_lo = (4 * n - 2 > 0) ? 4 * n - 2 : 0;
    const int NT = TYPE ? 4 * n + 4 : (4 * n + 4 - t_lo);
#define TILE_OF(t) (TYPE ? ((t) < 4 ? 4 * n + (t) : (t) - 4) : t_lo + (t))
    for (int e = tid; e < NLUT; e += NTHREADS) { const int dist = DMAXT - e; float v;
        if (dist < 0) v = NEGBIG; else if (dist < 128) v = tab[hh * 132 + dist] - (TYPE ? tab[hh * 132 + 128] : 0.f); else v = TYPE ? 0.f : NEGBIG;
        lut[e] = v; }
    if (TYPE) { const int nb = tid >> 6, d = tid & 63; float v = 0.f;
        if (nb < n) { const int pm = b * 8 + nb; v = kmp[((pm * 2 + 0) * 2 + g) * 64 + d] + kmp[((pm * 2 + 1) * 2 + g) * 64 + d]; }
        kml[tid] = v; }
    const bf16_t* Qw = qkv + (rowbase + q0 + wid * QBLK) * INW + colQ;
    const bf16_t* Kh = qkv + rowbase * INW + colK; const bf16_t* Vh = qkv + rowbase * INW + colV;
    const bf16_t* ksrc = Kh + (long)lane * INW + wid * 8;
    const bf16_t* vsrc = Vh + (long)(16 * (wid & 3) + (lane >> 2)) * INW + (wid >> 2) * 32 + (lane & 3) * 8;
    const unsigned kdst = lds0 + LDS_K + wid * 1024, vdst = lds0 + LDS_V + wid * 1024;
#define DMA_K(t, slot) glds16(ksrc + (long)TILE_OF(t) * KVBLK * INW, (unsigned)__builtin_amdgcn_readfirstlane(kdst + (slot)))
#define DMA_V(t, slot) glds16(vsrc + (long)TILE_OF(t) * KVBLK * INW, (unsigned)__builtin_amdgcn_readfirstlane(vdst + (slot)))
    const int vb0 = (int)(lds0 + LDS_V) + ((lane >> 4) & 1) * 32 + (lane & 3) * 8 + (4 * hi + ((lane & 15) >> 2)) * 64;
    bf16x8 kf[8];
    const lds_cptr kp0 = shm3 + LDS_K + hi * 1024 + r32 * 16; const lds_cptr vp0 = shm3 + LDS_V + ((lane >> 4) & 1) * 32 + (lane & 3) * 8 + (4 * hi + ((lane & 15) >> 2)) * 64;
    DMA_K(0, 0); DMA_V(0, 0); DMA_K(1, SLOTB);
    bf16x8 qr[4];
#pragma unroll
    for (int d0 = 0; d0 < 4; ++d0) qr[d0] = *(const bf16x8*)(&Qw[(long)r32 * INW + d0 * 16 + hi * 8]);
    float mhat = TYPE ? 0.f : FIN(I_SINKS)[hl] * LOG2E, l_reg = (TYPE == 0 && hi == 0) ? 1.f : 0.f;
    f32x16 o[2]; o[0] = f32x16{}; o[1] = f32x16{}; f32x16 negm;
#pragma unroll
    for (int r = 0; r < 16; ++r) negm[r] = -mhat;
    asm volatile("" : "+v"(negm));
    const int qpos = q0 + wid * QBLK + r32;
    const LAS float* lutq = lut + (DMAXT - qpos + 4 * hi);
#define LUTADD(P0, P1, t) do { const LAS float* lp_ = lutq + 64 * TILE_OF(t); \
        _Pragma("unroll") for (int r = 0; r < 16; ++r) { const int ko_ = (r & 3) + 8 * (r >> 2); P0[r] += lp_[ko_]; P1[r] += lp_[32 + ko_]; } } while (0)
#define NEAR(t) (TYPE == 0 || (t) < 4 || (t) >= NT - 2)
    unsigned sel = 0u;
#define PASTMASKED(tt) (TYPE == 1 && (tt) >= 4 && !((sel >> (((tt) - 4) >> 2)) & 1u))
    bool resc = false;
#define START(P0, P1) do { const float rm = rowmax(P0, P1); resc = false; \
        { const float dl = TYPE ? rm : (rm > (float)THRL ? rm : 0.f); mhat = fadd_s(mhat, dl); l_reg *= __builtin_amdgcn_exp2f(-dl); \
          _Pragma("unroll") for (int r = 0; r < 16; ++r) { P0[r] = fsub_s(P0[r], dl); P1[r] = fsub_s(P1[r], dl); } \
          _Pragma("unroll") for (int r = 0; r < 16; ++r) negm[r] = -mhat; asm volatile("" : "+v"(negm)); } \
        _Pragma("unroll") for (int r = 0; r < 16; ++r) P0[r] = __builtin_amdgcn_exp2f(P0[r]); } while (0)
#define RESC() do { if (resc) { asm volatile("s_waitcnt lgkmcnt(0)" ::: "memory"); \
        _Pragma("unroll") for (int d_ = 0; d_ < 2; ++d_) _Pragma("unroll") for (int r = 0; r < 16; ++r) o[d_][r] *= wsf[crow(r, hi)]; } } while (0)
    f32x16 pA0, pA1, pB0, pB1;
    int sl_prev = 0, sl_cur = 0, sl_next = SLOTB;
#define ROT() do { sl_prev = sl_cur; sl_cur = sl_next; sl_next = (sl_next == (NSLOT - 1) * SLOTB) ? 0 : sl_next + SLOTB; } while (0)
    DMA_K(2, 2 * SLOTB);
    WAIT_BAR(3);
    qkt(pA0, pA1, shm3 + LDS_K, qr, negm, r32, hi); asm volatile("s_nop 15\n\ts_nop 7" : "+v"(pA0), "+v"(pA1)); LUTADD(pA0, pA1, 0);
    START(pA0, pA1);
#pragma unroll
    for (int r = 0; r < 16; ++r) pA1[r] = __builtin_amdgcn_exp2f(pA1[r]);
    if (TYPE) {
        float gate[8];
#pragma unroll
        for (int nb = 0; nb < 8; ++nb) gate[nb] = 0.f;
#pragma unroll
        for (int d0 = 0; d0 < 4; ++d0) { float q8[8];
#pragma unroll
            for (int j = 0; j < 8; ++j) q8[j] = bf2f((unsigned short)qr[d0][j]);
#pragma unroll
            for (int nb = 0; nb < 7; ++nb) if (nb < n) { const f32x4 k0 = *(const LAS f32x4*)(kml + nb * 64 + 16 * d0 + 8 * hi), k1 = *(const LAS f32x4*)(kml + nb * 64 + 16 * d0 + 8 * hi + 4);
                gate[nb] += (q8[0] * k0[0] + q8[1] * k0[1]) + (q8[2] * k0[2] + q8[3] * k0[3]) + (q8[4] * k1[0] + q8[5] * k1[1]) + (q8[6] * k1[2] + q8[7] * k1[3]); } }
#pragma unroll
        for (int nb = 0; nb < 7; ++nb) gate[nb] = xsum(gate[nb]);
        const int nsel = n < 3 ? n : 3;
        for (int k = 0; k < nsel; ++k) { float best = -3e38f; int bi = 0;
#pragma unroll
            for (int nb = 0; nb < 7; ++nb) { const bool ok = (nb < n) && !((sel >> nb) & 1u) && (gate[nb] > best); if (ok) { best = gate[nb]; bi = nb; } }
            sel |= 1u << bi; }
    }
    WAIT_BAR(0);
    DMA_K(3, 0); DMA_V(1, SLOTB);
    ROT();
    kload8(kf, kp0 + sl_cur);
    WAIT_BAR(2);
    s16x4 vlo[8], vhi[8]; u32x4 pw0, pw1, pw2, pw3;
#define PKW(P, B) cvtpk_s(P[B], P[B + 1])
#define PAF(k) __builtin_bit_cast(bf16x8, pw##k)
#define VFR(i) (bf16x8){vlo[i][0], vlo[i][1], vlo[i][2], vlo[i][3], vhi[i][0], vhi[i][1], vhi[i][2], vhi[i][3]}
#define PIN(x) asm volatile("" : "+v"(x))
#define MX3(a, b, c) __builtin_fmaxf(__builtin_fmaxf((a), (b)), (c))
#define GAPA(MF, A0, A1, A2, A3, W0, W1, PW) do { MF; sacc += A0; sacc += A1; sacc += A2; sacc += A3; PIN(sacc); W0; W1; PIN(PW); SBAR(); } while (0)
#define EX(v) __builtin_amdgcn_exp2f(v)
#define GAPB(MF, X, B) do { MF; X[B] = EX(X[B]); X[B + 1] = EX(X[B + 1]); X[B + 2] = EX(X[B + 2]); X[B + 3] = EX(X[B + 3]); PIN(X); SBAR(); } while (0)
#define VRD(i) do { vlo[i] = vtr(vp_ + (((i) >> 2) * 4096 + ((i) & 3) * 1024)); vhi[i] = vtr(vp_ + (((i) >> 2) * 4096 + ((i) & 3) * 1024 + 512)); } while (0)
#define KRD(G, j) do { if (G) { kload2(kf, kp0 + sl_next, j); SBAR(); } } while (0)
#define STEP(C0, C1, P0, P1, t, GK, GV, GL, MASKED) do { SBAR(); \
    const lds_cptr vp_ = vp0 + sl_prev; \
    VRD(0); SBAR(); float sacc = (P0[0] + P0[1]); \
    GAPA(C0 = __builtin_amdgcn_mfma_f32_32x32x16_bf16(kf[0], qr[0], negm, 0, 0, 0), P0[2], P0[3], P0[4], P0[5],     pw0[0] = PKW(P0, 0), pw0[1] = PKW(P0, 2), pw0); \
    VRD(4); SBAR(); GAPA(C1 = __builtin_amdgcn_mfma_f32_32x32x16_bf16(kf[1], qr[0], negm, 0, 0, 0), P0[6], P0[7], P0[8], P0[9],     pw0[2] = PKW(P0, 4), pw0[3] = PKW(P0, 6), pw0); \
    VRD(1); SBAR(); GAPA(C0 = __builtin_amdgcn_mfma_f32_32x32x16_bf16(kf[2], qr[1], C0, 0, 0, 0),   P0[10], P0[11], P0[12], P0[13], pw1[0] = PKW(P0, 8), pw1[1] = PKW(P0, 10), pw1); \
    VRD(5); SBAR(); GAPA(C1 = __builtin_amdgcn_mfma_f32_32x32x16_bf16(kf[3], qr[1], C1, 0, 0, 0),   P0[14], P0[15], P1[0], P1[1],   pw1[2] = PKW(P0, 12), pw1[3] = PKW(P0, 14), pw1); \
    VRD(2); SBAR(); GAPA(C0 = __builtin_amdgcn_mfma_f32_32x32x16_bf16(kf[4], qr[2], C0, 0, 0, 0),   P1[2], P1[3], P1[4], P1[5],     pw2[0] = PKW(P1, 0), pw2[1] = PKW(P1, 2), pw2); \
    VRD(6); SBAR(); GAPA(C1 = __builtin_amdgcn_mfma_f32_32x32x16_bf16(kf[5], qr[2], C1, 0, 0, 0),   P1[6], P1[7], P1[8], P1[9],     pw2[2] = PKW(P1, 4), pw2[3] = PKW(P1, 6), pw2); \
    VRD(3); SBAR(); GAPA(C0 = __builtin_amdgcn_mfma_f32_32x32x16_bf16(kf[6], qr[3], C0, 0, 0, 0),   P1[10], P1[11], P1[12], P1[13], pw3[0] = PKW(P1, 8), pw3[1] = PKW(P1, 10), pw3); \
    VRD(7); SBAR(); GAPA(C1 = __builtin_amdgcn_mfma_f32_32x32x16_bf16(kf[7], qr[3], C1, 0, 0, 0),   P1[14], P1[15], 0.f, 0.f,       pw3[2] = PKW(P1, 12), pw3[3] = PKW(P1, 14), pw3); \
    l_reg += sacc; \
    if (GK) { DMA_K((t) + 3, sl_cur); } if (GV) { DMA_V((t) + 1, sl_next); } \
    if (MASKED) { if (NEAR(t)) LUTADD(C0, C1, t); } \
    { float a = MX3(C0[0], C0[1], C1[0]), b_ = MX3(C0[2], C0[3], C1[1]); a = MX3(a, C1[2], C1[3]); \
      _Pragma("unroll") for (int r = 4; r < 16; r += 4) { a = MX3(a, C0[r], C0[r + 1]); b_ = MX3(b_, C0[r + 2], C0[r + 3]); a = MX3(a, C1[r], C1[r + 1]); b_ = MX3(b_, C1[r + 2], C1[r + 3]); } \
      float rm = __builtin_fmaxf(a, b_); { auto rr = __builtin_amdgcn_permlane32_swap(__float_as_uint(rm), __float_as_uint(rm), false, false); rm = __builtin_fmaxf(__uint_as_float(rr[0]), __uint_as_float(rr[1])); } \
      resc = false; \
      if (__builtin_expect(__any(rm > (float)THRL), 0)) { const float dl = __builtin_fmaxf(rm, 0.f); mhat += dl; \
        _Pragma("unroll") for (int r = 0; r < 16; ++r) { C0[r] -= dl; C1[r] -= dl; } \
        const float f = __builtin_amdgcn_exp2f(-dl); l_reg *= f; if (hi == 0) wsf[r32] = f; resc = true; } \
        \
      if (resc || (TYPE == 1 && ((t) + 1) >= 4 && ((((t) + 1) & 3) == 0))) { const float cv_ = PASTMASKED((t) + 1) ? NEGBIG : -mhat; \
        _Pragma("unroll") for (int r = 0; r < 16; ++r) negm[r] = cv_; asm volatile("" : "+v"(negm)); } } \
    SBAR(); \
    GAPB(o[0] = __builtin_amdgcn_mfma_f32_32x32x16_bf16(PAF(0), VFR(0), o[0], 0, 0, 0), C0, 0); \
    GAPB(o[1] = __builtin_amdgcn_mfma_f32_32x32x16_bf16(PAF(0), VFR(4), o[1], 0, 0, 0), C0, 4); \
    KRD(GL, 0); GAPB(o[0] = __builtin_amdgcn_mfma_f32_32x32x16_bf16(PAF(1), VFR(1), o[0], 0, 0, 0), C0, 8); \
    KRD(GL, 1); GAPB(o[1] = __builtin_amdgcn_mfma_f32_32x32x16_bf16(PAF(1), VFR(5), o[1], 0, 0, 0), C0, 12); \
    KRD(GL, 2); GAPB(o[0] = __builtin_amdgcn_mfma_f32_32x32x16_bf16(PAF(2), VFR(2), o[0], 0, 0, 0), C1, 0); \
    KRD(GL, 3); GAPB(o[1] = __builtin_amdgcn_mfma_f32_32x32x16_bf16(PAF(2), VFR(6), o[1], 0, 0, 0), C1, 4); \
    GAPB(o[0] = __builtin_amdgcn_mfma_f32_32x32x16_bf16(PAF(3), VFR(3), o[0], 0, 0, 0), C1, 8); \
    GAPB(o[1] = __builtin_amdgcn_mfma_f32_32x32x16_bf16(PAF(3), VFR(7), o[1], 0, 0, 0), C1, 12); \
    } while (0)
    int t = 1;
    for (; t < 5 && t + 5 < NT; t += 2) {
        STEP(pB0, pB1, pA0, pA1, t, true, true, true, true);     WAIT_BAR(2); RESC(); ROT();
        STEP(pA0, pA1, pB0, pB1, t + 1, true, true, true, true); WAIT_BAR(2); RESC(); ROT();
    }
    for (; t + 5 < NT; t += 2) {
        STEP(pB0, pB1, pA0, pA1, t, true, true, true, false);     WAIT_BAR(2); RESC(); ROT();
        STEP(pA0, pA1, pB0, pB1, t + 1, true, true, true, false); WAIT_BAR(2); RESC(); ROT();
    }
#define ENDW(tt) do { if ((tt) + 3 < NT) { WAIT_BAR(2); } else if ((tt) + 2 < NT) { WAIT_BAR(1); } else { WAIT_BAR(0); } } while (0)
    for (; t + 1 < NT; t += 2) {
        STEP(pB0, pB1, pA0, pA1, t, (t + 3 < NT), (t + 1 < NT), (t + 1 < NT), true);         ENDW(t);     RESC(); ROT();
        STEP(pA0, pA1, pB0, pB1, t + 1, (t + 4 < NT), (t + 2 < NT), (t + 2 < NT), true);     ENDW(t + 1); RESC(); ROT();
    }
    STEP(pB0, pB1, pA0, pA1, NT - 1, false, false, false, true); RESC();
    { float sacc = pB0[0] + pB0[1];
#pragma unroll
      for (int r = 2; r < 16; ++r) sacc += pB0[r];
#pragma unroll
      for (int r = 0; r < 16; ++r) sacc += pB1[r];
      l_reg += sacc;
      pw0 = (u32x4){PKW(pB0, 0), PKW(pB0, 2), PKW(pB0, 4), PKW(pB0, 6)}; pw1 = (u32x4){PKW(pB0, 8), PKW(pB0, 10), PKW(pB0, 12), PKW(pB0, 14)};
      pw2 = (u32x4){PKW(pB1, 0), PKW(pB1, 2), PKW(pB1, 4), PKW(pB1, 6)}; pw3 = (u32x4){PKW(pB1, 8), PKW(pB1, 10), PKW(pB1, 12), PKW(pB1, 14)};
      SBAR(); pv(o, vb0 + sl_cur, PAF(0), PAF(1), PAF(2), PAF(3)); }
#undef ENDW
#undef STEP
#undef KRD
#undef VRD
#undef GAPB
#undef EX
#undef GAPA
#undef MX3
#undef PIN
#undef VFR
#undef PAF
#undef PKW
    l_reg = xsum(l_reg);
    int lane_e = lane; asm volatile("" : "+v"(lane_e));
    if (hi == 0) wsf[32 + r32] = l_reg; asm volatile("s_waitcnt lgkmcnt(0)" ::: "memory");
    float rli[16];
#pragma unroll
    for (int r = 0; r < 16; ++r) rli[r] = __builtin_amdgcn_rcpf(wsf[32 + crow(r, hi)]);
    bf16_t* Ow = O + (rowbase + q0 + wid * QBLK) * DM + 64 * hh;
    { LAS bf16_t* stg = (LAS bf16_t*)(shmw + LDS_OST) + wid * 2048;
#pragma unroll
      for (int r = 0; r < 16; ++r) { const int orow = crow(r, hi);
#pragma unroll
          for (int d0 = 0; d0 < 2; ++d0) stg[orow * 64 + d0 * 32 + r32] = (bf16_t)f2bf(o[d0][r] * rli[r]); }
      asm volatile("s_waitcnt lgkmcnt(0)" ::: "memory");
#pragma unroll
      for (int i = 0; i < 4; ++i) { const int row = i * 8 + (lane_e >> 3), ch = lane_e & 7; const u32x4 v = *(const LAS u32x4*)(stg + row * 64 + ch * 8);
          *(u32x4*)(Ow + (long)row * DM + ch * 8) = v;
          float q2 = bflo(v.x) * bflo(v.x) + bfhi(v.x) * bfhi(v.x) + bflo(v.y) * bflo(v.y) + bfhi(v.y) * bfhi(v.y) + bflo(v.z) * bflo(v.z) + bfhi(v.z) * bfhi(v.z) + bflo(v.w) * bflo(v.w) + bfhi(v.w) * bfhi(v.w);
          q2 += __shfl_xor(q2, 1); q2 += __shfl_xor(q2, 2); q2 += __shfl_xor(q2, 4);
          if (ch == 0) ssq[(size_t)(rowbase + q0 + wid * QBLK + row) * 16 + hh] = q2; } }
    asm volatile("s_waitcnt lgkmcnt(0)\n\ts_barrier" ::: "memory");
#undef DMA_K
#undef DMA_V
#undef LUTADD
#undef NEAR
#undef PASTMASKED
#undef START
#undef RESC
#undef ROT
#undef TILE_OF
}
#undef SBAR
#undef WAIT_BAR
}

__device__ __forceinline__ void p2_attention(Frame& F) {
    for (int j = F.vcu; j < 512; j += F.G) {
        if (j < 256) { const int b = j >> 5, hm = (j >> 2) & 7, pi = j & 3;
#pragma unroll 1
            for (int k = 0; k < 2; ++k) att2::attn_unit<1, 8>(F, b, hm, k ? pi : 7 - pi); }
        else { const int id = 2 * (j - 256);
#pragma unroll 1
            for (int k = 0; k < 2; ++k) { const int u = id + k; att2::attn_unit<0, 8>(F, u >> 6, (u >> 3) & 7, u & 7); } }
    }
    __syncthreads();
}

__device__ __forceinline__ void p4_router(Frame& F) {
    typedef float f32x16 __attribute__((ext_vector_type(16)));
    const bf16_t* x1b = (const bf16_t*)(F.ws + WS_X1B); float* r2 = (float*)(F.ws + WS_R2); const bf16_t* Wt = (const bf16_t*)(F.ws + WS_WR);
    LAS float* part = (LAS float*)F.lds;
    LAS float* sspart = (LAS float*)(F.lds + 98304);
    LAS int* lcnt = (LAS int*)(F.lds + MISC_OFF);
    LAS int* trec = (LAS int*)(F.lds + MISC_OFF + 512);
    unsigned* cnt = (unsigned*)(F.ctl + CW_CNT); unsigned* list = (unsigned*)(F.ws + WS_LIST); int* tok = (int*)(F.ws + WS_TOK);
    if (F.tid < 64) lcnt[F.tid] = 0;
    const int per = T / F.G;
    const int t0 = F.vcu * per;
    {
        const int tg = F.wave >> 2, kq = F.wave & 3, r32 = F.lane & 31, hi = F.lane >> 5;
        const bf16_t* ap = x1b + (size_t)(t0 + 32 * tg + r32) * DM + 256 * kq + 8 * hi;
        const bf16_t* bp = Wt + (size_t)r32 * DM + 256 * kq + 8 * hi;
        f32x16 a0 = {}, a1 = {}, a2 = {}; float ss = 0.f;
#pragma unroll 4
        for (int s = 0; s < 16; ++s) {
            const bf16x8 a = *(const bf16x8*)(ap + 16 * s);
            const bf16x8 b0 = *(const bf16x8*)(bp + 16 * s), b1 = *(const bf16x8*)(bp + (size_t)32 * DM + 16 * s), b2 = *(const bf16x8*)(bp + (size_t)64 * DM + 16 * s);
            a0 = __builtin_amdgcn_mfma_f32_32x32x16_bf16(a, b0, a0, 0, 0, 0); a1 = __builtin_amdgcn_mfma_f32_32x32x16_bf16(a, b1, a1, 0, 0, 0); a2 = __builtin_amdgcn_mfma_f32_32x32x16_bf16(a, b2, a2, 0, 0, 0);
#pragma unroll
            for (int j = 0; j < 8; ++j) { const float v = bf2f((unsigned short)a[j]); ss += v * v; }
        }
        LAS float* pp = part + ((tg * 4 + kq) * 32) * 96 + r32;
#pragma unroll
        for (int r = 0; r < 16; ++r) { const int tk = (r & 3) + 8 * (r >> 2) + 4 * hi; pp[tk * 96] = a0[r]; pp[tk * 96 + 32] = a1[r]; pp[tk * 96 + 64] = a2[r]; }
        sspart[((tg * 4 + kq) * 2 + hi) * 32 + r32] = ss;
    }
    __syncthreads();
    if (F.tid < per) {
        const int lt = F.tid, tg = lt >> 5, tk = lt & 31, t = t0 + lt;
        float lg[36]; float ssq = 0.f;
#pragma unroll
        for (int o = 0; o < 36; ++o) lg[o] = 0.f;
#pragma unroll
        for (int kq = 0; kq < 4; ++kq) { const LAS float* pr = part + ((tg * 4 + kq) * 32 + tk) * 96;
#pragma unroll
            for (int o = 0; o < 32; ++o) lg[o] += pr[o] + pr[32 + o];
#pragma unroll
            for (int o = 0; o < 4; ++o) lg[32 + o] += pr[64 + o] + pr[68 + o];
            ssq += sspart[((tg * 4 + kq) * 2 + 0) * 32 + tk] + sspart[((tg * 4 + kq) * 2 + 1) * 32 + tk]; }
        const float rs = 1.0f / sqrtf(ssq * (1.0f / DM) + EPS);
#pragma unroll
        for (int o = 0; o < 36; ++o) lg[o] *= rs;
        const float* brg = FIN(I_B_RG); const float* bre = FIN(I_B_RE);
        lg[0] += brg[0]; lg[1] += brg[1]; lg[2] += brg[2]; lg[3] += brg[3];
        int gsel = 0; float gm = lg[0];
#pragma unroll
        for (int o = 1; o < 4; ++o) if (lg[o] > gm) { gm = lg[o]; gsel = o; }
        float den = 0.f;
#pragma unroll
        for (int o = 0; o < 4; ++o) den += __expf(lg[o] - gm);
        const float gwt = 1.0f / den;
        float el[8];
#pragma unroll
        for (int j = 0; j < 8; ++j) { float a = lg[4 + j];
#pragma unroll
            for (int gq = 1; gq < 4; ++gq) a = (gsel == gq) ? lg[4 + 8 * gq + j] : a;
            el[j] = a + bre[gsel * 8 + j]; }
        int i0 = 0; float v0 = el[0];
#pragma unroll
        for (int j = 1; j < 8; ++j) if (el[j] > v0) { v0 = el[j]; i0 = j; }
        int i1 = -1; float v1 = -3e38f;
#pragma unroll
        for (int j = 0; j < 8; ++j) if (j != i0 && el[j] > v1) { v1 = el[j]; i1 = j; }
        const float e1 = __expf(v1 - v0); const float w0 = gwt / (1.0f + e1), w1 = gwt * e1 / (1.0f + e1);
        const int e0 = gsel * 8 + i0, e1i = gsel * 8 + i1;
        const int lr0 = __hip_atomic_fetch_add(&lcnt[e0], 1, __ATOMIC_RELAXED, __HIP_MEMORY_SCOPE_WORKGROUP);
        const int lr1 = __hip_atomic_fetch_add(&lcnt[e1i], 1, __ATOMIC_RELAXED, __HIP_MEMORY_SCOPE_WORKGROUP);
        trec[lt * 8 + 0] = e0; trec[lt * 8 + 1] = e1i; trec[lt * 8 + 2] = lr0; trec[lt * 8 + 3] = lr1;
        trec[lt * 8 + 4] = __builtin_bit_cast(int, w0); trec[lt * 8 + 5] = __builtin_bit_cast(int, w1);
        r2[t] = rs;
    }
    __syncthreads();
    if (F.tid < 32) { const int c = lcnt[F.tid]; int base = 0; if (c > 0) base = (int)__hip_atomic_fetch_add(&cnt[F.tid], (unsigned)c, __ATOMIC_RELAXED, __HIP_MEMORY_SCOPE_AGENT); lcnt[32 + F.tid] = base; }
    __syncthreads();
    for (int lt = F.tid; lt < per; lt += NTHREADS) {
        const int t = t0 + lt; const int e0 = trec[lt * 8 + 0], e1 = trec[lt * 8 + 1];
        const int rk0 = lcnt[32 + e0] + trec[lt * 8 + 2], rk1 = lcnt[32 + e1] + trec[lt * 8 + 3];
        list[e0 * 16384 + rk0] = (unsigned)(t * 2); list[e1 * 16384 + rk1] = (unsigned)(t * 2 + 1);
        int* tr = tok + (size_t)t * 8; tr[0] = e0; tr[1] = e1; tr[2] = rk0; tr[3] = rk1; tr[4] = trec[lt * 8 + 4]; tr[5] = trec[lt * 8 + 5];
    }
    __syncthreads();
}

__device__ __forceinline__ void build_tile_table(Frame& F, LAS int* tb) {
    if (F.tid < 64) {
        const unsigned* cnt = (const unsigned*)(F.ctl + CW_CNT);
        const int nt = (F.lane < NEXP) ? (int)((__hip_atomic_load(&cnt[F.lane & 31], __ATOMIC_RELAXED, __HIP_MEMORY_SCOPE_AGENT) + 255u) >> 8) : 0;
        int inc = nt;
#pragma unroll
        for (int o = 1; o < 32; o <<= 1) { const int v = __shfl_up(inc, o); if ((F.lane & 31) >= o) inc += v; }
        if (F.lane < NEXP) { tb[F.lane] = inc - nt; if (F.lane == NEXP - 1) tb[NEXP] = inc; }
    }
    __syncthreads();
}

__device__ __forceinline__ void p7_combine(Frame& F) {
    const bf16_t* x1b = (const bf16_t*)(F.ws + WS_X1B); const bf16_t* Y = (const bf16_t*)(F.ws + WS_Y); bf16_t* x2b = (bf16_t*)(F.ws + WS_X2B); float* r3 = (float*)(F.ws + WS_R3); const int* tok = (const int*)(F.ws + WS_TOK);
    const int gw = F.vcu * NWAVES + F.wave, NGW = F.G * NWAVES;
    for (int t = gw; t < T; t += 2 * NGW) {
        const int tb_ = (t + NGW < T) ? t + NGW : t; const bool two = tb_ != t;
        const f32x2 wa = *(const f32x2*)(tok + (size_t)t * 8 + 4), wb = *(const f32x2*)(tok + (size_t)tb_ * 8 + 4);
        u32x2 xa[2][4], ya[2][4], yb[2][4];
#pragma unroll
        for (int k = 0; k < 2; ++k) { const int tt = k ? tb_ : t;
            const GAS u32x2* xr = (const GAS u32x2*)(x1b + (size_t)tt * DM) + F.lane;
            const GAS u32x2* y0 = (const GAS u32x2*)(Y + (size_t)(2 * tt) * DM) + F.lane; const GAS u32x2* y1 = (const GAS u32x2*)(Y + (size_t)(2 * tt + 1) * DM) + F.lane;
#pragma unroll
            for (int j = 0; j < 4; ++j) { xa[k][j] = xr[64 * j]; ya[k][j] = y0[64 * j]; yb[k][j] = y1[64 * j]; } }
#pragma unroll
        for (int k = 0; k < 2; ++k) { const int tt = k ? tb_ : t; const float w0 = k ? wb.x : wa.x, w1 = k ? wb.y : wa.y;
            GAS u32x2* ob = (GAS u32x2*)(x2b + (size_t)tt * DM) + F.lane; float s = 0.f;
#pragma unroll
            for (int j = 0; j < 4; ++j) { f32x4 v;
                v.x = bflo(xa[k][j].x) + (w0 * bflo(ya[k][j].x) + w1 * bflo(yb[k][j].x)); v.y = bfhi(xa[k][j].x) + (w0 * bfhi(ya[k][j].x) + w1 * bfhi(yb[k][j].x));
                v.z = bflo(xa[k][j].y) + (w0 * bflo(ya[k][j].y) + w1 * bflo(yb[k][j].y)); v.w = bfhi(xa[k][j].y) + (w0 * bfhi(ya[k][j].y) + w1 * bfhi(yb[k][j].y));
                u32x2 w; w.x = pk2(v.x, v.y); w.y = pk2(v.z, v.w); if (k == 0 || two) ob[64 * j] = w; s += (v.x * v.x + v.y * v.y) + (v.z * v.z + v.w * v.w); }
            s = wave_sum(s);
            if (F.lane == 0 && (k == 0 || two)) r3[tt] = 1.0f / sqrtf(s * (1.0f / DM) + EPS); }
    }
}

#define XB_TMO      128
#define XB_XCNT(j)  (256  + 64 * (j))
#define XB_XSUB(j)  (1280 + 64 * (j))
#define XB_XGEN(j)  (2304 + 64 * (j))
#define XB_TOP      3328
#define XB_TOPGEN   3392
#define XCD_BAR_WORDS 3456
#define XB_SPIN_CAP (1u << 18)
__device__ __forceinline__ unsigned xb_ld(unsigned* p)              { return __hip_atomic_load(p, __ATOMIC_RELAXED, __HIP_MEMORY_SCOPE_AGENT); }
__device__ __forceinline__ unsigned xb_add(unsigned* p, unsigned v) { return __hip_atomic_fetch_add(p, v, __ATOMIC_RELAXED, __HIP_MEMORY_SCOPE_AGENT); }
__device__ __forceinline__ unsigned xb_xcc_id() { return (unsigned)__builtin_amdgcn_s_getreg((3 << 11) | 20) & 0xFu; }
#define XB_SPIN(cond, bar) do { unsigned _sp = 0; while (cond) { __builtin_amdgcn_s_sleep(1); \
    if ((++_sp & 255u) == 0u) { if (xb_ld(&(bar)[XB_TMO])) break; if (_sp > XB_SPIN_CAP) { atomicAdd(&(bar)[XB_TMO], 1u); break; } } } } while (0)
struct XcdBarrier { unsigned* bar; unsigned x; volatile LAS unsigned* st; };
__device__ __forceinline__ XcdBarrier xcd_barrier_post(unsigned* bar, volatile LAS unsigned* st) {
    XcdBarrier b; b.bar = bar; b.x = xb_xcc_id(); b.st = st;
    if (threadIdx.x == 0) (void)xb_add(&bar[XB_XCNT(b.x)], 1u);
    return b;
}
__device__ __forceinline__ void xcd_barrier_complete(unsigned* bar, unsigned x, unsigned& nloc, unsigned& nx) {
    const unsigned G = gridDim.x * gridDim.y * gridDim.z;
    unsigned sum, cnt, mine, sp = 0u;
    for (;;) {
        sum = 0u; cnt = 0u; mine = 0u;
#pragma unroll
        for (unsigned j = 0; j < 16; ++j) { const unsigned c = xb_ld(&bar[XB_XCNT(j)]); sum += c; cnt += (c > 0u) ? 1u : 0u; mine = (j == x) ? c : mine; }
        if (sum == G) break;
        __builtin_amdgcn_s_sleep(1);
        if ((++sp & 255u) == 0u) { if (xb_ld(&bar[XB_TMO])) break; if (sp > XB_SPIN_CAP) { atomicAdd(&bar[XB_TMO], 1u); break; } }
    }
    nloc = mine > 0u ? mine : 1u; nx = cnt > 0u ? cnt : 1u;
}
__device__ __forceinline__ void xcd_barrier(const XcdBarrier& b) {
    asm volatile("s_waitcnt vmcnt(0)" ::: "memory");
    __syncthreads();
    if (threadIdx.x == 0) {
        unsigned* bar = b.bar;
        __builtin_amdgcn_s_waitcnt(0);
        unsigned nloc = b.st[0], nx = b.st[1];
        if (nloc == 0u) { xcd_barrier_complete(bar, b.x, nloc, nx); b.st[0] = nloc; b.st[1] = nx; }
        const unsigned old = xb_add(&bar[XB_XSUB(b.x)], 1u);
        const unsigned gen = old / nloc;
        if (old + 1u == (gen + 1u) * nloc) {
            __builtin_amdgcn_fence(__ATOMIC_RELEASE, "agent");
            asm volatile("s_waitcnt vmcnt(0)" ::: "memory");
            const unsigned og = xb_add(&bar[XB_TOP], 1u);
            const unsigned tg = og / nx;
            if (og + 1u == (tg + 1u) * nx) xb_add(&bar[XB_TOPGEN], 1u);
            else XB_SPIN(xb_ld(&bar[XB_TOPGEN]) == tg, bar);
            __builtin_amdgcn_fence(__ATOMIC_ACQUIRE, "agent");
            xb_add(&bar[XB_XGEN(b.x)], 1u);
            asm volatile("s_waitcnt vmcnt(0)" ::: "memory");
        } else {
            XB_SPIN(xb_ld(&bar[XB_XGEN(b.x)]) == gen, bar);
            __builtin_amdgcn_fence(__ATOMIC_ACQUIRE, "agent");
            asm volatile("s_waitcnt vmcnt(0)" ::: "memory");
        }
    }
    __syncthreads();
}

__global__ void __launch_bounds__(NTHREADS, 2) hymba_fwd(Args args) {
    extern __shared__ __attribute__((aligned(16))) unsigned char lds[];
    Frame F;
    F.lds = (LAS unsigned char*)lds; unsigned char* ws;
#define REFRESH_IDS() do { int t_ = threadIdx.x; asm volatile("" : "+v"(t_)); F.tid = t_; F.lane = t_ & 63; F.wave = __builtin_amdgcn_readfirstlane(t_ >> 6); \
        unsigned char* w_ = args.ws; const __attribute__((address_space(4))) char* k_ = (const __attribute__((address_space(4))) char*)__builtin_amdgcn_kernarg_segment_ptr(); float* o_ = args.out; asm volatile("" : "+s"(w_), "+s"(k_), "+s"(o_)); \
        F.ws = w_; F.ka = k_; F.out = o_; F.ctl = (GAS unsigned*)(w_ + WS_CTL); ws = w_; } while (0)
    REFRESH_IDS();
    F.G = gridDim.x; { const int bx = blockIdx.x; F.vcu = (F.G % 8 == 0) ? (bx % 8) * (F.G / 8) + bx / 8 : bx; }
    const int lo = args.ph_lo, hi = args.ph_hi;
#ifdef ONLY_PHASE
#define IN(k) ((k) == ONLY_PHASE && lo <= (k) && (k) < hi)
#else
#define IN(k) (lo <= (k) && (k) < hi)
#endif
    LAS int* tb = (LAS int*)(F.lds + MISC_OFF + 8192);
    LAS f32x2* rowtab = (LAS f32x2*)(F.lds + MISC_OFF + 4096);
    volatile LAS unsigned* bst = (volatile LAS unsigned*)(F.lds + MISC_OFF + 12288);
    if (F.tid < 2) bst[F.tid] = 0u;
    __syncthreads();
    XcdBarrier bar; bar.bar = (unsigned*)(F.ctl + CW_BAR); bar.x = 0; bar.st = bst;
    if (hi - lo > 1) bar = xcd_barrier_post((unsigned*)(F.ctl + CW_BAR), bst);
#define SEAM(k) do { if (IN(k) && IN((k) + 1)) xcd_barrier(bar); } while (0)

    for (int rep = 0; rep < 1 + ((REPEAT_MASK >> 0) & 1); ++rep) { if (rep) xcd_barrier(bar);
    if (IN(0)) { REFRESH_IDS(); p0_prologue(F); }
    }
    SEAM(0);
    for (int rep = 0; rep < 1 + ((REPEAT_MASK >> 1) & 1); ++rep) { if (rep) xcd_barrier(bar);
    if (IN(1)) {
        REFRESH_IDS();
        { pg8::DenseOrder S{(const char*)(ws + WS_XB), (const char*)(ws + WS_WIN), T / 256, INW / 256, DM, F.G, (int)blockIdx.x};
          EpiQKV E{(bf16_t*)(ws + WS_QKV), (const float*)(ws + WS_RS1), FIN(I_SWA_QN), FIN(I_SWA_KN), FIN(I_MOBA_QN), FIN(I_MOBA_KN), (float*)(ws + WS_KMP)};
          pg8::gemm_phase<EpiQKV, pg8::DenseOrder, true, false, false>(F.lds, DM, S, E); }
        { const int hg = F.G / 2; const bool second = (int)blockIdx.x >= hg;
          pg8::DenseOrder S{(const char*)(ws + WS_PB), (const char*)(ws + WS_WPP), T / 256, DM / 256, PLE, second ? hg : (1 << 30), second ? (int)blockIdx.x - hg : (1 << 30)};
          EpiProj E{(bf16_t*)(ws + WS_PRAW), (float*)(ws + WS_SSQP)};
          pg8::gemm_phase<EpiProj, pg8::DenseOrder, true, false, false>(F.lds, PLE, S, E); }
    }
    }
    SEAM(1);
    for (int rep = 0; rep < 1 + ((REPEAT_MASK >> 2) & 1); ++rep) { if (rep) xcd_barrier(bar);
    if (IN(2)) { REFRESH_IDS(); p2_attention(F); }
    }
    SEAM(2);
    for (int rep = 0; rep < 1 + ((REPEAT_MASK >> 3) & 1); ++rep) { if (rep) xcd_barrier(bar);
    if (IN(3)) {
        pg8::DenseOrder S{(const char*)(ws + WS_O), (const char*)(ws + WS_WOUT), T / 256, DM / 256, DM, F.G, (int)blockIdx.x};
        REFRESH_IDS();
        { pg8::Unit u0; if (S.next(0, u0) && F.tid < 256) {
              const f32x4* p = (const f32x4*)((const float*)(ws + WS_SSQ) + (size_t)(u0.pm * 256 + F.tid) * 16); const f32x4 a0 = p[0], a1 = p[1], b0 = p[2], b1 = p[3];
              const float qa = ((a0[0] + a0[1]) + (a0[2] + a0[3])) + ((a1[0] + a1[1]) + (a1[2] + a1[3])), qb = ((b0[0] + b0[1]) + (b0[2] + b0[3])) + ((b1[0] + b1[1]) + (b1[2] + b1[3]));
              rowtab[F.tid] = (f32x2){1.0f / sqrtf(qa * (1.0f / 512.f) + EPS), 1.0f / sqrtf(qb * (1.0f / 512.f) + EPS)}; }
          __syncthreads(); }
        EpiOut E{(bf16_t*)(ws + WS_X1B), (const LAS f32x2*)rowtab};
        pg8::gemm_phase<EpiOut, pg8::DenseOrder, false, false, true>(F.lds, DM, S, E);
    }
    }
    SEAM(3);
    if (IN(4)) { REFRESH_IDS(); p4_router(F); }
    SEAM(4);
    for (int rep = 0; rep < 1 + ((REPEAT_MASK >> 5) & 1); ++rep) { if (rep) xcd_barrier(bar);
    if (IN(5)) {
        REFRESH_IDS(); build_tile_table(F, tb);
        MoeOrder S{(const char*)(ws + WS_X1B), (const char*)(ws + WS_WGU), tb, (const unsigned*)(F.ctl + CW_CNT), (const unsigned*)(ws + WS_LIST), DM, (size_t)DM * DM * 2, (size_t)DM * 2, F.G, (int)blockIdx.x, true};
        EpiG1 E{(bf16_t*)(ws + WS_H), (const float*)(ws + WS_R2), (const unsigned*)(ws + WS_LIST)};
        pg8::gemm_phase<EpiG1, MoeOrder, true, true, false>(F.lds, DM, S, E);
        { REFRESH_IDS();
          const int nwg = tb[NEXP] * 4, G = F.G, c = (int)blockIdx.x;
          const int maxnu = (nwg + G - 1) / G, nu = (nwg - c + G - 1) / G;
          const int nfull = nwg - (maxnu - 1) * G;
          const bool all = (nfull >= G);
          const int W = all ? G : G - nfull, rank = all ? c : c - nfull;
          if (all || nu < maxnu) { LAS float* scr = (LAS float*)(F.lds + F.wave * 16384); tr_stream(F, scr, rank * NWAVES + F.wave, W * NWAVES, TI_DOWN, TI_DOWN_BASE); } }
    }
    }
    SEAM(5);
    for (int rep = 0; rep < 1 + ((REPEAT_MASK >> 6) & 1); ++rep) { if (rep) xcd_barrier(bar);
    if (IN(6)) {
        REFRESH_IDS(); build_tile_table(F, tb);
        MoeOrder S{(const char*)(ws + WS_H), (const char*)(ws + WS_WD), tb, (const unsigned*)(F.ctl + CW_CNT), (const unsigned*)(ws + WS_LIST), DEXP, (size_t)DM * DEXP * 2, (size_t)DEXP * 2, F.G, (int)blockIdx.x, false};
        EpiG2 E{(bf16_t*)(ws + WS_Y), (const unsigned*)(ws + WS_LIST)};
        pg8::gemm_phase<EpiG2, MoeOrder, true, false, false>(F.lds, DEXP, S, E);
    }
    }
    SEAM(6);
    if (IN(7)) { REFRESH_IDS(); p7_combine(F); }
    SEAM(7);
    if (IN(8)) {
        pg8::DenseOrder S{(const char*)(ws + WS_X2B), (const char*)(ws + WS_WPG), T / 256, DM / 256, DM, F.G, (int)blockIdx.x};
        REFRESH_IDS();
        { pg8::Unit u0; if (S.next(0, u0) && F.tid < 256) {
              const int row = u0.pm * 256 + F.tid; const f32x4* sp = (const f32x4*)((const float*)(ws + WS_SSQP) + (size_t)row * 16); const f32x4 s0 = sp[0], s1 = sp[1], s2 = sp[2], s3 = sp[3];
              const float q = (((s0[0] + s0[1]) + (s0[2] + s0[3])) + ((s1[0] + s1[1]) + (s1[2] + s1[3]))) + (((s2[0] + s2[1]) + (s2[2] + s2[3])) + ((s3[0] + s3[1]) + (s3[2] + s3[3])));
              rowtab[F.tid] = (f32x2){((const float*)(ws + WS_R3))[row], 1.0f / sqrtf(q * (1.0f / DM) + EPS)}; }
          __syncthreads(); }
        EpiFinal E{F.out, (const bf16_t*)(ws + WS_X2B), (const bf16_t*)(ws + WS_PRAW), FIN(I_PLE_ON), (const LAS f32x2*)rowtab};
        pg8::gemm_phase<EpiFinal, pg8::DenseOrder, false, false, false>(F.lds, DM, S, E);
    }
#undef IN
#undef SEAM
}

extern "C" void kernel_launch(void* const* d_in, const int* in_sizes, int n_in, void* d_out, int out_size, void* d_ws, size_t ws_size, hipStream_t stream) {
    static int grid = 0;
    if (grid == 0) {
        if (n_in != 25 || in_sizes[0] != T * DM || out_size != T * DM || ws_size < WS_END) { fprintf(stderr, "kernel_launch: unexpected shapes (n_in %d, in0 %d, out %d, ws %zu)\n", n_in, n_in > 0 ? in_sizes[0] : -1, out_size, ws_size); grid = -1; return; }
        int dev = 0, cus = 0, per_cu = 0;
        if (hipGetDevice(&dev) != hipSuccess || hipDeviceGetAttribute(&cus, hipDeviceAttributeMultiprocessorCount, dev) != hipSuccess) { grid = -1; return; }
        if (hipFuncSetAttribute((const void*)hymba_fwd, hipFuncAttributeMaxDynamicSharedMemorySize, LDS_BYTES) != hipSuccess) { fprintf(stderr, "kernel_launch: hipFuncSetAttribute failed\n"); grid = -1; return; }
        if (hipOccupancyMaxActiveBlocksPerMultiprocessor(&per_cu, (const void*)hymba_fwd, NTHREADS, LDS_BYTES) != hipSuccess || per_cu < 1) { fprintf(stderr, "kernel_launch: occupancy query says %d\n", per_cu); per_cu = 1; }
        (void)hipGetLastError();
        grid = cus;
        if (grid != 256) { fprintf(stderr, "kernel_launch: %d CUs; this kernel is built for 256 (one 256x256 tile per workgroup in the N=1024 GEMM phases)\n", grid); grid = -1; return; }
    }
    if (grid < 0) return;
    (void)hipMemsetAsync((char*)d_ws + WS_CTL, 0, CTL_ZERO_BYTES, stream);
    Args a{};
    for (int i = 0; i < 25; ++i) a.in[i] = (const float*)d_in[i];
    a.out = (float*)d_out; a.ws = (unsigned char*)d_ws;
    constexpr int NPH = 9;
    for (int li = 0; li < MK_N_LAUNCHES; ++li) {
        a.ph_lo = (MK_N_LAUNCHES == NPH) ? li : 0; a.ph_hi = (MK_N_LAUNCHES == NPH) ? li + 1 : NPH; a.li = li;
        hipLaunchKernelGGL(hymba_fwd, dim3(grid), dim3(NTHREADS), LDS_BYTES, stream, a);
    }
}
```

```cpp
#include <hip/hip_runtime.h>
#include <cstdio>
#include <cstdint>

#ifndef MK_N_LAUNCHES
#define MK_N_LAUNCHES 1
#endif

#ifndef REPEAT_MASK
#define REPEAT_MASK 0
#endif
#define LAS __attribute__((address_space(3)))
#define GAS __attribute__((address_space(1)))
typedef unsigned short bf16_t;
typedef short bf16x8 __attribute__((ext_vector_type(8)));
typedef float f32x4 __attribute__((ext_vector_type(4)));
typedef float f32x2 __attribute__((ext_vector_type(2)));
typedef unsigned u32x4 __attribute__((ext_vector_type(4)));
typedef unsigned u32x2 __attribute__((ext_vector_type(2)));

constexpr int BATCH = 8, SEQ = 2048, DM = 1024, T = BATCH * SEQ;
constexpr int INW = 1536, NHQ = 16, HD = 64;
constexpr int NEXP = 32, DEXP = 512, PLE = 256;
constexpr int MAXTILES = 160;
constexpr float EPS = 1e-6f;
constexpr float LOG2E = 1.4426950408889634f;
constexpr float QSCALE = 0.125f * LOG2E;
constexpr int NWAVES = 8, NTHREADS = 512;

constexpr int C_QA = 0, C_KA = 512, C_VA = 640, C_QB = 768, C_KB = 1280, C_VB = 1408;

constexpr size_t KiB = 1024, MiB = 1u << 20;
constexpr size_t WS_CTL = 0, CTL_ZERO_BYTES = 1 * MiB;
constexpr size_t WS_RS1 = 1 * MiB, WS_R2 = WS_RS1 + 64 * KiB, WS_R3 = WS_R2 + 64 * KiB, WS_KMP = WS_R3 + 64 * KiB;
constexpr size_t WS_WR = WS_KMP + 64 * KiB;
constexpr size_t WS_BIAS = WS_WR + 192 * KiB;
constexpr size_t WS_TOK = 1 * MiB + 512 * KiB;
constexpr size_t WS_SSQ = 2 * MiB;
constexpr size_t WS_SSQP = 3 * MiB;
constexpr size_t WS_LIST = 4 * MiB;
constexpr size_t WS_WIN = 8 * MiB, WS_WOUT = 11 * MiB, WS_WPG = 13 * MiB, WS_WPP = 15 * MiB;
constexpr size_t WS_WGU = 16 * MiB;
constexpr size_t WS_WD = 80 * MiB;
constexpr size_t WS_PRAW = 112 * MiB;
constexpr size_t WS_X1B = 144 * MiB;
constexpr size_t WS_X2B = WS_X1B;
constexpr size_t WS_H = 176 * MiB;
constexpr size_t WS_Y = 216 * MiB;
constexpr size_t WS_QKV = 176 * MiB;
constexpr size_t WS_O = 224 * MiB;
constexpr size_t WS_PB = 240 * MiB;
constexpr size_t WS_XB = WS_X1B;
constexpr size_t WS_END = 280 * MiB;
constexpr int CW_CNT = 64;
constexpr int CW_BAR = 4096;

constexpr int RING_BYTES = 131072;
constexpr int MISC_OFF = 147456;
constexpr int LDS_BYTES = 163840;

__device__ __forceinline__ unsigned f2bf(float f) { unsigned u = __builtin_bit_cast(unsigned, f); return (u + 0x7fffu + ((u >> 16) & 1u)) >> 16; }
__device__ __forceinline__ unsigned pk2(float lo, float hi) { return f2bf(lo) | (f2bf(hi) << 16); }
__device__ __forceinline__ float bf2f(unsigned short h) { return __builtin_bit_cast(float, (unsigned)h << 16); }
__device__ __forceinline__ float bflo(unsigned w) { return __builtin_bit_cast(float, w << 16); }
__device__ __forceinline__ float bfhi(unsigned w) { return __builtin_bit_cast(float, w & 0xffff0000u); }
__device__ __forceinline__ float wave_sum(float v) {
#pragma unroll
    for (int o = 1; o < 64; o <<= 1) v += __shfl_xor(v, o);
    return v;
}
__device__ __forceinline__ float wave_max(float v) {
#pragma unroll
    for (int o = 1; o < 64; o <<= 1) v = fmaxf(v, __shfl_xor(v, o));
    return v;
}
#define LDS_WAIT() asm volatile("s_waitcnt lgkmcnt(0)" ::: "memory")
#define VM_WAIT() asm volatile("s_waitcnt vmcnt(0)" ::: "memory")

namespace pg8 {
constexpr int BM = 256, BK = 64, HALF = 128, HTB = HALF * BK * 2, STAGE_BYTES = 8 * HTB, NXCD = 8, WGM = 8;
__host__ __device__ __forceinline__ int lds_byte(int r, int c) { const int st = (r >> 4) * 2 + (c >> 5), rr = r & 15, cc = c & 31, ob = rr * 64 + cc * 2; return st * 1024 + (ob ^ (((ob >> 9) & 1) << 5)); }
__host__ __device__ __forceinline__ void stage_rc(int b, int& R, int& C) { const int st = b / 1024, sb = b % 1024, swz = sb ^ (((sb >> 9) & 1) << 5); R = (st >> 1) * 16 + swz / 64; C = (st & 1) * 32 + (swz % 64) / 2; }
__host__ __device__ __forceinline__ int perm32(int rho) { const int n = rho >> 4, i = rho & 15; return 8 * (i >> 2) + 4 * n + (i & 3); }

struct Unit { const char* A; const char* B; int pm, pn, e, nvalid; };

__device__ __forceinline__ bool static_tile(int i, int G, int c, int nM, int nN, int& pm, int& pn) {
    const int nwg = nM * nN; const long L = (long)i * G + c; if (L >= nwg) return false;
    int wgid = (int)L; { const int q = nwg / NXCD, r = nwg % NXCD, xcd = wgid % NXCD, off = wgid / NXCD; wgid = (xcd < r ? xcd * (q + 1) : r * (q + 1) + (xcd - r) * q) + off; }
    const int nig = WGM * nN, gid = wgid / nig, fm = gid * WGM, gsz = (nM - fm) < WGM ? (nM - fm) : WGM;
    pm = fm + ((wgid % nig) % gsz); pn = (wgid % nig) / gsz; return true;
}
struct DenseOrder {
    const char* A; const char* Bt; int nM, nN, K, G, c;
    __device__ __forceinline__ bool next(int i, Unit& u) const {
        int pm, pn; if (!static_tile(i, G, c, nM, nN, pm, pn)) return false;
        u.pm = pm; u.pn = pn; u.e = 0; u.nvalid = 256; u.A = A + (size_t)pm * 256 * K * 2; u.B = Bt + (size_t)pn * 256 * K * 2; return true;
    }
    __device__ __forceinline__ unsigned row_off(const Unit&, int) const { return 0u; }
};

__device__ __forceinline__ unsigned cvt_pk_bf16(float lo, float hi) { unsigned r; asm volatile("v_cvt_pk_bf16_f32 %0, %1, %2" : "=v"(r) : "v"(lo), "v"(hi)); return r; }

template <class Epi, class Sched, bool ALIGN_EPI, bool GATHER, bool MID>
__device__ __forceinline__ void gemm_phase(LAS unsigned char* lds, const int K, const Sched& S, const Epi& E) {
    int tid_ = threadIdx.x; asm volatile("" : "+v"(tid_));
    const int tid = tid_, wid = __builtin_amdgcn_readfirstlane(tid >> 6), lane = tid & 63, wr = wid >> 2, wc = wid & 3, fr = lane & 15, fq = lane >> 4;
    const int nt = K / BK;
    int Rst[2], Cst[2]; unsigned voffB[2];
#pragma unroll
    for (int i = 0; i < 2; ++i) { int R, C; stage_rc(tid * 16 + i * 8192, R, C); Rst[i] = R; Cst[i] = C; const int Rb = Epi::PERM ? ((R & ~31) + perm32(R & 31)) : R; voffB[i] = (unsigned)(Rb * K + C) * 2u; }
    const size_t kstep = (size_t)(BK * 2);
    const size_t hstep = (size_t)HALF * K * 2;
    const unsigned ldsw = (unsigned)wid * 1024u;
    const int aoff = lds_byte(wr * 64 + fr, fq * 8), boff = lds_byte(wc * 32 + fr, fq * 8);
#define PG8_SA(b, h) (((b) * 2 + (h)) * HTB)
#define PG8_SB(b, h) ((4 + (b) * 2 + (h)) * HTB)
#define PG8_STAGE(bufoff, gbase, voff) do { _Pragma("unroll") for (int _i = 0; _i < 2; ++_i) \
        __builtin_amdgcn_global_load_lds((const unsigned*)((const char*)(gbase) + (voff)[_i]), (LAS unsigned*)(lds + (bufoff) + ldsw + _i * 8192), 16, 0, 0); } while (0)
#define PG8_LDA(dst, b, h) do { _Pragma("unroll") for (int m = 0; m < 4; ++m) _Pragma("unroll") for (int k = 0; k < 2; ++k) dst[m][k] = *(const LAS bf16x8*)(lds + PG8_SA(b, h) + aoff + m * 2048 + k * 1024); } while (0)
#define PG8_LDB(dst, b, h) do { _Pragma("unroll") for (int n = 0; n < 2; ++n) _Pragma("unroll") for (int k = 0; k < 2; ++k) dst[n][k] = *(const LAS bf16x8*)(lds + PG8_SB(b, h) + boff + n * 2048 + k * 1024); } while (0)
#define PG8_MMA(ai, bj, At, Bt) do { __builtin_amdgcn_s_setprio(1); _Pragma("unroll") for (int m = 0; m < 4; ++m) _Pragma("unroll") for (int n = 0; n < 2; ++n) _Pragma("unroll") for (int k = 0; k < 2; ++k) \
        acc[ai][bj][m][n] = __builtin_amdgcn_mfma_f32_16x16x32_bf16(Bt[n][k], At[m][k], acc[ai][bj][m][n], 0, 0, 0); __builtin_amdgcn_s_setprio(0); } while (0)
#define PG8_WAIT_V(n) asm volatile("s_waitcnt vmcnt(" #n ")" ::: "memory")
#define PG8_WAIT_L(n) asm volatile("s_waitcnt lgkmcnt(" #n ")" ::: "memory")
#define PG8_BAR __builtin_amdgcn_s_barrier()
#define PG8_SCHED __builtin_amdgcn_sched_barrier(0)
#define PG8_AOFFS(dst, u) do { _Pragma("unroll") for (int _h = 0; _h < 2; ++_h) _Pragma("unroll") for (int _i = 0; _i < 2; ++_i) { \
        if constexpr (GATHER) dst[_h][_i] = S.row_off(u, _h * HALF + Rst[_i]) + (unsigned)Cst[_i] * 2u; \
        else dst[_h][_i] = (unsigned)((_h * HALF + Rst[_i]) * K + Cst[_i]) * 2u; } \
        if constexpr (GATHER) { asm volatile("" : "+v"(dst[0][0]), "+v"(dst[0][1]), "+v"(dst[1][0]), "+v"(dst[1][1]) :: "memory"); } } while (0)
    Unit cur, nxt; int ui = 0;
    if (!S.next(0, cur)) return;
    bool has_next = S.next(1, nxt);
    unsigned vA[2][2], vN[2][2];
    PG8_AOFFS(vA, cur);
    if constexpr (GATHER) { if (has_next) { PG8_AOFFS(vN, nxt); } else {
#pragma unroll
        for (int h = 0; h < 2; ++h) { vN[h][0] = vA[h][0]; vN[h][1] = vA[h][1]; } } }
    f32x4 acc[2][2][4][2];
#pragma unroll
    for (int a = 0; a < 2; ++a)
#pragma unroll
        for (int b = 0; b < 2; ++b)
#pragma unroll
            for (int m = 0; m < 4; ++m)
#pragma unroll
                for (int n = 0; n < 2; ++n) acc[a][b][m][n] = (f32x4){0.f, 0.f, 0.f, 0.f};
    bf16x8 At[4][2], B0[2][2], B1[2][2];
    const char* cA = cur.A; const char* cB = cur.B;
    PG8_STAGE(PG8_SB(0, 0), cB, voffB); PG8_STAGE(PG8_SB(0, 1), cB + hstep, voffB); PG8_STAGE(PG8_SA(0, 0), cA, vA[0]); PG8_STAGE(PG8_SA(0, 1), cA, vA[1]);
    if (wr == 1) PG8_BAR;
    PG8_WAIT_V(2); PG8_BAR;
    PG8_STAGE(PG8_SB(1, 0), cB + kstep, voffB); PG8_STAGE(PG8_SA(1, 0), cA + kstep, vA[0]); PG8_STAGE(PG8_SB(1, 1), cB + hstep + kstep, voffB);
    PG8_WAIT_V(6); PG8_BAR;
    for (;;) {
        const char* nA = has_next ? nxt.A : cA; const char* nB = has_next ? nxt.B : cB;
#pragma unroll 1
        for (int t = 0; t < nt; t += 2) {
            const bool last = (t == nt - 2);
            if constexpr (MID) { if (t == nt / 2) { int frE = fr, fqE = fq; asm volatile("" : "+v"(frE), "+v"(fqE)); E.mid(acc, cur, wr, wc, frE, fqE); } }
            const char* a1 = cA + (size_t)(t + 1) * kstep;
            const char* a2 = last ? nA : cA + (size_t)(t + 2) * kstep; const char* b2 = last ? nB : cB + (size_t)(t + 2) * kstep;
            const char* a3 = a2 + kstep; const char* b3 = b2 + kstep;
            unsigned v2[2][2];
#pragma unroll
            for (int h = 0; h < 2; ++h) { if constexpr (GATHER) { v2[h][0] = last ? vN[h][0] : vA[h][0]; v2[h][1] = last ? vN[h][1] : vA[h][1]; } else { v2[h][0] = vA[h][0]; v2[h][1] = vA[h][1]; } }
            PG8_LDB(B0, 0, 0); PG8_LDB(B1, 0, 1); PG8_SCHED; PG8_LDA(At, 0, 0); PG8_STAGE(PG8_SA(1, 1), a1, vA[1]);
            PG8_WAIT_V(8); PG8_WAIT_L(0); PG8_BAR; PG8_MMA(0, 0, At, B0); PG8_MMA(0, 1, At, B1); PG8_BAR; PG8_SCHED;
            PG8_LDA(At, 0, 1); PG8_STAGE(PG8_SB(0, 0), b2, voffB); PG8_STAGE(PG8_SB(0, 1), b2 + hstep, voffB); PG8_STAGE(PG8_SA(0, 0), a2, v2[0]);
            PG8_WAIT_V(8); PG8_WAIT_L(0); PG8_BAR; PG8_MMA(1, 0, At, B0); PG8_MMA(1, 1, At, B1); PG8_BAR; PG8_SCHED;
            PG8_LDB(B0, 1, 0); PG8_LDB(B1, 1, 1); PG8_SCHED; PG8_LDA(At, 1, 0); PG8_STAGE(PG8_SA(0, 1), a2, v2[1]);
            PG8_WAIT_V(8); PG8_WAIT_L(0); PG8_BAR; PG8_MMA(0, 0, At, B0); PG8_MMA(0, 1, At, B1); PG8_BAR; PG8_SCHED;
            PG8_LDA(At, 1, 1); PG8_STAGE(PG8_SB(1, 0), b3, voffB); PG8_STAGE(PG8_SB(1, 1), b3 + hstep, voffB); PG8_STAGE(PG8_SA(1, 0), a3, v2[0]);
            PG8_WAIT_V(8); PG8_WAIT_L(0); PG8_BAR; PG8_MMA(1, 0, At, B0); PG8_MMA(1, 1, At, B1); PG8_BAR; PG8_SCHED;
        }
        if constexpr (ALIGN_EPI) { if (wr == 0) PG8_BAR; }
        { int frE = fr, fqE = fq; asm volatile("" : "+v"(frE), "+v"(fqE));
          E(acc, cur, wr, wc, frE, fqE); }
        if (!has_next) break;
#pragma unroll
        for (int a = 0; a < 2; ++a)
#pragma unroll
            for (int b = 0; b < 2; ++b)
#pragma unroll
                for (int m = 0; m < 4; ++m)
#pragma unroll
                    for (int n = 0; n < 2; ++n) acc[a][b][m][n] = (f32x4){0.f, 0.f, 0.f, 0.f};
        cur = nxt; cA = nA; cB = nB; ++ui;
        if constexpr (GATHER) {
#pragma unroll
            for (int h = 0; h < 2; ++h) { vA[h][0] = vN[h][0]; vA[h][1] = vN[h][1]; } }
        has_next = S.next(ui + 1, nxt);
        if constexpr (GATHER) { if (has_next) { PG8_AOFFS(vN, nxt); } }
        if constexpr (ALIGN_EPI) { if (wr == 1) PG8_BAR; }
    }
    PG8_WAIT_V(0);
    if constexpr (!ALIGN_EPI) { if (wr == 0) PG8_BAR; }
    PG8_BAR;
#undef PG8_SA
#undef PG8_SB
#undef PG8_STAGE
#undef PG8_LDA
#undef PG8_LDB
#undef PG8_MMA
#undef PG8_WAIT_V
#undef PG8_WAIT_L
#undef PG8_BAR
#undef PG8_SCHED
#undef PG8_AOFFS
}
}

struct Args { const float* in[25]; float* out; unsigned char* ws; int ph_lo, ph_hi, li, pad; };
struct Frame {
    LAS unsigned char* lds; unsigned char* ws; GAS unsigned* ctl;
    int tid, lane, wave, vcu, G;
    float* out; const __attribute__((address_space(4))) char* ka;
};
#define FIN(i) (((const float* const __attribute__((address_space(4)))*)F.ka)[i])
enum { I_X = 0, I_P, I_RELB, I_ATTN_NORM, I_W_IN, I_SWA_QN, I_SWA_KN, I_SINKS, I_MOBA_QN, I_MOBA_KN, I_SWA_ON, I_MOBA_ON, I_W_OUT, I_FFN_NORM,
       I_W_RG, I_B_RG, I_W_RE, I_B_RE, I_W_EG, I_W_EU, I_W_ED, I_PLE_NORM, I_W_PG, I_W_PP, I_PLE_ON };

struct TrItem { const float* src; bf16_t* dst; const float* gk; int N, K; };
__device__ __forceinline__ int map_in(int n0) { const int head = n0 >> 6, d = n0 & 63; return 256 * (head >> 2) + 128 * (d >> 5) + 32 * (head & 3) + (d & 31); }
__device__ __forceinline__ int map_gu(int n0, int up) { return 256 * (n0 >> 7) + 128 * up + (n0 & 127); }
constexpr int TI_IN = (DM / 64) * (INW / 32), TI_OUT = (DM / 64) * (DM / 32), TI_PG = TI_OUT, TI_PP = (PLE / 64) * (DM / 32);
constexpr int TI_G1 = (DM / 64) * (DEXP / 32), TI_D1 = (DEXP / 64) * (DM / 32);
constexpr int TI_TOTAL = TI_IN + TI_OUT + TI_PG + TI_PP + NEXP * (2 * TI_G1);
constexpr int TI_DOWN_BASE = 1 << 20, TI_DOWN = NEXP * TI_D1;
__device__ __forceinline__ void tr_decode(const Frame& F, int it, TrItem& d) {
    unsigned char* ws = F.ws;
    const float* W; bf16_t* WT; const float* g = nullptr; int K, N, mode = 0, up = 0; int r = it;
    if (it >= TI_DOWN_BASE) r = 1 << 28;
    if (r < TI_IN) { W = FIN(I_W_IN); WT = (bf16_t*)(ws + WS_WIN); K = DM; N = INW; g = FIN(I_ATTN_NORM); mode = 1; }
    else if ((r -= TI_IN) < TI_OUT) { W = FIN(I_W_OUT); WT = (bf16_t*)(ws + WS_WOUT); K = DM; N = DM; mode = 3; }
    else if ((r -= TI_OUT) < TI_PG) { W = FIN(I_W_PG); WT = (bf16_t*)(ws + WS_WPG); K = DM; N = DM; g = FIN(I_PLE_NORM); }
    else if ((r -= TI_PG) < TI_PP) { W = FIN(I_W_PP); WT = (bf16_t*)(ws + WS_WPP); K = PLE; N = DM; }
    else if (it >= TI_DOWN_BASE) { r = it - TI_DOWN_BASE; const int e = r / TI_D1; r -= e * TI_D1; W = FIN(I_W_ED) + (size_t)e * DEXP * DM; WT = (bf16_t*)(ws + WS_WD) + (size_t)e * DM * DEXP; K = DEXP; N = DM; }
    else { r -= TI_PP; const int e = r / (2 * TI_G1); r -= e * (2 * TI_G1);
        if (r < TI_G1) { W = FIN(I_W_EG) + (size_t)e * DM * DEXP; WT = (bf16_t*)(ws + WS_WGU) + (size_t)e * DM * DM; K = DM; N = DEXP; g = FIN(I_FFN_NORM); mode = 2; up = 0; }
        else { r -= TI_G1; W = FIN(I_W_EU) + (size_t)e * DM * DEXP; WT = (bf16_t*)(ws + WS_WGU) + (size_t)e * DM * DM; K = DM; N = DEXP; g = FIN(I_FFN_NORM); mode = 2; up = 1; } }
    const int nblk = N / 32, kb = r / nblk, nb = r % nblk, k0 = 64 * kb, n0 = 32 * nb;
    if (mode == 3) g = (k0 < 512) ? FIN(I_SWA_ON) : (FIN(I_MOBA_ON) - 512);
    const int drow0 = mode == 1 ? map_in(n0) : mode == 2 ? map_gu(n0, up) : n0;
    d.src = W + (size_t)k0 * N + n0; d.dst = WT + (size_t)drow0 * K + k0; d.gk = g ? g + k0 : nullptr; d.N = N; d.K = K;
}
__device__ __forceinline__ void tr_load(const TrItem& d, int lane, float (&v)[32], f32x4 (&gv)[2]) {
    const float* p = d.src + (size_t)(lane >> 5) * d.N + (lane & 31);
#pragma unroll
    for (int i = 0; i < 32; ++i) v[i] = p[(size_t)(2 * i) * d.N];
    const int c = lane & 7;
    if (d.gk) { gv[0] = *(const f32x4*)(d.gk + 8 * c); gv[1] = *(const f32x4*)(d.gk + 8 * c + 4); } else { gv[0] = (f32x4){1.f, 1.f, 1.f, 1.f}; gv[1] = gv[0]; }
}
__device__ __forceinline__ void tr_process(const TrItem& d, int lane, const float (&v)[32], const f32x4 (&gv)[2], LAS float* scr) {
#pragma unroll
    for (int i = 0; i < 32; ++i) scr[(2 * i + (lane >> 5)) * 33 + (lane & 31)] = v[i];
    LDS_WAIT(); asm volatile("" ::: "memory");
    const int c = lane & 7;
#pragma unroll
    for (int j = 0; j < 4; ++j) { const int n = (lane >> 3) + 8 * j; const LAS float* sp = scr + (8 * c) * 33 + n;
        u32x4 o; o.x = pk2(sp[0 * 33] * gv[0][0], sp[1 * 33] * gv[0][1]); o.y = pk2(sp[2 * 33] * gv[0][2], sp[3 * 33] * gv[0][3]); o.z = pk2(sp[4 * 33] * gv[1][0], sp[5 * 33] * gv[1][1]); o.w = pk2(sp[6 * 33] * gv[1][2], sp[7 * 33] * gv[1][3]);
        *(GAS u32x4*)(d.dst + (size_t)n * d.K + 8 * c) = o; }
    LDS_WAIT(); asm volatile("" ::: "memory");
}

__constant__ unsigned char c_bucket[128] = {0,1,2,3,4,5,6,7,8,9,10,11,12,13,14,15,16,16,16,17,17,18,18,18,19,19,19,20,20,20,20,21,21,21,21,22,22,22,22,22,23,23,23,23,23,23,24,24,24,24,24,24,25,25,25,25,25,25,25,26,26,26,26,26,26,26,26,27,27,27,27,27,27,27,27,27,27,28,28,28,28,28,28,28,28,28,28,29,29,29,29,29,29,29,29,29,29,29,29,30,30,30,30,30,30,30,30,30,30,30,30,30,30,31,31,31,31,31,31,31,31,31,31,31,31,31,31,31};

__device__ __forceinline__ void tr_stream(Frame& F, LAS float* scr, int first, int step, int count, int base) {
    TrItem cur, nxt; float v[32], vn[32]; f32x4 gv[2], gn[2];
    int it = first; bool have = it < count;
    if (have) { tr_decode(F, base + it, cur); tr_load(cur, F.lane, v, gv); }
    while (have) {
        const int itn = it + step; const bool hn = itn < count;
        if (hn) { tr_decode(F, base + itn, nxt); tr_load(nxt, F.lane, vn, gn); }
        tr_process(cur, F.lane, v, gv, scr);
        cur = nxt; gv[0] = gn[0]; gv[1] = gn[1];
#pragma unroll
        for (int i = 0; i < 32; ++i) v[i] = vn[i];
        it = itn; have = hn;
    }
}
__device__ __forceinline__ void p0_prologue(Frame& F) {
    LAS float* scr = (LAS float*)(F.lds + F.wave * 16384);
    const int gw = F.vcu * NWAVES + F.wave, NGW = F.G * NWAVES;
    tr_stream(F, scr, gw, NGW, TI_TOTAL, 0);
    const float* x = FIN(I_X); bf16_t* xb = (bf16_t*)(F.ws + WS_XB); float* rs1 = (float*)(F.ws + WS_RS1);
    for (int m = gw; m < T; m += 2 * NGW) {
        const int m2 = m + NGW; const bool h2 = m2 < T;
        const GAS f32x4* xr = (const GAS f32x4*)(x + (size_t)m * DM) + F.lane; const GAS f32x4* xr2 = (const GAS f32x4*)(x + (size_t)(h2 ? m2 : m) * DM) + F.lane;
        f32x4 v[4], u[4]; float s = 0.f, s2 = 0.f;
#pragma unroll
        for (int j = 0; j < 4; ++j) { v[j] = xr[64 * j]; u[j] = xr2[64 * j]; }
#pragma unroll
        for (int j = 0; j < 4; ++j) { s += (v[j].x * v[j].x + v[j].y * v[j].y) + (v[j].z * v[j].z + v[j].w * v[j].w); s2 += (u[j].x * u[j].x + u[j].y * u[j].y) + (u[j].z * u[j].z + u[j].w * u[j].w); }
        s = wave_sum(s); s2 = wave_sum(s2);
        GAS u32x2* o8 = (GAS u32x2*)(xb + (size_t)m * DM) + F.lane;
#pragma unroll
        for (int j = 0; j < 4; ++j) { u32x2 w; w.x = pk2(v[j].x, v[j].y); w.y = pk2(v[j].z, v[j].w); o8[64 * j] = w; }
        if (F.lane == 0) rs1[m] = 1.0f / sqrtf(s * (1.0f / DM) + EPS);
        if (h2) { GAS u32x2* o9 = (GAS u32x2*)(xb + (size_t)m2 * DM) + F.lane;
#pragma unroll
            for (int j = 0; j < 4; ++j) { u32x2 w; w.x = pk2(u[j].x, u[j].y); w.y = pk2(u[j].z, u[j].w); o9[64 * j] = w; }
            if (F.lane == 0) rs1[m2] = 1.0f / sqrtf(s2 * (1.0f / DM) + EPS); }
    }
    { const GAS f32x4* p4 = (const GAS f32x4*)FIN(I_P); GAS u32x2* o = (GAS u32x2*)(F.ws + WS_PB); const int n4 = T * PLE / 4;
      for (int i = (F.vcu * NTHREADS + F.tid); i < n4; i += F.G * NTHREADS) { const f32x4 v = p4[i]; u32x2 w; w.x = pk2(v.x, v.y); w.y = pk2(v.z, v.w); o[i] = w; } }
    { bf16_t* Wt = (bf16_t*)(F.ws + WS_WR); const float* g = FIN(I_FFN_NORM); const float* wrg = FIN(I_W_RG); const float* wre = FIN(I_W_RE);
      for (int i = (F.vcu * NTHREADS + F.tid); i < 96 * DM; i += F.G * NTHREADS) { const int n = i / DM, c = i % DM; int o = -1; bool lo = false;
          if (n < 32) o = n; else if (n < 64) { o = n - 32; lo = true; } else if (n < 68) o = 32 + (n - 64); else if (n < 72) { o = 32 + (n - 68); lo = true; }
          unsigned short r = 0;
          if (o >= 0) { const float w = g[c] * ((o < 4) ? wrg[c * 4 + o] : wre[c * 32 + (o - 4)]); const unsigned h = f2bf(w); r = (unsigned short)h;
              if (lo) r = (unsigned short)f2bf(w - bf2f((unsigned short)h)); }
          Wt[i] = r; } }
    { float* tab = (float*)(F.ws + WS_BIAS);
      for (int i = (F.vcu * NTHREADS + F.tid); i < 16 * 132; i += F.G * NTHREADS) { const int hh = i / 132, dd = i % 132; const int bk = dd < 128 ? (int)c_bucket[dd] : 31;
          tab[i] = FIN(I_RELB)[bk * NHQ + hh] * LOG2E; } }
}

using pg8::Unit;
struct EpiQKV {
    static constexpr bool PERM = true;
    bf16_t* qkv; const float* rs1; const float* gq_a; const float* gk_a; const float* gq_b; const float* gk_b; float* kmp;
    __device__ __forceinline__ void operator()(const f32x4 (&acc)[2][2][4][2], const Unit& u, int wr, int wc, int fr, int fq) const {
        const int head = 4 * u.pn + wc;
        const float* gain = nullptr; float qs = 1.f; bool kmean = false;
        if (head < 8) { gain = gq_a; qs = QSCALE; } else if (head < 10) { gain = gk_a; } else if (head < 12) {} else if (head < 20) { gain = gq_b; qs = QSCALE; } else if (head < 22) { gain = gk_b; kmean = true; }
        f32x4 gv[2][2];
#pragma unroll
        for (int bj = 0; bj < 2; ++bj)
#pragma unroll
            for (int n = 0; n < 2; ++n) { if (gain) { gv[bj][n] = *(const f32x4*)(gain + 32 * bj + 8 * fq + 4 * n) * qs; } else gv[bj][n] = (f32x4){1.f, 1.f, 1.f, 1.f}; }
        f32x4 ks[2][2];
#pragma unroll
        for (int bj = 0; bj < 2; ++bj)
#pragma unroll
            for (int n = 0; n < 2; ++n) ks[bj][n] = (f32x4){0.f, 0.f, 0.f, 0.f};
        float rsv[2][4];
#pragma unroll
        for (int ai = 0; ai < 2; ++ai)
#pragma unroll
            for (int m = 0; m < 4; ++m) rsv[ai][m] = rs1[u.pm * 256 + ai * 128 + wr * 64 + m * 16 + fr];
        asm volatile("" ::: "memory");
#pragma unroll
        for (int ai = 0; ai < 2; ++ai)
#pragma unroll
            for (int m = 0; m < 4; ++m) {
                const int row = u.pm * 256 + ai * 128 + wr * 64 + m * 16 + fr; const float rs = rsv[ai][m];
                f32x4 v[2][2]; float ss = 0.f;
#pragma unroll
                for (int bj = 0; bj < 2; ++bj)
#pragma unroll
                    for (int n = 0; n < 2; ++n) { v[bj][n] = acc[ai][bj][m][n] * rs; const f32x4 q = v[bj][n] * v[bj][n]; ss += (q[0] + q[1]) + (q[2] + q[3]); }
                float rn = 1.f;
                if (gain) { ss += __shfl_xor(ss, 16); ss += __shfl_xor(ss, 32); rn = 1.0f / sqrtf(ss * (1.0f / HD) + EPS); }
                bf16_t* rowp = qkv + (size_t)row * INW + 64 * head + 8 * fq;
#pragma unroll
                for (int bj = 0; bj < 2; ++bj) { const f32x4 v0 = v[bj][0] * rn * gv[bj][0], v1 = v[bj][1] * rn * gv[bj][1];
                    if (kmean) { ks[bj][0] += v0; ks[bj][1] += v1; }
                    u32x4 w; w.x = pg8::cvt_pk_bf16(v0[0], v0[1]); w.y = pg8::cvt_pk_bf16(v0[2], v0[3]); w.z = pg8::cvt_pk_bf16(v1[0], v1[1]); w.w = pg8::cvt_pk_bf16(v1[2], v1[3]);
                    *(u32x4*)(rowp + 32 * bj) = w; }
            }
        if (kmean) {
#pragma unroll
            for (int bj = 0; bj < 2; ++bj)
#pragma unroll
                for (int n = 0; n < 2; ++n)
#pragma unroll
                    for (int i = 0; i < 4; ++i) { float s = ks[bj][n][i]; s += __shfl_xor(s, 1); s += __shfl_xor(s, 2); s += __shfl_xor(s, 4); s += __shfl_xor(s, 8);
                        if (fr == 0) kmp[((u.pm * 2 + wr) * 2 + (head - 20)) * 64 + 32 * bj + 8 * fq + 4 * n + i] = s; }
        }
    }
};
struct EpiProj {
    static constexpr bool PERM = true;
    bf16_t* praw; float* ssqp;
    __device__ __forceinline__ void operator()(const f32x4 (&acc)[2][2][4][2], const Unit& u, int wr, int wc, int fr, int fq) const {
#pragma unroll
        for (int ai = 0; ai < 2; ++ai)
#pragma unroll
            for (int m = 0; m < 4; ++m) {
                const int row = u.pm * 256 + ai * 128 + wr * 64 + m * 16 + fr; float ss = 0.f;
                bf16_t* rowp = praw + (size_t)row * DM + u.pn * 256 + wc * 32 + 8 * fq;
#pragma unroll
                for (int bj = 0; bj < 2; ++bj) { const f32x4 v0 = acc[ai][bj][m][0], v1 = acc[ai][bj][m][1];
                    const f32x4 q = v0 * v0 + v1 * v1; ss += (q[0] + q[1]) + (q[2] + q[3]);
                    u32x4 w; w.x = pg8::cvt_pk_bf16(v0[0], v0[1]); w.y = pg8::cvt_pk_bf16(v0[2], v0[3]); w.z = pg8::cvt_pk_bf16(v1[0], v1[1]); w.w = pg8::cvt_pk_bf16(v1[2], v1[3]);
                    *(u32x4*)(rowp + 128 * bj) = w; }
                ss += __shfl_xor(ss, 16); ss += __shfl_xor(ss, 32);
                if (fq == 0) ssqp[(size_t)row * 16 + u.pn * 4 + wc] = ss;
            }
    }
};
struct EpiOut {
    static constexpr bool PERM = true;
    bf16_t* x1b; const LAS f32x2* tab;
    __device__ __forceinline__ void mid(f32x4 (&acc)[2][2][4][2], const Unit& u, int wr, int wc, int fr, int fq) const {
#pragma unroll
        for (int ai = 0; ai < 2; ++ai)
#pragma unroll
            for (int m = 0; m < 4; ++m) { const f32x2 sc = tab[ai * 128 + wr * 64 + m * 16 + fr]; const float r = sc.x / sc.y;
#pragma unroll
                for (int bj = 0; bj < 2; ++bj)
#pragma unroll
                    for (int n = 0; n < 2; ++n) acc[ai][bj][m][n] *= r; }
    }
    __device__ __forceinline__ void operator()(const f32x4 (&acc)[2][2][4][2], const Unit& u, int wr, int wc, int fr, int fq) const {
        const int col0 = u.pn * 256 + wc * 32 + 8 * fq;
#pragma unroll
        for (int ai = 0; ai < 2; ++ai) {
            u32x4 xv[4][2];
#pragma unroll
            for (int m = 0; m < 4; ++m) { const size_t off = (size_t)(u.pm * 256 + ai * 128 + wr * 64 + m * 16 + fr) * DM + col0;
#pragma unroll
                for (int bj = 0; bj < 2; ++bj) xv[m][bj] = *(const u32x4*)(x1b + off + bj * 128); }
            asm volatile("" ::: "memory");
#pragma unroll
            for (int m = 0; m < 4; ++m) { const int r = ai * 128 + wr * 64 + m * 16 + fr; const float sb = tab[r].y; const size_t off = (size_t)(u.pm * 256 + r) * DM + col0;
#pragma unroll
                for (int bj = 0; bj < 2; ++bj) { const u32x4 xw = xv[m][bj];
                    const f32x4 o0 = (f32x4){bflo(xw.x), bfhi(xw.x), bflo(xw.y), bfhi(xw.y)} + acc[ai][bj][m][0] * sb, o1 = (f32x4){bflo(xw.z), bfhi(xw.z), bflo(xw.w), bfhi(xw.w)} + acc[ai][bj][m][1] * sb;
                    u32x4 w; w.x = pg8::cvt_pk_bf16(o0[0], o0[1]); w.y = pg8::cvt_pk_bf16(o0[2], o0[3]); w.z = pg8::cvt_pk_bf16(o1[0], o1[1]); w.w = pg8::cvt_pk_bf16(o1[2], o1[3]);
                    *(u32x4*)(x1b + off + bj * 128) = w; } }
            asm volatile("" ::: "memory");
        }
    }
};
struct MoeOrder {
    const char* A; const char* Bt; const LAS int* tb; const unsigned* cnt; const unsigned* list; int K; size_t wstride; size_t arow_bytes; int G, c; bool gather;
    __device__ __forceinline__ bool next(int i, Unit& u) const {
        const int NT = tb[NEXP]; const int nwg = NT * 4; const long L = (long)i * G + c; if (L >= nwg) return false;
        int wgid = (int)L; { const int q = nwg / 8, r = nwg % 8, xcd = wgid % 8, off = wgid / 8; wgid = (xcd < r ? xcd * (q + 1) : r * (q + 1) + (xcd - r) * q) + off; }
        const int gt = wgid >> 2, pn = wgid & 3; int e = 0;
#pragma unroll 1
        while (e < NEXP - 1 && gt >= tb[e + 1]) ++e;
        const int lt = gt - tb[e]; const int nv = (int)cnt[e] - lt * 256;
        u.pm = gt; u.pn = pn; u.e = e * 16384 + lt * 256; u.nvalid = nv < 256 ? nv : 256;
        u.A = gather ? A : A + (size_t)gt * 256 * arow_bytes; u.B = Bt + (size_t)e * wstride + (size_t)pn * 256 * K * 2; return true;
    }
    __device__ __forceinline__ unsigned row_off(const Unit& u, int r) const {
        const unsigned ent = (r < u.nvalid) ? list[u.e + r] : 0u; return (ent >> 1) * (unsigned)arow_bytes;
    }
};
struct EpiG1 {
    static constexpr bool PERM = true;
    bf16_t* H; const float* r2; const unsigned* list;
    __device__ __forceinline__ void operator()(const f32x4 (&acc)[2][2][4][2], const Unit& u, int wr, int wc, int fr, int fq) const {
        unsigned entv[2][4]; float rsv[2][4];
#pragma unroll
        for (int ai = 0; ai < 2; ++ai)
#pragma unroll
            for (int m = 0; m < 4; ++m) { const int r = ai * 128 + wr * 64 + m * 16 + fr; entv[ai][m] = (r < u.nvalid) ? list[u.e + r] : 0u; }
#pragma unroll
        for (int ai = 0; ai < 2; ++ai)
#pragma unroll
            for (int m = 0; m < 4; ++m) rsv[ai][m] = r2[entv[ai][m] >> 1];
        asm volatile("" ::: "memory");
#pragma unroll
        for (int ai = 0; ai < 2; ++ai)
#pragma unroll
            for (int m = 0; m < 4; ++m) { const int r = ai * 128 + wr * 64 + m * 16 + fr; const float rs = rsv[ai][m];
                float h[8];
#pragma unroll
                for (int n = 0; n < 2; ++n)
#pragma unroll
                    for (int i = 0; i < 4; ++i) { const float g = acc[ai][0][m][n][i] * rs, up = acc[ai][1][m][n][i] * rs; h[4 * n + i] = g / (1.0f + __builtin_amdgcn_exp2f(-g * LOG2E)) * up; }
                u32x4 w; w.x = pg8::cvt_pk_bf16(h[0], h[1]); w.y = pg8::cvt_pk_bf16(h[2], h[3]); w.z = pg8::cvt_pk_bf16(h[4], h[5]); w.w = pg8::cvt_pk_bf16(h[6], h[7]);
                *(u32x4*)(H + (size_t)(u.pm * 256 + r) * DEXP + u.pn * 128 + wc * 32 + 8 * fq) = w; }
    }
};
struct EpiG2 {
    static constexpr bool PERM = true;
    bf16_t* Y; const unsigned* list;
    __device__ __forceinline__ void operator()(const f32x4 (&acc)[2][2][4][2], const Unit& u, int wr, int wc, int fr, int fq) const {
        unsigned entv[2][4];
#pragma unroll
        for (int ai = 0; ai < 2; ++ai)
#pragma unroll
            for (int m = 0; m < 4; ++m) { const int r = ai * 128 + wr * 64 + m * 16 + fr; entv[ai][m] = (r < u.nvalid) ? list[u.e + r] : 0u; }
        asm volatile("" ::: "memory");
#pragma unroll
        for (int ai = 0; ai < 2; ++ai)
#pragma unroll
            for (int m = 0; m < 4; ++m) { const int r = ai * 128 + wr * 64 + m * 16 + fr;
                if (r < u.nvalid) { const unsigned ent = entv[ai][m]; bf16_t* rowp = Y + (size_t)ent * DM + u.pn * 256 + wc * 32 + 8 * fq;
#pragma unroll
                    for (int bj = 0; bj < 2; ++bj) { const f32x4 v0 = acc[ai][bj][m][0], v1 = acc[ai][bj][m][1];
                        u32x4 w; w.x = pg8::cvt_pk_bf16(v0[0], v0[1]); w.y = pg8::cvt_pk_bf16(v0[2], v0[3]); w.z = pg8::cvt_pk_bf16(v1[0], v1[1]); w.w = pg8::cvt_pk_bf16(v1[2], v1[3]);
                        *(u32x4*)(rowp + 128 * bj) = w; } } }
    }
};
struct EpiFinal {
    static constexpr bool PERM = false;
    float* out; const bf16_t* x2b; const bf16_t* praw; const float* gout; const LAS f32x2* tab;
    __device__ __forceinline__ void operator()(const f32x4 (&acc)[2][2][4][2], const Unit& u, int wr, int wc, int fr, int fq) const {
        const int col0 = u.pn * 256 + wc * 32 + 4 * fq;
        f32x4 gv[2][2];
#pragma unroll
        for (int bj = 0; bj < 2; ++bj)
#pragma unroll
            for (int n = 0; n < 2; ++n) gv[bj][n] = *(const f32x4*)(gout + col0 + bj * 128 + n * 16);
#pragma unroll
        for (int am = 0; am < 4; ++am) { const int ai = am >> 1, mb = 2 * (am & 1);
            u32x2 xw[2][2][2], pw[2][2][2];
#pragma unroll
            for (int mm = 0; mm < 2; ++mm) { const size_t off = (size_t)(u.pm * 256 + ai * 128 + wr * 64 + (mb + mm) * 16 + fr) * DM + col0;
#pragma unroll
                for (int bj = 0; bj < 2; ++bj)
#pragma unroll
                    for (int n = 0; n < 2; ++n) { xw[mm][bj][n] = *(const u32x2*)(x2b + off + bj * 128 + n * 16); pw[mm][bj][n] = *(const u32x2*)(praw + off + bj * 128 + n * 16); } }
            asm volatile("" ::: "memory");
#pragma unroll
            for (int mm = 0; mm < 2; ++mm) { const int m = mb + mm; const int r = ai * 128 + wr * 64 + m * 16 + fr; const f32x2 sc = tab[r]; const size_t off = (size_t)(u.pm * 256 + r) * DM + col0;
#pragma unroll
                for (int bj = 0; bj < 2; ++bj)
#pragma unroll
                    for (int n = 0; n < 2; ++n) { const u32x2 a = xw[mm][bj][n], p = pw[mm][bj][n];
                        const f32x4 xv = (f32x4){bflo(a.x), bfhi(a.x), bflo(a.y), bfhi(a.y)}, pv = (f32x4){bflo(p.x), bfhi(p.x), bflo(p.y), bfhi(p.y)}; f32x4 o;
#pragma unroll
                        for (int i = 0; i < 4; ++i) { const float z = acc[ai][bj][m][n][i] * sc.x; const float sg = 1.0f / (1.0f + __builtin_amdgcn_exp2f(-z * LOG2E)); o[i] = xv[i] + sg * (pv[i] * sc.y * gv[bj][n][i]); }
                        *(f32x4*)(out + off + bj * 128 + n * 16) = o; }
                asm volatile("" ::: "memory"); }
        }
    }
};

namespace att {
typedef float f32x16 __attribute__((ext_vector_type(16)));
typedef short s16x4 __attribute__((ext_vector_type(4)));
constexpr int NSLOT = 6, KBUF = 0, VBUF = NSLOT * 8192, LUT_OFF = 2 * NSLOT * 8192, KM_OFF = LUT_OFF + 2048;
constexpr float NEGBIG = -1e30f, MFLOOR = -1e20f;
__device__ __forceinline__ s16x4 vtr(const LAS unsigned char* p) { return __builtin_bit_cast(s16x4, __builtin_amdgcn_ds_read_tr16_b64_v4i16((LAS s16x4*)p)); }
__device__ __forceinline__ unsigned pkbf(float lo, float hi) { f32x2 v = {lo, hi}; typedef __bf16 bf2 __attribute__((ext_vector_type(2))); bf2 b = __builtin_convertvector(v, bf2); return __builtin_bit_cast(unsigned, b); }

template <int TYPE>
__device__ __forceinline__ void attn_unit(Frame& F, int b, int hlp, int n) {
    const int tid = F.tid, lane = F.lane, w = F.wave, r32 = lane & 31, hi = lane >> 5;
    const int hl = TYPE ? hlp : 2 * hlp + (w >> 2);
    const int hh = TYPE * 8 + hl, g = hl >> 2;
    const int colQ = (TYPE ? C_QB : C_QA) + 64 * hl, colK = (TYPE ? C_KB : C_KA) + 64 * g, colV = (TYPE ? C_VB : C_VA) + 64 * g;
    const bf16_t* qkv = (const bf16_t*)(F.ws + WS_QKV); bf16_t* O = (bf16_t*)(F.ws + WS_O); float* ssq = (float*)(F.ws + WS_SSQ);
    const float* tab = (const float*)(F.ws + WS_BIAS); const float* kmp = (const float*)(F.ws + WS_KMP);
    const size_t rowb = (size_t)b * SEQ;
    LAS unsigned char* L = F.lds; LAS float* lut = (LAS float*)(L + LUT_OFF) + (TYPE ? 0 : 316 * (w >> 2)); LAS float* kml = (LAS float*)(L + KM_OFF);
    const int q0w = TYPE ? 256 * n + 32 * w : 128 * n + 32 * (w & 3);
    const int t_lo = TYPE ? 0 : (2 * n - 2 > 0 ? 2 * n - 2 : 0), t_hi = TYPE ? 4 * n + 3 : 2 * n + 1;
    __syncthreads();
    for (int e = tid; e < (TYPE ? 316 : 632); e += NTHREADS) { const int ti = TYPE ? e : e % 316, hx = TYPE ? hh : 2 * hlp + e / 316; const int dist = 221 - ti; float v;
        if (dist < 0) v = NEGBIG; else if (dist < 128) v = tab[hx * 132 + dist] - (TYPE ? tab[hx * 132 + 128] : 0.f); else v = TYPE ? 0.f : NEGBIG;
        ((LAS float*)(L + LUT_OFF))[e] = v; }
    if (TYPE) { const int nb = tid >> 6, d = tid & 63; float v = 0.f;
        if (nb < n) { const int pm = b * 8 + nb; v = kmp[((pm * 2 + 0) * 2 + g) * 64 + d] + kmp[((pm * 2 + 1) * 2 + g) * 64 + d]; }
        kml[tid] = v; }
    bf16x8 qf[4];
    { const bf16_t* qp = qkv + (rowb + q0w + r32) * INW + colQ + 8 * hi;
#pragma unroll
      for (int d0 = 0; d0 < 4; ++d0) qf[d0] = *(const bf16x8*)(qp + 16 * d0); }
    const int srow = 8 * w + (lane >> 3);
    const bf16_t* kg = qkv + (rowb + srow) * INW + colK + 8 * ((lane & 7) ^ ((srow >> 1) & 7));
    const bf16_t* vg = qkv + (rowb + srow) * INW + colV + 8 * ((lane & 7) ^ (((srow >> 1) & 1) << 2));
    const int ntl = t_hi - t_lo + 1;
#define TILE_OF(i) (TYPE ? ((i) < 4 ? 4 * n + (i) : (i) - 4) : t_lo + (i))
#define STAGE(ti, slot) do { const int ti_ = (ti) < ntl ? (ti) : ntl - 1; const size_t go_ = (size_t)TILE_OF(ti_) * 64 * INW; \
        __builtin_amdgcn_global_load_lds((const unsigned*)(kg + go_), (LAS unsigned*)(L + KBUF + (slot) * 8192 + w * 1024), 16, 0, 0); \
        __builtin_amdgcn_global_load_lds((const unsigned*)(vg + go_), (LAS unsigned*)(L + VBUF + (slot) * 8192 + w * 1024), 16, 0, 0); } while (0)
    STAGE(0, 0); STAGE(1, 1); STAGE(2, 2); STAGE(3, 3);
    asm volatile("s_waitcnt vmcnt(4)" ::: "memory");
    asm volatile("s_waitcnt lgkmcnt(0)" ::: "memory"); __builtin_amdgcn_s_barrier(); asm volatile("" ::: "memory");
    unsigned sel = 0u;
    if (TYPE) {
        float gate[8];
#pragma unroll
        for (int nb = 0; nb < 8; ++nb) gate[nb] = 0.f;
#pragma unroll
        for (int d0 = 0; d0 < 4; ++d0) { float q8[8];
#pragma unroll
            for (int j = 0; j < 8; ++j) q8[j] = bf2f((unsigned short)qf[d0][j]);
#pragma unroll
            for (int nb = 0; nb < 7; ++nb) if (nb < n) { const f32x4 k0 = *(const LAS f32x4*)(kml + nb * 64 + 16 * d0 + 8 * hi), k1 = *(const LAS f32x4*)(kml + nb * 64 + 16 * d0 + 8 * hi + 4);
                gate[nb] += (q8[0] * k0[0] + q8[1] * k0[1]) + (q8[2] * k0[2] + q8[3] * k0[3]) + (q8[4] * k1[0] + q8[5] * k1[1]) + (q8[6] * k1[2] + q8[7] * k1[3]); } }
#pragma unroll
        for (int nb = 0; nb < 7; ++nb) gate[nb] += __shfl_xor(gate[nb], 32);
        const int nsel = n < 3 ? n : 3;
        for (int k = 0; k < nsel; ++k) { float best = -3e38f; int bi = 0;
#pragma unroll
            for (int nb = 0; nb < 7; ++nb) { const bool ok = (nb < n) && !((sel >> nb) & 1u) && (gate[nb] > best); if (ok) { best = gate[nb]; bi = nb; } }
            sel |= 1u << bi; }
    }
    float m = TYPE ? 0.f : FIN(I_SINKS)[hl] * LOG2E, l = (TYPE == 0 && hi == 0) ? 1.f : 0.f;
    f32x16 negm;
#pragma unroll
    for (int r = 0; r < 16; ++r) negm[r] = -m;
    f32x16 o0 = {}, o1 = {};
    const int qpos = q0w + r32;
    const int kroff = r32 * 128;  const int ksw = (r32 >> 1) & 7;
    const int q_ = (lane & 15) >> 2, p_ = lane & 3, sw = (q_ >> 1) & 1, clow = 2 * ((lane >> 4) & 1) + (p_ >> 1);
    const int vrow = (4 * hi + q_) * 128 + (p_ & 1) * 8;
    const int vb0 = vrow + ((4 * (0 ^ sw) + clow) << 4), vb1 = vrow + ((4 * (1 ^ sw) + clow) << 4);
    const int vaddr0 = (int)(unsigned)(unsigned long)(L + VBUF) + vb0, vaddr1 = (int)(unsigned)(unsigned long)(L + VBUF) + vb1;
    constexpr float THR = 8.0f;
#define ATT_STEP(IDX, SLOT) do { const int i = (IDX);         const int kt = TILE_OF(i); const int cur = (SLOT); \
        const int k0 = 64 * kt; const int dmax = q0w + 31 - k0, dmin = q0w - k0 - 63; \
        bool active, near, mine = true; \
        if (TYPE == 0) { active = (dmax >= 0) && (dmin <= 127); near = true; } \
        else if (kt >= 4 * n) { active = dmax >= 0; near = dmin < 128; } \
        else { mine = (sel >> (kt >> 2)) & 1u; active = __ballot(mine) != 0ull; near = dmin < 128; } \
        if (active) { \
            const LAS unsigned char* Kb = L + KBUF + cur * 8192; const LAS unsigned char* Vb = L + VBUF + cur * 8192; \
            f32x16 p0, p1, c = negm; \
            if (TYPE && kt < 4 * n) { \
        _Pragma("unroll") \
                for (int r = 0; r < 16; ++r) c[r] = mine ? negm[r] : NEGBIG; } \
            { const int co = ((0 + hi) ^ ksw) << 4; const bf16x8 ka = *(const LAS bf16x8*)(Kb + kroff + co), kb2 = *(const LAS bf16x8*)(Kb + 4096 + kroff + co); \
              p0 = __builtin_amdgcn_mfma_f32_32x32x16_bf16(ka, qf[0], c, 0, 0, 0); p1 = __builtin_amdgcn_mfma_f32_32x32x16_bf16(kb2, qf[0], c, 0, 0, 0); } \
        _Pragma("unroll") \
            for (int d0 = 1; d0 < 4; ++d0) { const int co = ((2 * d0 + hi) ^ ksw) << 4; \
                const bf16x8 ka = *(const LAS bf16x8*)(Kb + kroff + co), kb2 = *(const LAS bf16x8*)(Kb + 4096 + kroff + co); \
                p0 = __builtin_amdgcn_mfma_f32_32x32x16_bf16(ka, qf[d0], p0, 0, 0, 0); p1 = __builtin_amdgcn_mfma_f32_32x32x16_bf16(kb2, qf[d0], p1, 0, 0, 0); } \
            if (near) { const LAS float* lp = lut + (221 - (qpos - k0 - 4 * hi)); \
        _Pragma("unroll") \
                for (int r = 0; r < 16; ++r) { const int ko = (r & 3) + 8 * (r >> 2); p0[r] += lp[ko]; p1[r] += lp[32 + ko]; } } \
            float mx = __builtin_fmaxf(__builtin_fmaxf(p0[0], p1[0]), p0[1]); \
        _Pragma("unroll") \
            for (int r = 1; r < 16; ++r) mx = (r == 1) ? __builtin_fmaxf(mx, p1[1]) : __builtin_fmaxf(__builtin_fmaxf(mx, p0[r]), p1[r]); \
            mx = __builtin_fmaxf(mx, __shfl_xor(mx, 32)); \
            const bool first = (TYPE == 1) && (i == 0); \
            const float delta = first ? mx : (mx > THR ? mx : 0.f); \
            if (__ballot(delta != 0.f) != 0ull) { \
                m += delta; const float alpha = __builtin_amdgcn_exp2f(-delta); l *= alpha; \
        _Pragma("unroll") \
                for (int r = 0; r < 16; ++r) { o0[r] *= alpha; o1[r] *= alpha; negm[r] = -m; p0[r] -= delta; p1[r] -= delta; } \
            } \
            float ps = 0.f; \
        _Pragma("unroll") \
            for (int r = 0; r < 16; ++r) { p0[r] = __builtin_amdgcn_exp2f(p0[r]); p1[r] = __builtin_amdgcn_exp2f(p1[r]); ps += p0[r] + p1[r]; } \
            l += ps; \
            s16x4 ta[4][2], tc[4][2];                                    \
        _Pragma("unroll") \
            for (int s = 0; s < 4; ++s) { \
                asm volatile("ds_read_b64_tr_b16 %0, %1 offset:%c2" : "=&v"(ta[s][0]) : "v"(vaddr0 + cur * 8192), "i"(s * 2048) : "memory"); \
                asm volatile("ds_read_b64_tr_b16 %0, %1 offset:%c2" : "=&v"(ta[s][1]) : "v"(vaddr0 + cur * 8192), "i"(s * 2048 + 1024) : "memory"); \
                asm volatile("ds_read_b64_tr_b16 %0, %1 offset:%c2" : "=&v"(tc[s][0]) : "v"(vaddr1 + cur * 8192), "i"(s * 2048) : "memory"); \
                asm volatile("ds_read_b64_tr_b16 %0, %1 offset:%c2" : "=&v"(tc[s][1]) : "v"(vaddr1 + cur * 8192), "i"(s * 2048 + 1024) : "memory"); } \
            asm volatile("s_waitcnt lgkmcnt(0)" ::: "memory"); __builtin_amdgcn_sched_barrier(0); \
        _Pragma("unroll") \
            for (int s = 0; s < 4; ++s) { \
                u32x4 pw; \
                if (s < 2) { pw.x = pkbf(p0[8 * s + 0], p0[8 * s + 1]); pw.y = pkbf(p0[8 * s + 2], p0[8 * s + 3]); pw.z = pkbf(p0[8 * s + 4], p0[8 * s + 5]); pw.w = pkbf(p0[8 * s + 6], p0[8 * s + 7]); } \
                else { const int s2 = s - 2; pw.x = pkbf(p1[8 * s2 + 0], p1[8 * s2 + 1]); pw.y = pkbf(p1[8 * s2 + 2], p1[8 * s2 + 3]); pw.z = pkbf(p1[8 * s2 + 4], p1[8 * s2 + 5]); pw.w = pkbf(p1[8 * s2 + 6], p1[8 * s2 + 7]); } \
                const bf16x8 pb = __builtin_bit_cast(bf16x8, pw); \
                const s16x4 a0 = ta[s][0], a1 = ta[s][1], c0 = tc[s][0], c1 = tc[s][1]; \
                const bf16x8 va = (bf16x8){a0[0], a0[1], a0[2], a0[3], a1[0], a1[1], a1[2], a1[3]}, vc = (bf16x8){c0[0], c0[1], c0[2], c0[3], c1[0], c1[1], c1[2], c1[3]}; \
                o0 = __builtin_amdgcn_mfma_f32_32x32x16_bf16(va, pb, o0, 0, 0, 0); o1 = __builtin_amdgcn_mfma_f32_32x32x16_bf16(vc, pb, o1, 0, 0, 0); \
            } \
        } \
    } while (0)
    { int sc = 0;
      for (int i2 = 0; i2 < ntl; i2 += 2) {
          const int s4 = (sc + 4 >= NSLOT) ? sc + 4 - NSLOT : sc + 4, s5 = (sc + 5 >= NSLOT) ? sc + 5 - NSLOT : sc + 5, sn = sc + 1;
          STAGE(i2 + 4, s4); STAGE(i2 + 5, s5);
          ATT_STEP(i2, sc); ATT_STEP(i2 + 1, sn);
          asm volatile("s_waitcnt vmcnt(4)" ::: "memory");
          asm volatile("s_waitcnt lgkmcnt(0)" ::: "memory"); __builtin_amdgcn_s_barrier(); asm volatile("" ::: "memory");
          sc = (sc + 2 >= NSLOT) ? sc + 2 - NSLOT : sc + 2; } }
    asm volatile("s_waitcnt vmcnt(0)" ::: "memory");
#undef ATT_STEP
#undef STAGE
#undef TILE_OF
    l += __shfl_xor(l, 32);
    const float rl = 1.0f / l; float q2 = 0.f;
    const size_t t = rowb + qpos; bf16_t* op = O + t * DM + 64 * hh + 4 * hi;
#pragma unroll
    for (int c4 = 0; c4 < 4; ++c4) {
        const float a0 = o0[4 * c4 + 0] * rl, a1 = o0[4 * c4 + 1] * rl, a2 = o0[4 * c4 + 2] * rl, a3 = o0[4 * c4 + 3] * rl;
        const float b0 = o1[4 * c4 + 0] * rl, b1 = o1[4 * c4 + 1] * rl, b2 = o1[4 * c4 + 2] * rl, b3 = o1[4 * c4 + 3] * rl;
        q2 += (a0 * a0 + a1 * a1) + (a2 * a2 + a3 * a3) + (b0 * b0 + b1 * b1) + (b2 * b2 + b3 * b3);
        u32x2 wa; wa.x = pkbf(a0, a1); wa.y = pkbf(a2, a3); *(u32x2*)(op + 8 * c4) = wa;
        u32x2 wb; wb.x = pkbf(b0, b1); wb.y = pkbf(b2, b3); *(u32x2*)(op + 32 + 8 * c4) = wb;
    }
    q2 += __shfl_xor(q2, 32);
    if (hi == 0) ssq[t * 16 + hh] = q2;
}
}
namespace att2 {
typedef float f32x16 __attribute__((ext_vector_type(16)));
typedef short s16x4 __attribute__((ext_vector_type(4)));
typedef short v4i16_t __attribute__((ext_vector_type(4)));
typedef LAS const unsigned char* lds_cptr;
constexpr int NW = 8, QBLK = 32, QB = 256, KVBLK = 64, NSLOT = 3, SLOTB = 8192;
constexpr int LDS_K = 0, LDS_V = NSLOT * SLOTB, LDS_WS = 2 * NSLOT * SLOTB, LDS_OST = LDS_WS + NW * 64 * 4, LDS_LUT = LDS_OST + NW * 4096, LDS_KM = LDS_LUT + 2560, LDS_END = LDS_LUT + 5120;
constexpr int DMAXT = 383, NLUT = 639;
constexpr float NEGBIG = -1e30f;
__device__ __forceinline__ int crow(int r, int hi) { return (r & 3) + 8 * (r >> 2) + 4 * hi; }
#define SBAR() __builtin_amdgcn_sched_barrier(0)
__device__ __forceinline__ void glds16(const void* gsrc, unsigned lds_dst) { unsigned keep;
    asm volatile("s_mov_b32 %0, m0\n\ts_mov_b32 m0, %2\n\ts_nop 0\n\tglobal_load_lds_dwordx4 %1, off\n\ts_mov_b32 m0, %0" : "=&s"(keep) : "v"(gsrc), "s"(lds_dst) : "memory"); }
__device__ __forceinline__ float fadd_s(float a, float b) { float r; asm("v_add_f32_e32 %0, %1, %2" : "=v"(r) : "v"(a), "v"(b)); return r; }
__device__ __forceinline__ float fsub_s(float a, float b) { float r; asm("v_sub_f32_e32 %0, %1, %2" : "=v"(r) : "v"(a), "v"(b)); return r; }
__device__ __forceinline__ unsigned cvtpk_s(float lo, float hi) { f32x2 v = {lo, hi}; typedef __bf16 bf2 __attribute__((ext_vector_type(2))); bf2 b = __builtin_convertvector(v, bf2); return __builtin_bit_cast(unsigned, b); }
#define WAIT_BAR(N) asm volatile("s_waitcnt vmcnt(" #N ") lgkmcnt(0)\n\ts_barrier" ::: "memory")
__device__ __forceinline__ void qkt(f32x16& p0, f32x16& p1, lds_cptr Kslot, const bf16x8* qr, const f32x16& negm, int r32, int hi) {
    lds_cptr kb = Kslot + hi * 1024 + r32 * 16;
#pragma unroll
    for (int d0 = 0; d0 < 4; ++d0) {
        const bf16x8 b0 = *(const LAS bf16x8*)(kb + d0 * 2048), b1 = *(const LAS bf16x8*)(kb + d0 * 2048 + 512);
        if (d0 == 0) { p0 = __builtin_amdgcn_mfma_f32_32x32x16_bf16(b0, qr[0], negm, 0, 0, 0); p1 = __builtin_amdgcn_mfma_f32_32x32x16_bf16(b1, qr[0], negm, 0, 0, 0); }
        else { p0 = __builtin_amdgcn_mfma_f32_32x32x16_bf16(b0, qr[d0], p0, 0, 0, 0); p1 = __builtin_amdgcn_mfma_f32_32x32x16_bf16(b1, qr[d0], p1, 0, 0, 0); } }
}
__device__ __forceinline__ void kload8(bf16x8* kf, lds_cptr kp) {
    kf[0] = *(const LAS bf16x8*)(kp);        kf[1] = *(const LAS bf16x8*)(kp + 512);
    kf[2] = *(const LAS bf16x8*)(kp + 2048); kf[3] = *(const LAS bf16x8*)(kp + 2560);
    kf[4] = *(const LAS bf16x8*)(kp + 4096); kf[5] = *(const LAS bf16x8*)(kp + 4608);
    kf[6] = *(const LAS bf16x8*)(kp + 6144); kf[7] = *(const LAS bf16x8*)(kp + 6656);
}
__device__ __forceinline__ void kload2(bf16x8* kf, lds_cptr kp, int j) { kf[2 * j] = *(const LAS bf16x8*)(kp + j * 2048); kf[2 * j + 1] = *(const LAS bf16x8*)(kp + j * 2048 + 512); }
__device__ __forceinline__ s16x4 vtr(lds_cptr p) { return __builtin_bit_cast(s16x4, __builtin_amdgcn_ds_read_tr16_b64_v4i16((LAS v4i16_t*)p)); }
__device__ __forceinline__ float rowmax(const f32x16& p0, const f32x16& p1) {
    float a = __builtin_fmaxf(__builtin_fmaxf(p0[0], p0[1]), p1[0]), b = __builtin_fmaxf(__builtin_fmaxf(p0[2], p0[3]), p1[1]); a = __builtin_fmaxf(__builtin_fmaxf(a, p1[2]), p1[3]);
#pragma unroll
    for (int r = 4; r < 16; r += 4) { a = __builtin_fmaxf(__builtin_fmaxf(a, p0[r]), p0[r + 1]); b = __builtin_fmaxf(__builtin_fmaxf(b, p0[r + 2]), p0[r + 3]); a = __builtin_fmaxf(__builtin_fmaxf(a, p1[r]), p1[r + 1]); b = __builtin_fmaxf(__builtin_fmaxf(b, p1[r + 2]), p1[r + 3]); }
    const float m = __builtin_fmaxf(a, b);
    auto rr = __builtin_amdgcn_permlane32_swap(__float_as_uint(m), __float_as_uint(m), false, false);
    return __builtin_fmaxf(__uint_as_float(rr[0]), __uint_as_float(rr[1]));
}
__device__ __forceinline__ float xsum(float v) { auto rr = __builtin_amdgcn_permlane32_swap(__float_as_uint(v), __float_as_uint(v), false, false); return __uint_as_float(rr[0]) + __uint_as_float(rr[1]); }
__device__ __forceinline__ void pv(f32x16* o, int vb, bf16x8 pa0, bf16x8 pa1, bf16x8 pa2, bf16x8 pa3) {
#pragma unroll
    for (int d0 = 0; d0 < 2; ++d0) { s16x4 lo[4], hi[4];
#pragma unroll
        for (int ks = 0; ks < 4; ++ks) {
            asm volatile("ds_read_b64_tr_b16 %0,%1 offset:%c2" : "=&v"(lo[ks]) : "v"(vb), "i"(d0 * 4096 + ks * 1024) : "memory");
            asm volatile("ds_read_b64_tr_b16 %0,%1 offset:%c2" : "=&v"(hi[ks]) : "v"(vb), "i"(d0 * 4096 + ks * 1024 + 512) : "memory"); }
        asm volatile("s_waitcnt lgkmcnt(0)" ::: "memory"); SBAR();
#define PK(k) (bf16x8){lo[k][0], lo[k][1], lo[k][2], lo[k][3], hi[k][0], hi[k][1], hi[k][2], hi[k][3]}
        o[d0] = __builtin_amdgcn_mfma_f32_32x32x16_bf16(pa0, PK(0), o[d0], 0, 0, 0);
        o[d0] = __builtin_amdgcn_mfma_f32_32x32x16_bf16(pa1, PK(1), o[d0], 0, 0, 0);
        o[d0] = __builtin_amdgcn_mfma_f32_32x32x16_bf16(pa2, PK(2), o[d0], 0, 0, 0);
        o[d0] = __builtin_amdgcn_mfma_f32_32x32x16_bf16(pa3, PK(3), o[d0], 0, 0, 0);
#undef PK
    }
}

template <int TYPE, int THRL>
__device__ __forceinline__ void attn_unit(Frame& F, int b, int hlp, int n) {
    int tid_ = F.tid; asm volatile("" : "+v"(tid_));
    const int tid = tid_, lane = tid & 63, r32 = lane & 31, hi = lane >> 5; const int wid = F.wave;
    const int hl = TYPE ? hlp : 2 * hlp + (wid >> 2);
    const int hh = TYPE * 8 + hl, g = hl >> 2;
    const int colQ = (TYPE ? C_QB : C_QA) + 64 * hl, colK = (TYPE ? C_KB : C_KA) + 64 * g, colV = (TYPE ? C_VB : C_VA) + 64 * g;
    const bf16_t* qkv = (const bf16_t*)(F.ws + WS_QKV); bf16_t* O = (bf16_t*)(F.ws + WS_O); float* ssq = (float*)(F.ws + WS_SSQ);
    const float* tab = (const float*)(F.ws + WS_BIAS); const float* kmp = (const float*)(F.ws + WS_KMP);
    const long rowbase = (long)b * SEQ; const int q0 = TYPE ? n * QB : n * 128 + 0;
    const int qw0 = q0 + (TYPE ? wid : (wid & 3)) * QBLK;
    const lds_cptr shm3 = (lds_cptr)F.lds; LAS unsigned char* shmw = F.lds;
    const unsigned lds0 = (unsigned)(unsigned long)F.lds;
    LAS float* wsf = (LAS float*)(shmw + LDS_WS) + wid * 64;
    LAS float* lut = (LAS float*)(shmw + LDS_LUT) + (TYPE ? 0 : (wid >> 2) * 640); LAS float* kml = (LAS float*)(shmw + LDS_KM);
    const int t_lo = (2 * n - 2 > 0) ? 2 * n - 2 : 0;
    const int NT = TYPE ? 4 * n + 4 : 4;
#define TILE_OF(t) (TYPE ? ((t) < 4 ? 4 * n + (t) : (t) - 4) : t_lo + (t))
    for (int e = tid; e < (TYPE ? NLUT : 2 * 640); e += NTHREADS) { const int ei = TYPE ? e : e % 640, hx = TYPE ? hh : 2 * hlp + e / 640; const int dist = DMAXT - ei; float v;
        if (dist < 0 || ei >= NLUT) v = NEGBIG; else if (dist < 128) v = tab[hx * 132 + dist] - (TYPE ? tab[hx * 132 + 128] : 0.f); else v = TYPE ? 0.f : NEGBIG;
        ((LAS float*)(shmw + LDS_LUT))[e] = v; }
    if (TYPE) { const int nb = tid >> 6, d = tid & 63; float v = 0.f;
        if (nb < n) { const int pm = b * 8 + nb; v = kmp[((pm * 2 + 0) * 2 + g) * 64 + d] + kmp[((pm * 2 + 1) * 2 + g) * 64 + d]; }
        kml[tid] = v; }
    const bf16_t* Qw = qkv + (rowbase + qw0) * INW + colQ;
    const bf16_t* Kh = qkv + rowbase * INW + colK; const bf16_t* Vh = qkv + rowbase * INW + colV;
    const bf16_t* ksrc = Kh + (long)lane * INW + wid * 8;
    const bf16_t* vsrc = Vh + (long)(16 * (wid & 3) + (lane >> 2)) * INW + (wid >> 2) * 32 + (lane & 3) * 8;
    const unsigned kdst = lds0 + LDS_K + wid * 1024, vdst = lds0 + LDS_V + wid * 1024;
#define DMA_K(t, slot) glds16(ksrc + (long)TILE_OF(t) * KVBLK * INW, (unsigned)__builtin_amdgcn_readfirstlane(kdst + (slot)))
#define DMA_V(t, slot) glds16(vsrc + (long)TILE_OF(t) * KVBLK * INW, (unsigned)__builtin_amdgcn_readfirstlane(vdst + (slot)))
    const int vb0 = (int)(lds0 + LDS_V) + ((lane >> 4) & 1) * 32 + (lane & 3) * 8 + (4 * hi + ((lane & 15) >> 2)) * 64;
    bf16x8 kf[8];
    const lds_cptr kp0 = shm3 + LDS_K + hi * 1024 + r32 * 16; const lds_cptr vp0 = shm3 + LDS_V + ((lane >> 4) & 1) * 32 + (lane & 3) * 8 + (4 * hi + ((lane & 15) >> 2)) * 64;
    DMA_K(0, 0); DMA_V(0, 0); DMA_K(1, SLOTB);
    bf16x8 qr[4];
#pragma unroll
    for (int d0 = 0; d0 < 4; ++d0) qr[d0] = *(const bf16x8*)(&Qw[(long)r32 * INW + d0 * 16 + hi * 8]);
    float mhat = TYPE ? 0.f : FIN(I_SINKS)[hl] * LOG2E, l_reg = (TYPE == 0 && hi == 0) ? 1.f : 0.f;
    f32x16 o[2]; o[0] = f32x16{}; o[1] = f32x16{}; f32x16 negm;
#pragma unroll
    for (int r = 0; r < 16; ++r) negm[r] = -mhat;
    asm volatile("" : "+v"(negm));
    const int qpos = qw0 + r32;
    const LAS float* lutq = lut + (DMAXT - qpos + 4 * hi);
#define LUTADD(P0, P1, t) do { const LAS float* lp_ = lutq + 64 * TILE_OF(t); \
        _Pragma("unroll") for (int r = 0; r < 16; ++r) { const int ko_ = (r & 3) + 8 * (r >> 2); P0[r] += lp_[ko_]; P1[r] += lp_[32 + ko_]; } } while (0)
#define NEAR(t) (TYPE == 0 || (t) < 4 || (t) >= NT - 2)
    unsigned sel = 0u;
#define PASTMASKED(tt) (TYPE == 1 && (tt) >= 4 && !((sel >> (((tt) - 4) >> 2)) & 1u))
    bool resc = false;
#define START(P0, P1) do { const float rm = rowmax(P0, P1); resc = false; \
        { const float dl = TYPE ? rm : (rm > (float)THRL ? rm : 0.f); mhat = fadd_s(mhat, dl); l_reg *= __builtin_amdgcn_exp2f(-dl); \
          _Pragma("unroll") for (int r = 0; r < 16; ++r) { P0[r] = fsub_s(P0[r], dl); P1[r] = fsub_s(P1[r], dl); } \
          _Pragma("unroll") for (int r = 0; r < 16; ++r) negm[r] = -mhat; asm volatile("" : "+v"(negm)); } \
        _Pragma("unroll") for (int r = 0; r < 16; ++r) P0[r] = __builtin_amdgcn_exp2f(P0[r]); } while (0)
#define RESC() do { if (resc) { asm volatile("s_waitcnt lgkmcnt(0)" ::: "memory"); \
        _Pragma("unroll") for (int d_ = 0; d_ < 2; ++d_) _Pragma("unroll") for (int r = 0; r < 16; ++r) o[d_][r] *= wsf[crow(r, hi)]; } } while (0)
    f32x16 pA0, pA1, pB0, pB1;
    int sl_prev = 0, sl_cur = 0, sl_next = SLOTB;
#define ROT() do { sl_prev = sl_cur; sl_cur = sl_next; sl_next = (sl_next == (NSLOT - 1) * SLOTB) ? 0 : sl_next + SLOTB; } while (0)
    DMA_K(2, 2 * SLOTB);
    WAIT_BAR(3);
    qkt(pA0, pA1, shm3 + LDS_K, qr, negm, r32, hi); asm volatile("s_nop 15\n\ts_nop 7" : "+v"(pA0), "+v"(pA1)); LUTADD(pA0, pA1, 0);
    START(pA0, pA1);
#pragma unroll
    for (int r = 0; r < 16; ++r) pA1[r] = __builtin_amdgcn_exp2f(pA1[r]);
    if (TYPE) {
        float gate[8];
#pragma unroll
        for (int nb = 0; nb < 8; ++nb) gate[nb] = 0.f;
#pragma unroll
        for (int d0 = 0; d0 < 4; ++d0) { float q8[8];
#pragma unroll
            for (int j = 0; j < 8; ++j) q8[j] = bf2f((unsigned short)qr[d0][j]);
#pragma unroll
            for (int nb = 0; nb < 7; ++nb) if (nb < n) { const f32x4 k0 = *(const LAS f32x4*)(kml + nb * 64 + 16 * d0 + 8 * hi), k1 = *(const LAS f32x4*)(kml + nb * 64 + 16 * d0 + 8 * hi + 4);
                gate[nb] += (q8[0] * k0[0] + q8[1] * k0[1]) + (q8[2] * k0[2] + q8[3] * k0[3]) + (q8[4] * k1[0] + q8[5] * k1[1]) + (q8[6] * k1[2] + q8[7] * k1[3]); } }
#pragma unroll
        for (int nb = 0; nb < 7; ++nb) gate[nb] = xsum(gate[nb]);
        const int nsel = n < 3 ? n : 3;
        for (int k = 0; k < nsel; ++k) { float best = -3e38f; int bi = 0;
#pragma unroll
            for (int nb = 0; nb < 7; ++nb) { const bool ok = (nb < n) && !((sel >> nb) & 1u) && (gate[nb] > best); if (ok) { best = gate[nb]; bi = nb; } }
            sel |= 1u << bi; }
    }
    WAIT_BAR(0);
    DMA_K(3, 0); DMA_V(1, SLOTB);
    ROT();
    kload8(kf, kp0 + sl_cur);
    WAIT_BAR(2);
    s16x4 vlo[8], vhi[8]; u32x4 pw0, pw1, pw2, pw3;
#define PKW(P, B) cvtpk_s(P[B], P[B + 1])
#define PAF(k) __builtin_bit_cast(bf16x8, pw##k)
#define VFR(i) (bf16x8){vlo[i][0], vlo[i][1], vlo[i][2], vlo[i][3], vhi[i][0], vhi[i][1], vhi[i][2], vhi[i][3]}
#define PIN(x) asm volatile("" : "+v"(x))
#define MX3(a, b, c) __builtin_fmaxf(__builtin_fmaxf((a), (b)), (c))
#define GAPA(MF, A0, A1, A2, A3, W0, W1, PW) do { MF; sacc += A0; sacc += A1; sacc += A2; sacc += A3; PIN(sacc); W0; W1; PIN(PW); SBAR(); } while (0)
#define EX(v) __builtin_amdgcn_exp2f(v)
#define GAPB(MF, X, B) do { MF; X[B] = EX(X[B]); X[B + 1] = EX(X[B + 1]); X[B + 2] = EX(X[B + 2]); X[B + 3] = EX(X[B + 3]); PIN(X); SBAR(); } while (0)
#define VRD(i) do { vlo[i] = vtr(vp_ + (((i) >> 2) * 4096 + ((i) & 3) * 1024)); vhi[i] = vtr(vp_ + (((i) >> 2) * 4096 + ((i) & 3) * 1024 + 512)); } while (0)
#define KRD(G, j) do { if (G) { kload2(kf, kp0 + sl_next, j); SBAR(); } } while (0)
#define STEP(C0, C1, P0, P1, t, GK, GV, GL, MASKED) do { SBAR(); \
    const lds_cptr vp_ = vp0 + sl_prev; \
    VRD(0); SBAR(); float sacc = (P0[0] + P0[1]); \
    GAPA(C0 = __builtin_amdgcn_mfma_f32_32x32x16_bf16(kf[0], qr[0], negm, 0, 0, 0), P0[2], P0[3], P0[4], P0[5],     pw0[0] = PKW(P0, 0), pw0[1] = PKW(P0, 2), pw0); \
    VRD(4); SBAR(); GAPA(C1 = __builtin_amdgcn_mfma_f32_32x32x16_bf16(kf[1], qr[0], negm, 0, 0, 0), P0[6], P0[7], P0[8], P0[9],     pw0[2] = PKW(P0, 4), pw0[3] = PKW(P0, 6), pw0); \
    VRD(1); SBAR(); GAPA(C0 = __builtin_amdgcn_mfma_f32_32x32x16_bf16(kf[2], qr[1], C0, 0, 0, 0),   P0[10], P0[11], P0[12], P0[13], pw1[0] = PKW(P0, 8), pw1[1] = PKW(P0, 10), pw1); \
    VRD(5); SBAR(); GAPA(C1 = __builtin_amdgcn_mfma_f32_32x32x16_bf16(kf[3], qr[1], C1, 0, 0, 0),   P0[14], P0[15], P1[0], P1[1],   pw1[2] = PKW(P0, 12), pw1[3] = PKW(P0, 14), pw1); \
    VRD(2); SBAR(); GAPA(C0 = __builtin_amdgcn_mfma_f32_32x32x16_bf16(kf[4], qr[2], C0, 0, 0, 0),   P1[2], P1[3], P1[4], P1[5],     pw2[0] = PKW(P1, 0), pw2[1] = PKW(P1, 2), pw2); \
    VRD(6); SBAR(); GAPA(C1 = __builtin_amdgcn_mfma_f32_32x32x16_bf16(kf[5], qr[2], C1, 0, 0, 0),   P1[6], P1[7], P1[8], P1[9],     pw2[2] = PKW(P1, 4), pw2[3] = PKW(P1, 6), pw2); \
    VRD(3); SBAR(); GAPA(C0 = __builtin_amdgcn_mfma_f32_32x32x16_bf16(kf[6], qr[3], C0, 0, 0, 0),   P1[10], P1[11], P1[12], P1[13], pw3[0] = PKW(P1, 8), pw3[1] = PKW(P1, 10), pw3); \
    VRD(7); SBAR(); GAPA(C1 = __builtin_amdgcn_mfma_f32_32x32x16_bf16(kf[7], qr[3], C1, 0, 0, 0),   P1[14], P1[15], 0.f, 0.f,       pw3[2] = PKW(P1, 12), pw3[3] = PKW(P1, 14), pw3); \
    l_reg += sacc; \
    if (GK) { DMA_K((t) + 3, sl_cur); } if (GV) { DMA_V((t) + 1, sl_next); } \
    if (MASKED) { if (NEAR(t)) LUTADD(C0, C1, t); } \
    { float a = MX3(C0[0], C0[1], C1[0]), b_ = MX3(C0[2], C0[3], C1[1]); a = MX3(a, C1[2], C1[3]); \
      _Pragma("unroll") for (int r = 4; r < 16; r += 4) { a = MX3(a, C0[r], C0[r + 1]); b_ = MX3(b_, C0[r + 2], C0[r + 3]); a = MX3(a, C1[r], C1[r + 1]); b_ = MX3(b_, C1[r + 2], C1[r + 3]); } \
      float rm = __builtin_fmaxf(a, b_); { auto rr = __builtin_amdgcn_permlane32_swap(__float_as_uint(rm), __float_as_uint(rm), false, false); rm = __builtin_fmaxf(__uint_as_float(rr[0]), __uint_as_float(rr[1])); } \
      resc = false; \
      if (__builtin_expect(__any(rm > (float)THRL), 0)) { const float dl = __builtin_fmaxf(rm, 0.f); mhat += dl; \
        _Pragma("unroll") for (int r = 0; r < 16; ++r) { C0[r] -= dl; C1[r] -= dl; } \
        const float f = __builtin_amdgcn_exp2f(-dl); l_reg *= f; if (hi == 0) wsf[r32] = f; resc = true; } \
        \
      if (resc || (TYPE == 1 && ((t) + 1) >= 4 && ((((t) + 1) & 3) == 0))) { const float cv_ = PASTMASKED((t) + 1) ? NEGBIG : -mhat; \
        _Pragma("unroll") for (int r = 0; r < 16; ++r) negm[r] = cv_; asm volatile("" : "+v"(negm)); } } \
    SBAR(); \
    GAPB(o[0] = __builtin_amdgcn_mfma_f32_32x32x16_bf16(PAF(0), VFR(0), o[0], 0, 0, 0), C0, 0); \
    GAPB(o[1] = __builtin_amdgcn_mfma_f32_32x32x16_bf16(PAF(0), VFR(4), o[1], 0, 0, 0), C0, 4); \
    KRD(GL, 0); GAPB(o[0] = __builtin_amdgcn_mfma_f32_32x32x16_bf16(PAF(1), VFR(1), o[0], 0, 0, 0), C0, 8); \
    KRD(GL, 1); GAPB(o[1] = __builtin_amdgcn_mfma_f32_32x32x16_bf16(PAF(1), VFR(5), o[1], 0, 0, 0), C0, 12); \
    KRD(GL, 2); GAPB(o[0] = __builtin_amdgcn_mfma_f32_32x32x16_bf16(PAF(2), VFR(2), o[0], 0, 0, 0), C1, 0); \
    KRD(GL, 3); GAPB(o[1] = __builtin_amdgcn_mfma_f32_32x32x16_bf16(PAF(2), VFR(6), o[1], 0, 0, 0), C1, 4); \
    GAPB(o[0] = __builtin_amdgcn_mfma_f32_32x32x16_bf16(PAF(3), VFR(3), o[0], 0, 0, 0), C1, 8); \
    GAPB(o[1] = __builtin_amdgcn_mfma_f32_32x32x16_bf16(PAF(3), VFR(7), o[1], 0, 0, 0), C1, 12); \
    } while (0)
    int t = 1;
    for (; t < 5 && t + 5 < NT; t += 2) {
        STEP(pB0, pB1, pA0, pA1, t, true, true, true, true);     WAIT_BAR(2); RESC(); ROT();
        STEP(pA0, pA1, pB0, pB1, t + 1, true, true, true, true); WAIT_BAR(2); RESC(); ROT();
    }
    for (; t + 5 < NT; t += 2) {
        STEP(pB0, pB1, pA0, pA1, t, true, true, true, false);     WAIT_BAR(2); RESC(); ROT();
        STEP(pA0, pA1, pB0, pB1, t + 1, true, true, true, false); WAIT_BAR(2); RESC(); ROT();
    }
#define ENDW(tt) do { if ((tt) + 3 < NT) { WAIT_BAR(2); } else if ((tt) + 2 < NT) { WAIT_BAR(1); } else { WAIT_BAR(0); } } while (0)
    for (; t + 1 < NT; t += 2) {
        STEP(pB0, pB1, pA0, pA1, t, (t + 3 < NT), (t + 1 < NT), (t + 1 < NT), true);         ENDW(t);     RESC(); ROT();
        STEP(pA0, pA1, pB0, pB1, t + 1, (t + 4 < NT), (t + 2 < NT), (t + 2 < NT), true);     ENDW(t + 1); RESC(); ROT();
    }
    STEP(pB0, pB1, pA0, pA1, NT - 1, false, false, false, true); RESC();
    { float sacc = pB0[0] + pB0[1];
#pragma unroll
      for (int r = 2; r < 16; ++r) sacc += pB0[r];
#pragma unroll
      for (int r = 0; r < 16; ++r) sacc += pB1[r];
      l_reg += sacc;
      pw0 = (u32x4){PKW(pB0, 0), PKW(pB0, 2), PKW(pB0, 4), PKW(pB0, 6)}; pw1 = (u32x4){PKW(pB0, 8), PKW(pB0, 10), PKW(pB0, 12), PKW(pB0, 14)};
      pw2 = (u32x4){PKW(pB1, 0), PKW(pB1, 2), PKW(pB1, 4), PKW(pB1, 6)}; pw3 = (u32x4){PKW(pB1, 8), PKW(pB1, 10), PKW(pB1, 12), PKW(pB1, 14)};
      SBAR(); pv(o, vb0 + sl_cur, PAF(0), PAF(1), PAF(2), PAF(3)); }
#undef ENDW
#undef STEP
#undef KRD
#undef VRD
#undef GAPB
#undef EX
#undef GAPA
#undef MX3
#undef PIN
#undef VFR
#undef PAF
#undef PKW
    l_reg = xsum(l_reg);
    int lane_e = lane; asm volatile("" : "+v"(lane_e));
    if (hi == 0) wsf[32 + r32] = l_reg; asm volatile("s_waitcnt lgkmcnt(0)" ::: "memory");
    float rli[16];
#pragma unroll
    for (int r = 0; r < 16; ++r) rli[r] = __builtin_amdgcn_rcpf(wsf[32 + crow(r, hi)]);
    bf16_t* Ow = O + (rowbase + qw0) * DM + 64 * hh;
    { LAS bf16_t* stg = (LAS bf16_t*)(shmw + LDS_OST) + wid * 2048;
#pragma unroll
      for (int r = 0; r < 16; ++r) { const int orow = crow(r, hi);
#pragma unroll
          for (int d0 = 0; d0 < 2; ++d0) stg[orow * 64 + d0 * 32 + r32] = (bf16_t)f2bf(o[d0][r] * rli[r]); }
      asm volatile("s_waitcnt lgkmcnt(0)" ::: "memory");
#pragma unroll
      for (int i = 0; i < 4; ++i) { const int row = i * 8 + (lane_e >> 3), ch = lane_e & 7; const u32x4 v = *(const LAS u32x4*)(stg + row * 64 + ch * 8);
          *(u32x4*)(Ow + (long)row * DM + ch * 8) = v;
          float q2 = bflo(v.x) * bflo(v.x) + bfhi(v.x) * bfhi(v.x) + bflo(v.y) * bflo(v.y) + bfhi(v.y) * bfhi(v.y) + bflo(v.z) * bflo(v.z) + bfhi(v.z) * bfhi(v.z) + bflo(v.w) * bflo(v.w) + bfhi(v.w) * bfhi(v.w);
          q2 += __shfl_xor(q2, 1); q2 += __shfl_xor(q2, 2); q2 += __shfl_xor(q2, 4);
          if (ch == 0) ssq[(size_t)(rowbase + qw0 + row) * 16 + hh] = q2; } }
    asm volatile("s_waitcnt lgkmcnt(0)\n\ts_barrier" ::: "memory");
#undef DMA_K
#undef DMA_V
#undef LUTADD
#undef NEAR
#undef PASTMASKED
#undef START
#undef RESC
#undef ROT
#undef TILE_OF
}
#undef SBAR
#undef WAIT_BAR
}

__device__ __forceinline__ void p2_attention(Frame& F) {
    for (int j = F.vcu; j < 512; j += F.G) {
        if (j < 256) { const int b = j >> 5, hm = (j >> 2) & 7, pi = j & 3;
#pragma unroll 1
            for (int k = 0; k < 2; ++k) att2::attn_unit<1, 8>(F, b, hm, k ? pi : 7 - pi); }
        else { const int id = 2 * (j - 256);
#pragma unroll 1
            for (int k = 0; k < 2; ++k) { const int u = id + k; att2::attn_unit<0, 8>(F, u >> 6, (u >> 4) & 3, u & 15); } }
    }
    __syncthreads();
}

__device__ __forceinline__ void p4_router(Frame& F) {
    typedef float f32x16 __attribute__((ext_vector_type(16)));
    const bf16_t* x1b = (const bf16_t*)(F.ws + WS_X1B); float* r2 = (float*)(F.ws + WS_R2); const bf16_t* Wt = (const bf16_t*)(F.ws + WS_WR);
    LAS float* part = (LAS float*)F.lds;
    LAS float* sspart = (LAS float*)(F.lds + 98304);
    LAS int* lcnt = (LAS int*)(F.lds + MISC_OFF);
    LAS int* trec = (LAS int*)(F.lds + MISC_OFF + 512);
    unsigned* cnt = (unsigned*)(F.ctl + CW_CNT); unsigned* list = (unsigned*)(F.ws + WS_LIST); int* tok = (int*)(F.ws + WS_TOK);
    if (F.tid < 64) lcnt[F.tid] = 0;
    const int per = T / F.G;
    const int t0 = F.vcu * per;
    {
        const int tg = F.wave >> 2, kq = F.wave & 3, r32 = F.lane & 31, hi = F.lane >> 5;
        const bf16_t* ap = x1b + (size_t)(t0 + 32 * tg + r32) * DM + 256 * kq + 8 * hi;
        const bf16_t* bp = Wt + (size_t)r32 * DM + 256 * kq + 8 * hi;
        f32x16 a0 = {}, a1 = {}, a2 = {}; float ss = 0.f;
#pragma unroll 4
        for (int s = 0; s < 16; ++s) {
            const bf16x8 a = *(const bf16x8*)(ap + 16 * s);
            const bf16x8 b0 = *(const bf16x8*)(bp + 16 * s), b1 = *(const bf16x8*)(bp + (size_t)32 * DM + 16 * s), b2 = *(const bf16x8*)(bp + (size_t)64 * DM + 16 * s);
            a0 = __builtin_amdgcn_mfma_f32_32x32x16_bf16(a, b0, a0, 0, 0, 0); a1 = __builtin_amdgcn_mfma_f32_32x32x16_bf16(a, b1, a1, 0, 0, 0); a2 = __builtin_amdgcn_mfma_f32_32x32x16_bf16(a, b2, a2, 0, 0, 0);
#pragma unroll
            for (int j = 0; j < 8; ++j) { const float v = bf2f((unsigned short)a[j]); ss += v * v; }
        }
        LAS float* pp = part + ((tg * 4 + kq) * 32) * 96 + r32;
#pragma unroll
        for (int r = 0; r < 16; ++r) { const int tk = (r & 3) + 8 * (r >> 2) + 4 * hi; pp[tk * 96] = a0[r]; pp[tk * 96 + 32] = a1[r]; pp[tk * 96 + 64] = a2[r]; }
        sspart[((tg * 4 + kq) * 2 + hi) * 32 + r32] = ss;
    }
    __syncthreads();
    if (F.tid < per) {
        const int lt = F.tid, tg = lt >> 5, tk = lt & 31, t = t0 + lt;
        float lg[36]; float ssq = 0.f;
#pragma unroll
        for (int o = 0; o < 36; ++o) lg[o] = 0.f;
#pragma unroll
        for (int kq = 0; kq < 4; ++kq) { const LAS float* pr = part + ((tg * 4 + kq) * 32 + tk) * 96;
#pragma unroll
            for (int o = 0; o < 32; ++o) lg[o] += pr[o] + pr[32 + o];
#pragma unroll
            for (int o = 0; o < 4; ++o) lg[32 + o] += pr[64 + o] + pr[68 + o];
            ssq += sspart[((tg * 4 + kq) * 2 + 0) * 32 + tk] + sspart[((tg * 4 + kq) * 2 + 1) * 32 + tk]; }
        const float rs = 1.0f / sqrtf(ssq * (1.0f / DM) + EPS);
#pragma unroll
        for (int o = 0; o < 36; ++o) lg[o] *= rs;
        const float* brg = FIN(I_B_RG); const float* bre = FIN(I_B_RE);
        lg[0] += brg[0]; lg[1] += brg[1]; lg[2] += brg[2]; lg[3] += brg[3];
        int gsel = 0; float gm = lg[0];
#pragma unroll
        for (int o = 1; o < 4; ++o) if (lg[o] > gm) { gm = lg[o]; gsel = o; }
        float den = 0.f;
#pragma unroll
        for (int o = 0; o < 4; ++o) den += __expf(lg[o] - gm);
        const float gwt = 1.0f / den;
        float el[8];
#pragma unroll
        for (int j = 0; j < 8; ++j) { float a = lg[4 + j];
#pragma unroll
            for (int gq = 1; gq < 4; ++gq) a = (gsel == gq) ? lg[4 + 8 * gq + j] : a;
            el[j] = a + bre[gsel * 8 + j]; }
        int i0 = 0; float v0 = el[0];
#pragma unroll
        for (int j = 1; j < 8; ++j) if (el[j] > v0) { v0 = el[j]; i0 = j; }
        int i1 = -1; float v1 = -3e38f;
#pragma unroll
        for (int j = 0; j < 8; ++j) if (j != i0 && el[j] > v1) { v1 = el[j]; i1 = j; }
        const float e1 = __expf(v1 - v0); const float w0 = gwt / (1.0f + e1), w1 = gwt * e1 / (1.0f + e1);
        const int e0 = gsel * 8 + i0, e1i = gsel * 8 + i1;
        const int lr0 = __hip_atomic_fetch_add(&lcnt[e0], 1, __ATOMIC_RELAXED, __HIP_MEMORY_SCOPE_WORKGROUP);
        const int lr1 = __hip_atomic_fetch_add(&lcnt[e1i], 1, __ATOMIC_RELAXED, __HIP_MEMORY_SCOPE_WORKGROUP);
        trec[lt * 8 + 0] = e0; trec[lt * 8 + 1] = e1i; trec[lt * 8 + 2] = lr0; trec[lt * 8 + 3] = lr1;
        trec[lt * 8 + 4] = __builtin_bit_cast(int, w0); trec[lt * 8 + 5] = __builtin_bit_cast(int, w1);
        r2[t] = rs;
    }
    __syncthreads();
    if (F.tid < 32) { const int c = lcnt[F.tid]; int base = 0; if (c > 0) base = (int)__hip_atomic_fetch_add(&cnt[F.tid], (unsigned)c, __ATOMIC_RELAXED, __HIP_MEMORY_SCOPE_AGENT); lcnt[32 + F.tid] = base; }
    __syncthreads();
    for (int lt = F.tid; lt < per; lt += NTHREADS) {
        const int t = t0 + lt; const int e0 = trec[lt * 8 + 0], e1 = trec[lt * 8 + 1];
        const int rk0 = lcnt[32 + e0] + trec[lt * 8 + 2], rk1 = lcnt[32 + e1] + trec[lt * 8 + 3];
        list[e0 * 16384 + rk0] = (unsigned)(t * 2); list[e1 * 16384 + rk1] = (unsigned)(t * 2 + 1);
        int* tr = tok + (size_t)t * 8; tr[0] = e0; tr[1] = e1; tr[2] = rk0; tr[3] = rk1; tr[4] = trec[lt * 8 + 4]; tr[5] = trec[lt * 8 + 5];
    }
    __syncthreads();
}

__device__ __forceinline__ void build_tile_table(Frame& F, LAS int* tb) {
    if (F.tid < 64) {
        const unsigned* cnt = (const unsigned*)(F.ctl + CW_CNT);
        const int nt = (F.lane < NEXP) ? (int)((__hip_atomic_load(&cnt[F.lane & 31], __ATOMIC_RELAXED, __HIP_MEMORY_SCOPE_AGENT) + 255u) >> 8) : 0;
        int inc = nt;
#pragma unroll
        for (int o = 1; o < 32; o <<= 1) { const int v = __shfl_up(inc, o); if ((F.lane & 31) >= o) inc += v; }
        if (F.lane < NEXP) { tb[F.lane] = inc - nt; if (F.lane == NEXP - 1) tb[NEXP] = inc; }
    }
    __syncthreads();
}

__device__ __forceinline__ void p7_combine(Frame& F) {
    const bf16_t* x1b = (const bf16_t*)(F.ws + WS_X1B); const bf16_t* Y = (const bf16_t*)(F.ws + WS_Y); bf16_t* x2b = (bf16_t*)(F.ws + WS_X2B); float* r3 = (float*)(F.ws + WS_R3); const int* tok = (const int*)(F.ws + WS_TOK);
    const int gw = F.vcu * NWAVES + F.wave, NGW = F.G * NWAVES;
    for (int t = gw; t < T; t += 2 * NGW) {
        const int tb_ = (t + NGW < T) ? t + NGW : t; const bool two = tb_ != t;
        const f32x2 wa = *(const f32x2*)(tok + (size_t)t * 8 + 4), wb = *(const f32x2*)(tok + (size_t)tb_ * 8 + 4);
        u32x2 xa[2][4], ya[2][4], yb[2][4];
#pragma unroll
        for (int k = 0; k < 2; ++k) { const int tt = k ? tb_ : t;
            const GAS u32x2* xr = (const GAS u32x2*)(x1b + (size_t)tt * DM) + F.lane;
            const GAS u32x2* y0 = (const GAS u32x2*)(Y + (size_t)(2 * tt) * DM) + F.lane; const GAS u32x2* y1 = (const GAS u32x2*)(Y + (size_t)(2 * tt + 1) * DM) + F.lane;
#pragma unroll
            for (int j = 0; j < 4; ++j) { xa[k][j] = xr[64 * j]; ya[k][j] = y0[64 * j]; yb[k][j] = y1[64 * j]; } }
#pragma unroll
        for (int k = 0; k < 2; ++k) { const int tt = k ? tb_ : t; const float w0 = k ? wb.x : wa.x, w1 = k ? wb.y : wa.y;
            GAS u32x2* ob = (GAS u32x2*)(x2b + (size_t)tt * DM) + F.lane; float s = 0.f;
#pragma unroll
            for (int j = 0; j < 4; ++j) { f32x4 v;
                v.x = bflo(xa[k][j].x) + (w0 * bflo(ya[k][j].x) + w1 * bflo(yb[k][j].x)); v.y = bfhi(xa[k][j].x) + (w0 * bfhi(ya[k][j].x) + w1 * bfhi(yb[k][j].x));
                v.z = bflo(xa[k][j].y) + (w0 * bflo(ya[k][j].y) + w1 * bflo(yb[k][j].y)); v.w = bfhi(xa[k][j].y) + (w0 * bfhi(ya[k][j].y) + w1 * bfhi(yb[k][j].y));
                u32x2 w; w.x = pk2(v.x, v.y); w.y = pk2(v.z, v.w); if (k == 0 || two) ob[64 * j] = w; s += (v.x * v.x + v.y * v.y) + (v.z * v.z + v.w * v.w); }
            s = wave_sum(s);
            if (F.lane == 0 && (k == 0 || two)) r3[tt] = 1.0f / sqrtf(s * (1.0f / DM) + EPS); }
    }
}

#define XB_TMO      128
#define XB_XCNT(j)  (256  + 64 * (j))
#define XB_XSUB(j)  (1280 + 64 * (j))
#define XB_XGEN(j)  (2304 + 64 * (j))
#define XB_TOP      3328
#define XB_TOPGEN   3392
#define XCD_BAR_WORDS 3456
#define XB_SPIN_CAP (1u << 18)
__device__ __forceinline__ unsigned xb_ld(unsigned* p)              { return __hip_atomic_load(p, __ATOMIC_RELAXED, __HIP_MEMORY_SCOPE_AGENT); }
__device__ __forceinline__ unsigned xb_add(unsigned* p, unsigned v) { return __hip_atomic_fetch_add(p, v, __ATOMIC_RELAXED, __HIP_MEMORY_SCOPE_AGENT); }
__device__ __forceinline__ unsigned xb_xcc_id() { return (unsigned)__builtin_amdgcn_s_getreg((3 << 11) | 20) & 0xFu; }
#define XB_SPIN(cond, bar) do { unsigned _sp = 0; while (cond) { __builtin_amdgcn_s_sleep(1); \
    if ((++_sp & 255u) == 0u) { if (xb_ld(&(bar)[XB_TMO])) break; if (_sp > XB_SPIN_CAP) { atomicAdd(&(bar)[XB_TMO], 1u); break; } } } } while (0)
struct XcdBarrier { unsigned* bar; unsigned x; volatile LAS unsigned* st; };
__device__ __forceinline__ XcdBarrier xcd_barrier_post(unsigned* bar, volatile LAS unsigned* st) {
    XcdBarrier b; b.bar = bar; b.x = xb_xcc_id(); b.st = st;
    if (threadIdx.x == 0) (void)xb_add(&bar[XB_XCNT(b.x)], 1u);
    return b;
}
__device__ __forceinline__ void xcd_barrier_complete(unsigned* bar, unsigned x, unsigned& nloc, unsigned& nx) {
    const unsigned G = gridDim.x * gridDim.y * gridDim.z;
    unsigned sum, cnt, mine, sp = 0u;
    for (;;) {
        sum = 0u; cnt = 0u; mine = 0u;
#pragma unroll
        for (unsigned j = 0; j < 16; ++j) { const unsigned c = xb_ld(&bar[XB_XCNT(j)]); sum += c; cnt += (c > 0u) ? 1u : 0u; mine = (j == x) ? c : mine; }
        if (sum == G) break;
        __builtin_amdgcn_s_sleep(1);
        if ((++sp & 255u) == 0u) { if (xb_ld(&bar[XB_TMO])) break; if (sp > XB_SPIN_CAP) { atomicAdd(&bar[XB_TMO], 1u); break; } }
    }
    nloc = mine > 0u ? mine : 1u; nx = cnt > 0u ? cnt : 1u;
}
__device__ __forceinline__ void xcd_barrier(const XcdBarrier& b) {
    asm volatile("s_waitcnt vmcnt(0)" ::: "memory");
    __syncthreads();
    if (threadIdx.x == 0) {
        unsigned* bar = b.bar;
        __builtin_amdgcn_s_waitcnt(0);
        unsigned nloc = b.st[0], nx = b.st[1];
        if (nloc == 0u) { xcd_barrier_complete(bar, b.x, nloc, nx); b.st[0] = nloc; b.st[1] = nx; }
        const unsigned old = xb_add(&bar[XB_XSUB(b.x)], 1u);
        const unsigned gen = old / nloc;
        if (old + 1u == (gen + 1u) * nloc) {
            __builtin_amdgcn_fence(__ATOMIC_RELEASE, "agent");
            asm volatile("s_waitcnt vmcnt(0)" ::: "memory");
            const unsigned og = xb_add(&bar[XB_TOP], 1u);
            const unsigned tg = og / nx;
            if (og + 1u == (tg + 1u) * nx) xb_add(&bar[XB_TOPGEN], 1u);
            else XB_SPIN(xb_ld(&bar[XB_TOPGEN]) == tg, bar);
            __builtin_amdgcn_fence(__ATOMIC_ACQUIRE, "agent");
            xb_add(&bar[XB_XGEN(b.x)], 1u);
            asm volatile("s_waitcnt vmcnt(0)" ::: "memory");
        } else {
            XB_SPIN(xb_ld(&bar[XB_XGEN(b.x)]) == gen, bar);
            __builtin_amdgcn_fence(__ATOMIC_ACQUIRE, "agent");
            asm volatile("s_waitcnt vmcnt(0)" ::: "memory");
        }
    }
    __syncthreads();
}

__global__ void __launch_bounds__(NTHREADS, 2) hymba_fwd(Args args) {
    extern __shared__ __attribute__((aligned(16))) unsigned char lds[];
    Frame F;
    F.lds = (LAS unsigned char*)lds; unsigned char* ws;
#define REFRESH_IDS() do { int t_ = threadIdx.x; asm volatile("" : "+v"(t_)); F.tid = t_; F.lane = t_ & 63; F.wave = __builtin_amdgcn_readfirstlane(t_ >> 6); \
        unsigned char* w_ = args.ws; const __attribute__((address_space(4))) char* k_ = (const __attribute__((address_space(4))) char*)__builtin_amdgcn_kernarg_segment_ptr(); float* o_ = args.out; asm volatile("" : "+s"(w_), "+s"(k_), "+s"(o_)); \
        F.ws = w_; F.ka = k_; F.out = o_; F.ctl = (GAS unsigned*)(w_ + WS_CTL); ws = w_; } while (0)
    REFRESH_IDS();
    F.G = gridDim.x; { const int bx = blockIdx.x; F.vcu = (F.G % 8 == 0) ? (bx % 8) * (F.G / 8) + bx / 8 : bx; }
    const int lo = args.ph_lo, hi = args.ph_hi;
#ifdef ONLY_PHASE
#define IN(k) ((k) == ONLY_PHASE && lo <= (k) && (k) < hi)
#else
#define IN(k) (lo <= (k) && (k) < hi)
#endif
    LAS int* tb = (LAS int*)(F.lds + MISC_OFF + 8192);
    LAS f32x2* rowtab = (LAS f32x2*)(F.lds + MISC_OFF + 4096);
    volatile LAS unsigned* bst = (volatile LAS unsigned*)(F.lds + MISC_OFF + 12288);
    if (F.tid < 2) bst[F.tid] = 0u;
    __syncthreads();
    XcdBarrier bar; bar.bar = (unsigned*)(F.ctl + CW_BAR); bar.x = 0; bar.st = bst;
    if (hi - lo > 1) bar = xcd_barrier_post((unsigned*)(F.ctl + CW_BAR), bst);
#define SEAM(k) do { if (IN(k) && IN((k) + 1)) xcd_barrier(bar); } while (0)

    for (int rep = 0; rep < 1 + ((REPEAT_MASK >> 0) & 1); ++rep) { if (rep) xcd_barrier(bar);
    if (IN(0)) { REFRESH_IDS(); p0_prologue(F); }
    }
    SEAM(0);
    for (int rep = 0; rep < 1 + ((REPEAT_MASK >> 1) & 1); ++rep) { if (rep) xcd_barrier(bar);
    if (IN(1)) {
        REFRESH_IDS();
        { pg8::DenseOrder S{(const char*)(ws + WS_XB), (const char*)(ws + WS_WIN), T / 256, INW / 256, DM, F.G, (int)blockIdx.x};
          EpiQKV E{(bf16_t*)(ws + WS_QKV), (const float*)(ws + WS_RS1), FIN(I_SWA_QN), FIN(I_SWA_KN), FIN(I_MOBA_QN), FIN(I_MOBA_KN), (float*)(ws + WS_KMP)};
          pg8::gemm_phase<EpiQKV, pg8::DenseOrder, true, false, false>(F.lds, DM, S, E); }
        { const int hg = F.G / 2; const bool second = (int)blockIdx.x >= hg;
          pg8::DenseOrder S{(const char*)(ws + WS_PB), (const char*)(ws + WS_WPP), T / 256, DM / 256, PLE, second ? hg : (1 << 30), second ? (int)blockIdx.x - hg : (1 << 30)};
          EpiProj E{(bf16_t*)(ws + WS_PRAW), (float*)(ws + WS_SSQP)};
          pg8::gemm_phase<EpiProj, pg8::DenseOrder, true, false, false>(F.lds, PLE, S, E); }
    }
    }
    SEAM(1);
    for (int rep = 0; rep < 1 + ((REPEAT_MASK >> 2) & 1); ++rep) { if (rep) xcd_barrier(bar);
    if (IN(2)) { REFRESH_IDS(); p2_attention(F); }
    }
    SEAM(2);
    for (int rep = 0; rep < 1 + ((REPEAT_MASK >> 3) & 1); ++rep) { if (rep) xcd_barrier(bar);
    if (IN(3)) {
        pg8::DenseOrder S{(const char*)(ws + WS_O), (const char*)(ws + WS_WOUT), T / 256, DM / 256, DM, F.G, (int)blockIdx.x};
        REFRESH_IDS();
        { pg8::Unit u0; if (S.next(0, u0) && F.tid < 256) {
              const f32x4* p = (const f32x4*)((const float*)(ws + WS_SSQ) + (size_t)(u0.pm * 256 + F.tid) * 16); const f32x4 a0 = p[0], a1 = p[1], b0 = p[2], b1 = p[3];
              const float qa = ((a0[0] + a0[1]) + (a0[2] + a0[3])) + ((a1[0] + a1[1]) + (a1[2] + a1[3])), qb = ((b0[0] + b0[1]) + (b0[2] + b0[3])) + ((b1[0] + b1[1]) + (b1[2] + b1[3]));
              rowtab[F.tid] = (f32x2){1.0f / sqrtf(qa * (1.0f / 512.f) + EPS), 1.0f / sqrtf(qb * (1.0f / 512.f) + EPS)}; }
          __syncthreads(); }
        EpiOut E{(bf16_t*)(ws + WS_X1B), (const LAS f32x2*)rowtab};
        pg8::gemm_phase<EpiOut, pg8::DenseOrder, false, false, true>(F.lds, DM, S, E);
    }
    }
    SEAM(3);
    if (IN(4)) { REFRESH_IDS(); p4_router(F); }
    SEAM(4);
    for (int rep = 0; rep < 1 + ((REPEAT_MASK >> 5) & 1); ++rep) { if (rep) xcd_barrier(bar);
    if (IN(5)) {
        REFRESH_IDS(); build_tile_table(F, tb);
        MoeOrder S{(const char*)(ws + WS_X1B), (const char*)(ws + WS_WGU), tb, (const unsigned*)(F.ctl + CW_CNT), (const unsigned*)(ws + WS_LIST), DM, (size_t)DM * DM * 2, (size_t)DM * 2, F.G, (int)blockIdx.x, true};
        EpiG1 E{(bf16_t*)(ws + WS_H), (const float*)(ws + WS_R2), (const unsigned*)(ws + WS_LIST)};
        pg8::gemm_phase<EpiG1, MoeOrder, true, true, false>(F.lds, DM, S, E);
        { REFRESH_IDS();
          const int nwg = tb[NEXP] * 4, G = F.G, c = (int)blockIdx.x;
          const int maxnu = (nwg + G - 1) / G, nu = (nwg - c + G - 1) / G;
          const int nfull = nwg - (maxnu - 1) * G;
          const bool all = (nfull >= G);
          const int W = all ? G : G - nfull, rank = all ? c : c - nfull;
          if (all || nu < maxnu) { LAS float* scr = (LAS float*)(F.lds + F.wave * 16384); tr_stream(F, scr, rank * NWAVES + F.wave, W * NWAVES, TI_DOWN, TI_DOWN_BASE); } }
    }
    }
    SEAM(5);
    for (int rep = 0; rep < 1 + ((REPEAT_MASK >> 6) & 1); ++rep) { if (rep) xcd_barrier(bar);
    if (IN(6)) {
        REFRESH_IDS(); build_tile_table(F, tb);
        MoeOrder S{(const char*)(ws + WS_H), (const char*)(ws + WS_WD), tb, (const unsigned*)(F.ctl + CW_CNT), (const unsigned*)(ws + WS_LIST), DEXP, (size_t)DM * DEXP * 2, (size_t)DEXP * 2, F.G, (int)blockIdx.x, false};
        EpiG2 E{(bf16_t*)(ws + WS_Y), (const unsigned*)(ws + WS_LIST)};
        pg8::gemm_phase<EpiG2, MoeOrder, true, false, false>(F.lds, DEXP, S, E);
    }
    }
    SEAM(6);
    if (IN(7)) { REFRESH_IDS(); p7_combine(F); }
    SEAM(7);
    if (IN(8)) {
        pg8::DenseOrder S{(const char*)(ws + WS_X2B), (const char*)(ws + WS_WPG), T / 256, DM / 256, DM, F.G, (int)blockIdx.x};
        REFRESH_IDS();
        { pg8::Unit u0; if (S.next(0, u0) && F.tid < 256) {
              const int row = u0.pm * 256 + F.tid; const f32x4* sp = (const f32x4*)((const float*)(ws + WS_SSQP) + (size_t)row * 16); const f32x4 s0 = sp[0], s1 = sp[1], s2 = sp[2], s3 = sp[3];
              const float q = (((s0[0] + s0[1]) + (s0[2] + s0[3])) + ((s1[0] + s1[1]) + (s1[2] + s1[3]))) + (((s2[0] + s2[1]) + (s2[2] + s2[3])) + ((s3[0] + s3[1]) + (s3[2] + s3[3])));
              rowtab[F.tid] = (f32x2){((const float*)(ws + WS_R3))[row], 1.0f / sqrtf(q * (1.0f / DM) + EPS)}; }
          __syncthreads(); }
        EpiFinal E{F.out, (const bf16_t*)(ws + WS_X2B), (const bf16_t*)(ws + WS_PRAW), FIN(I_PLE_ON), (const LAS f32x2*)rowtab};
        pg8::gemm_phase<EpiFinal, pg8::DenseOrder, false, false, false>(F.lds, DM, S, E);
    }
#undef IN
#undef SEAM
}

extern "C" void kernel_launch(void* const* d_in, const int* in_sizes, int n_in, void* d_out, int out_size, void* d_ws, size_t ws_size, hipStream_t stream) {
    static int grid = 0;
    if (grid == 0) {
        if (n_in != 25 || in_sizes[0] != T * DM || out_size != T * DM || ws_size < WS_END) { fprintf(stderr, "kernel_launch: unexpected shapes (n_in %d, in0 %d, out %d, ws %zu)\n", n_in, n_in > 0 ? in_sizes[0] : -1, out_size, ws_size); grid = -1; return; }
        int dev = 0, cus = 0, per_cu = 0;
        if (hipGetDevice(&dev) != hipSuccess || hipDeviceGetAttribute(&cus, hipDeviceAttributeMultiprocessorCount, dev) != hipSuccess) { grid = -1; return; }
        if (hipFuncSetAttribute((const void*)hymba_fwd, hipFuncAttributeMaxDynamicSharedMemorySize, LDS_BYTES) != hipSuccess) { fprintf(stderr, "kernel_launch: hipFuncSetAttribute failed\n"); grid = -1; return; }
        if (hipOccupancyMaxActiveBlocksPerMultiprocessor(&per_cu, (const void*)hymba_fwd, NTHREADS, LDS_BYTES) != hipSuccess || per_cu < 1) { fprintf(stderr, "kernel_launch: occupancy query says %d\n", per_cu); per_cu = 1; }
        (void)hipGetLastError();
        grid = cus;
        if (grid != 256) { fprintf(stderr, "kernel_launch: %d CUs; this kernel is built for 256 (one 256x256 tile per workgroup in the N=1024 GEMM phases)\n", grid); grid = -1; return; }
    }
    if (grid < 0) return;
    (void)hipMemsetAsync((char*)d_ws + WS_CTL, 0, CTL_ZERO_BYTES, stream);
    Args a{};
    for (int i = 0; i < 25; ++i) a.in[i] = (const float*)d_in[i];
    a.out = (float*)d_out; a.ws = (unsigned char*)d_ws;
    constexpr int NPH = 9;
    for (int li = 0; li < MK_N_LAUNCHES; ++li) {
        a.ph_lo = (MK_N_LAUNCHES == NPH) ? li : 0; a.ph_hi = (MK_N_LAUNCHES == NPH) ? li + 1 : NPH; a.li = li;
        hipLaunchKernelGGL(hymba_fwd, dim3(grid), dim3(NTHREADS), LDS_BYTES, stream, a);
    }
}
```

```cpp
#include <hip/hip_runtime.h>
#include <cstdio>
#include <cstdint>

#ifndef MK_N_LAUNCHES
#define MK_N_LAUNCHES 1
#endif

#ifndef REPEAT_MASK
#define REPEAT_MASK 0
#endif
#define LAS __attribute__((address_space(3)))
#define GAS __attribute__((address_space(1)))
typedef unsigned short bf16_t;
typedef short bf16x8 __attribute__((ext_vector_type(8)));
typedef float f32x4 __attribute__((ext_vector_type(4)));
typedef float f32x2 __attribute__((ext_vector_type(2)));
typedef unsigned u32x4 __attribute__((ext_vector_type(4)));
typedef unsigned u32x2 __attribute__((ext_vector_type(2)));

constexpr int BATCH = 8, SEQ = 2048, DM = 1024, T = BATCH * SEQ;
constexpr int INW = 1536, NHQ = 16, HD = 64;
constexpr int NEXP = 32, DEXP = 512, PLE = 256;
constexpr int MAXTILES = 160;
constexpr float EPS = 1e-6f;
constexpr float LOG2E = 1.4426950408889634f;
constexpr float QSCALE = 0.125f * LOG2E;
constexpr int NWAVES = 8, NTHREADS = 512;

constexpr int C_QA = 0, C_KA = 512, C_VA = 640, C_QB = 768, C_KB = 1280, C_VB = 1408;

constexpr size_t KiB = 1024, MiB = 1u << 20;
constexpr size_t WS_CTL = 0, CTL_ZERO_BYTES = 1 * MiB;
constexpr size_t WS_RS1 = 1 * MiB, WS_R2 = WS_RS1 + 64 * KiB, WS_R3 = WS_R2 + 64 * KiB, WS_KMP = WS_R3 + 64 * KiB;
constexpr size_t WS_WR = WS_KMP + 64 * KiB;
constexpr size_t WS_BIAS = WS_WR + 192 * KiB;
constexpr size_t WS_TOK = 1 * MiB + 512 * KiB;
constexpr size_t WS_SSQ = 2 * MiB;
constexpr size_t WS_SSQP = 3 * MiB;
constexpr size_t WS_LIST = 4 * MiB;
constexpr size_t WS_WIN = 8 * MiB, WS_WOUT = 11 * MiB, WS_WPG = 13 * MiB, WS_WPP = 15 * MiB;
constexpr size_t WS_WGU = 16 * MiB;
constexpr size_t WS_WD = 80 * MiB;
constexpr size_t WS_PRAW = 112 * MiB;
constexpr size_t WS_X1B = 144 * MiB;
constexpr size_t WS_X2B = WS_X1B;
constexpr size_t WS_H = 176 * MiB;
constexpr size_t WS_Y = 216 * MiB;
constexpr size_t WS_QKV = 176 * MiB;
constexpr size_t WS_O = 224 * MiB;
constexpr size_t WS_PB = 240 * MiB;
constexpr size_t WS_XB = WS_X1B;
constexpr size_t WS_END = 280 * MiB;
constexpr int CW_CNT = 64;
constexpr int CW_BAR = 4096;

constexpr int RING_BYTES = 131072;
constexpr int MISC_OFF = 147456;
constexpr int LDS_BYTES = 163840;

__device__ __forceinline__ unsigned f2bf(float f) { unsigned u = __builtin_bit_cast(unsigned, f); return (u + 0x7fffu + ((u >> 16) & 1u)) >> 16; }
__device__ __forceinline__ unsigned pk2(float lo, float hi) { return f2bf(lo) | (f2bf(hi) << 16); }
__device__ __forceinline__ float bf2f(unsigned short h) { return __builtin_bit_cast(float, (unsigned)h << 16); }
__device__ __forceinline__ float bflo(unsigned w) { return __builtin_bit_cast(float, w << 16); }
__device__ __forceinline__ float bfhi(unsigned w) { return __builtin_bit_cast(float, w & 0xffff0000u); }
__device__ __forceinline__ float wave_sum(float v) {
#pragma unroll
    for (int o = 1; o < 64; o <<= 1) v += __shfl_xor(v, o);
    return v;
}
__device__ __forceinline__ float wave_max(float v) {
#pragma unroll
    for (int o = 1; o < 64; o <<= 1) v = fmaxf(v, __shfl_xor(v, o));
    return v;
}
#define LDS_WAIT() asm volatile("s_waitcnt lgkmcnt(0)" ::: "memory")
#define VM_WAIT() asm volatile("s_waitcnt vmcnt(0)" ::: "memory")

namespace pg8 {
constexpr int BM = 256, BK = 64, HALF = 128, HTB = HALF * BK * 2, STAGE_BYTES = 8 * HTB, NXCD = 8, WGM = 8;
__host__ __device__ __forceinline__ int lds_byte(int r, int c) { const int st = (r >> 4) * 2 + (c >> 5), rr = r & 15, cc = c & 31, ob = rr * 64 + cc * 2; return st * 1024 + (ob ^ (((ob >> 9) & 1) << 5)); }
__host__ __device__ __forceinline__ void stage_rc(int b, int& R, int& C) { const int st = b / 1024, sb = b % 1024, swz = sb ^ (((sb >> 9) & 1) << 5); R = (st >> 1) * 16 + swz / 64; C = (st & 1) * 32 + (swz % 64) / 2; }
__host__ __device__ __forceinline__ int perm32(int rho) { const int n = rho >> 4, i = rho & 15; return 8 * (i >> 2) + 4 * n + (i & 3); }

struct Unit { const char* A; const char* B; int pm, pn, e, nvalid; };

__device__ __forceinline__ bool static_tile(int i, int G, int c, int nM, int nN, int& pm, int& pn) {
    const int nwg = nM * nN; const long L = (long)i * G + c; if (L >= nwg) return false;
    int wgid = (int)L; { const int q = nwg / NXCD, r = nwg % NXCD, xcd = wgid % NXCD, off = wgid / NXCD; wgid = (xcd < r ? xcd * (q + 1) : r * (q + 1) + (xcd - r) * q) + off; }
    const int nig = WGM * nN, gid = wgid / nig, fm = gid * WGM, gsz = (nM - fm) < WGM ? (nM - fm) : WGM;
    pm = fm + ((wgid % nig) % gsz); pn = (wgid % nig) / gsz; return true;
}
struct DenseOrder {
    const char* A; const char* Bt; int nM, nN, K, G, c;
    __device__ __forceinline__ bool next(int i, Unit& u) const {
        int pm, pn; if (!static_tile(i, G, c, nM, nN, pm, pn)) return false;
        u.pm = pm; u.pn = pn; u.e = 0; u.nvalid = 256; u.A = A + (size_t)pm * 256 * K * 2; u.B = Bt + (size_t)pn * 256 * K * 2; return true;
    }
    __device__ __forceinline__ unsigned row_off(const Unit&, int) const { return 0u; }
};

__device__ __forceinline__ unsigned cvt_pk_bf16(float lo, float hi) { unsigned r; asm volatile("v_cvt_pk_bf16_f32 %0, %1, %2" : "=v"(r) : "v"(lo), "v"(hi)); return r; }

template <class Epi, class Sched, bool ALIGN_EPI, bool GATHER, bool MID>
__device__ __forceinline__ void gemm_phase(LAS unsigned char* lds, const int K, const Sched& S, const Epi& E) {
    int tid_ = threadIdx.x; asm volatile("" : "+v"(tid_));
    const int tid = tid_, wid = __builtin_amdgcn_readfirstlane(tid >> 6), lane = tid & 63, wr = wid >> 2, wc = wid & 3, fr = lane & 15, fq = lane >> 4;
    const int nt = K / BK;
    int Rst[2], Cst[2]; unsigned voffB[2];
#pragma unroll
    for (int i = 0; i < 2; ++i) { int R, C; stage_rc(tid * 16 + i * 8192, R, C); Rst[i] = R; Cst[i] = C; const int Rb = Epi::PERM ? ((R & ~31) + perm32(R & 31)) : R; voffB[i] = (unsigned)(Rb * K + C) * 2u; }
    const size_t kstep = (size_t)(BK * 2);
    const size_t hstep = (size_t)HALF * K * 2;
    const unsigned ldsw = (unsigned)wid * 1024u;
    const int aoff = lds_byte(wr * 64 + fr, fq * 8), boff = lds_byte(wc * 32 + fr, fq * 8);
#define PG8_SA(b, h) (((b) * 2 + (h)) * HTB)
#define PG8_SB(b, h) ((4 + (b) * 2 + (h)) * HTB)
#define PG8_STAGE(bufoff, gbase, voff) do { _Pragma("unroll") for (int _i = 0; _i < 2; ++_i) \
        __builtin_amdgcn_global_load_lds((const unsigned*)((const char*)(gbase) + (voff)[_i]), (LAS unsigned*)(lds + (bufoff) + ldsw + _i * 8192), 16, 0, 0); } while (0)
#define PG8_LDA(dst, b, h) do { _Pragma("unroll") for (int m = 0; m < 4; ++m) _Pragma("unroll") for (int k = 0; k < 2; ++k) dst[m][k] = *(const LAS bf16x8*)(lds + PG8_SA(b, h) + aoff + m * 2048 + k * 1024); } while (0)
#define PG8_LDB(dst, b, h) do { _Pragma("unroll") for (int n = 0; n < 2; ++n) _Pragma("unroll") for (int k = 0; k < 2; ++k) dst[n][k] = *(const LAS bf16x8*)(lds + PG8_SB(b, h) + boff + n * 2048 + k * 1024); } while (0)
#define PG8_MMA(ai, bj, At, Bt) do { __builtin_amdgcn_s_setprio(1); _Pragma("unroll") for (int m = 0; m < 4; ++m) _Pragma("unroll") for (int n = 0; n < 2; ++n) _Pragma("unroll") for (int k = 0; k < 2; ++k) \
        acc[ai][bj][m][n] = __builtin_amdgcn_mfma_f32_16x16x32_bf16(Bt[n][k], At[m][k], acc[ai][bj][m][n], 0, 0, 0); __builtin_amdgcn_s_setprio(0); } while (0)
#define PG8_WAIT_V(n) asm volatile("s_waitcnt vmcnt(" #n ")" ::: "memory")
#define PG8_WAIT_L(n) asm volatile("s_waitcnt lgkmcnt(" #n ")" ::: "memory")
#define PG8_BAR __builtin_amdgcn_s_barrier()
#define PG8_SCHED __builtin_amdgcn_sched_barrier(0)
#define PG8_AOFFS(dst, u) do { _Pragma("unroll") for (int _h = 0; _h < 2; ++_h) _Pragma("unroll") for (int _i = 0; _i < 2; ++_i) { \
        if constexpr (GATHER) dst[_h][_i] = S.row_off(u, _h * HALF + Rst[_i]) + (unsigned)Cst[_i] * 2u; \
        else dst[_h][_i] = (unsigned)((_h * HALF + Rst[_i]) * K + Cst[_i]) * 2u; } \
        if constexpr (GATHER) { asm volatile("" : "+v"(dst[0][0]), "+v"(dst[0][1]), "+v"(dst[1][0]), "+v"(dst[1][1]) :: "memory"); } } while (0)
    Unit cur, nxt; int ui = 0;
    if (!S.next(0, cur)) return;
    bool has_next = S.next(1, nxt);
    unsigned vA[2][2], vN[2][2];
    PG8_AOFFS(vA, cur);
    if constexpr (GATHER) { if (has_next) { PG8_AOFFS(vN, nxt); } else {
#pragma unroll
        for (int h = 0; h < 2; ++h) { vN[h][0] = vA[h][0]; vN[h][1] = vA[h][1]; } } }
    f32x4 acc[2][2][4][2];
#pragma unroll
    for (int a = 0; a < 2; ++a)
#pragma unroll
        for (int b = 0; b < 2; ++b)
#pragma unroll
            for (int m = 0; m < 4; ++m)
#pragma unroll
                for (int n = 0; n < 2; ++n) acc[a][b][m][n] = (f32x4){0.f, 0.f, 0.f, 0.f};
    bf16x8 At[4][2], B0[2][2], B1[2][2];
    const char* cA = cur.A; const char* cB = cur.B;
    PG8_STAGE(PG8_SB(0, 0), cB, voffB); PG8_STAGE(PG8_SB(0, 1), cB + hstep, voffB); PG8_STAGE(PG8_SA(0, 0), cA, vA[0]); PG8_STAGE(PG8_SA(0, 1), cA, vA[1]);
    if (wr == 1) PG8_BAR;
    PG8_WAIT_V(2); PG8_BAR;
    PG8_STAGE(PG8_SB(1, 0), cB + kstep, voffB); PG8_STAGE(PG8_SA(1, 0), cA + kstep, vA[0]); PG8_STAGE(PG8_SB(1, 1), cB + hstep + kstep, voffB);
    PG8_WAIT_V(6); PG8_BAR;
    for (;;) {
        const char* nA = has_next ? nxt.A : cA; const char* nB = has_next ? nxt.B : cB;
#pragma unroll 1
        for (int t = 0; t < nt; t += 2) {
            const bool last = (t == nt - 2);
            if constexpr (MID) { if (t == nt / 2) { int frE = fr, fqE = fq; asm volatile("" : "+v"(frE), "+v"(fqE)); E.mid(acc, cur, wr, wc, frE, fqE); } }
            const char* a1 = cA + (size_t)(t + 1) * kstep;
            const char* a2 = last ? nA : cA + (size_t)(t + 2) * kstep; const char* b2 = last ? nB : cB + (size_t)(t + 2) * kstep;
            const char* a3 = a2 + kstep; const char* b3 = b2 + kstep;
            unsigned v2[2][2];
#pragma unroll
            for (int h = 0; h < 2; ++h) { if constexpr (GATHER) { v2[h][0] = last ? vN[h][0] : vA[h][0]; v2[h][1] = last ? vN[h][1] : vA[h][1]; } else { v2[h][0] = vA[h][0]; v2[h][1] = vA[h][1]; } }
            PG8_LDB(B0, 0, 0); PG8_LDB(B1, 0, 1); PG8_SCHED; PG8_LDA(At, 0, 0); PG8_STAGE(PG8_SA(1, 1), a1, vA[1]);
            PG8_WAIT_V(8); PG8_WAIT_L(0); PG8_BAR; PG8_MMA(0, 0, At, B0); PG8_MMA(0, 1, At, B1); PG8_BAR; PG8_SCHED;
            PG8_LDA(At, 0, 1); PG8_STAGE(PG8_SB(0, 0), b2, voffB); PG8_STAGE(PG8_SB(0, 1), b2 + hstep, voffB); PG8_STAGE(PG8_SA(0, 0), a2, v2[0]);
            PG8_WAIT_V(8); PG8_WAIT_L(0); PG8_BAR; PG8_MMA(1, 0, At, B0); PG8_MMA(1, 1, At, B1); PG8_BAR; PG8_SCHED;
            PG8_LDB(B0, 1, 0); PG8_LDB(B1, 1, 1); PG8_SCHED; PG8_LDA(At, 1, 0); PG8_STAGE(PG8_SA(0, 1), a2, v2[1]);
            PG8_WAIT_V(8); PG8_WAIT_L(0); PG8_BAR; PG8_MMA(0, 0, At, B0); PG8_MMA(0, 1, At, B1); PG8_BAR; PG8_SCHED;
            PG8_LDA(At, 1, 1); PG8_STAGE(PG8_SB(1, 0), b3, voffB); PG8_STAGE(PG8_SB(1, 1), b3 + hstep, voffB); PG8_STAGE(PG8_SA(1, 0), a3, v2[0]);
            PG8_WAIT_V(8); PG8_WAIT_L(0); PG8_BAR; PG8_MMA(1, 0, At, B0); PG8_MMA(1, 1, At, B1); PG8_BAR; PG8_SCHED;
        }
        if constexpr (ALIGN_EPI) { if (wr == 0) PG8_BAR; }
        { int frE = fr, fqE = fq; asm volatile("" : "+v"(frE), "+v"(fqE));
          E(acc, cur, wr, wc, frE, fqE); }
        if (!has_next) break;
#pragma unroll
        for (int a = 0; a < 2; ++a)
#pragma unroll
            for (int b = 0; b < 2; ++b)
#pragma unroll
                for (int m = 0; m < 4; ++m)
#pragma unroll
                    for (int n = 0; n < 2; ++n) acc[a][b][m][n] = (f32x4){0.f, 0.f, 0.f, 0.f};
        cur = nxt; cA = nA; cB = nB; ++ui;
        if constexpr (GATHER) {
#pragma unroll
            for (int h = 0; h < 2; ++h) { vA[h][0] = vN[h][0]; vA[h][1] = vN[h][1]; } }
        has_next = S.next(ui + 1, nxt);
        if constexpr (GATHER) { if (has_next) { PG8_AOFFS(vN, nxt); } }
        if constexpr (ALIGN_EPI) { if (wr == 1) PG8_BAR; }
    }
    PG8_WAIT_V(0);
    if constexpr (!ALIGN_EPI) { if (wr == 0) PG8_BAR; }
    PG8_BAR;
#undef PG8_SA
#undef PG8_SB
#undef PG8_STAGE
#undef PG8_LDA
#undef PG8_LDB
#undef PG8_MMA
#undef PG8_WAIT_V
#undef PG8_WAIT_L
#undef PG8_BAR
#undef PG8_SCHED
#undef PG8_AOFFS
}
}

struct Args { const float* in[25]; float* out; unsigned char* ws; int ph_lo, ph_hi, li, pad; };
struct Frame {
    LAS unsigned char* lds; unsigned char* ws; GAS unsigned* ctl;
    int tid, lane, wave, vcu, G;
    float* out; const __attribute__((address_space(4))) char* ka;
};
#define FIN(i) (((const float* const __attribute__((address_space(4)))*)F.ka)[i])
enum { I_X = 0, I_P, I_RELB, I_ATTN_NORM, I_W_IN, I_SWA_QN, I_SWA_KN, I_SINKS, I_MOBA_QN, I_MOBA_KN, I_SWA_ON, I_MOBA_ON, I_W_OUT, I_FFN_NORM,
       I_W_RG, I_B_RG, I_W_RE, I_B_RE, I_W_EG, I_W_EU, I_W_ED, I_PLE_NORM, I_W_PG, I_W_PP, I_PLE_ON };

struct TrItem { const float* src; bf16_t* dst; const float* gk; int N, K; };
__device__ __forceinline__ int map_in(int n0) { const int head = n0 >> 6, d = n0 & 63; return 256 * (head >> 2) + 128 * (d >> 5) + 32 * (head & 3) + (d & 31); }
__device__ __forceinline__ int map_gu(int n0, int up) { return 256 * (n0 >> 7) + 128 * up + (n0 & 127); }
constexpr int TI_IN = (DM / 64) * (INW / 32), TI_OUT = (DM / 64) * (DM / 32), TI_PG = TI_OUT, TI_PP = (PLE / 64) * (DM / 32);
constexpr int TI_G1 = (DM / 64) * (DEXP / 32), TI_D1 = (DEXP / 64) * (DM / 32);
constexpr int TI_TOTAL = TI_IN + TI_OUT + TI_PG + TI_PP + NEXP * (2 * TI_G1);
constexpr int TI_DOWN_BASE = 1 << 20, TI_DOWN = NEXP * TI_D1;
__device__ __forceinline__ void tr_decode(const Frame& F, int it, TrItem& d) {
    unsigned char* ws = F.ws;
    const float* W; bf16_t* WT; const float* g = nullptr; int K, N, mode = 0, up = 0; int r = it;
    if (it >= TI_DOWN_BASE) r = 1 << 28;
    if (r < TI_IN) { W = FIN(I_W_IN); WT = (bf16_t*)(ws + WS_WIN); K = DM; N = INW; g = FIN(I_ATTN_NORM); mode = 1; }
    else if ((r -= TI_IN) < TI_OUT) { W = FIN(I_W_OUT); WT = (bf16_t*)(ws + WS_WOUT); K = DM; N = DM; mode = 3; }
    else if ((r -= TI_OUT) < TI_PG) { W = FIN(I_W_PG); WT = (bf16_t*)(ws + WS_WPG); K = DM; N = DM; g = FIN(I_PLE_NORM); }
    else if ((r -= TI_PG) < TI_PP) { W = FIN(I_W_PP); WT = (bf16_t*)(ws + WS_WPP); K = PLE; N = DM; }
    else if (it >= TI_DOWN_BASE) { r = it - TI_DOWN_BASE; const int e = r / TI_D1; r -= e * TI_D1; W = FIN(I_W_ED) + (size_t)e * DEXP * DM; WT = (bf16_t*)(ws + WS_WD) + (size_t)e * DM * DEXP; K = DEXP; N = DM; }
    else { r -= TI_PP; const int e = r / (2 * TI_G1); r -= e * (2 * TI_G1);
        if (r < TI_G1) { W = FIN(I_W_EG) + (size_t)e * DM * DEXP; WT = (bf16_t*)(ws + WS_WGU) + (size_t)e * DM * DM; K = DM; N = DEXP; g = FIN(I_FFN_NORM); mode = 2; up = 0; }
        else { r -= TI_G1; W = FIN(I_W_EU) + (size_t)e * DM * DEXP; WT = (bf16_t*)(ws + WS_WGU) + (size_t)e * DM * DM; K = DM; N = DEXP; g = FIN(I_FFN_NORM); mode = 2; up = 1; } }
    const int nblk = N / 32, kb = r / nblk, nb = r % nblk, k0 = 64 * kb, n0 = 32 * nb;
    if (mode == 3) g = (k0 < 512) ? FIN(I_SWA_ON) : (FIN(I_MOBA_ON) - 512);
    const int drow0 = mode == 1 ? map_in(n0) : mode == 2 ? map_gu(n0, up) : n0;
    d.src = W + (size_t)k0 * N + n0; d.dst = WT + (size_t)drow0 * K + k0; d.gk = g ? g + k0 : nullptr; d.N = N; d.K = K;
}
__device__ __forceinline__ void tr_load(const TrItem& d, int lane, float (&v)[32], f32x4 (&gv)[2]) {
    const float* p = d.src + (size_t)(lane >> 5) * d.N + (lane & 31);
#pragma unroll
    for (int i = 0; i < 32; ++i) v[i] = __builtin_nontemporal_load(p + (size_t)(2 * i) * d.N);
    const int c = lane & 7;
    if (d.gk) { gv[0] = *(const f32x4*)(d.gk + 8 * c); gv[1] = *(const f32x4*)(d.gk + 8 * c + 4); } else { gv[0] = (f32x4){1.f, 1.f, 1.f, 1.f}; gv[1] = gv[0]; }
}
__device__ __forceinline__ void tr_process(const TrItem& d, int lane, const float (&v)[32], const f32x4 (&gv)[2], LAS float* scr) {
#pragma unroll
    for (int i = 0; i < 32; ++i) scr[(2 * i + (lane >> 5)) * 33 + (lane & 31)] = v[i];
    LDS_WAIT(); asm volatile("" ::: "memory");
    const int c = lane & 7;
#pragma unroll
    for (int j = 0; j < 4; ++j) { const int n = (lane >> 3) + 8 * j; const LAS float* sp = scr + (8 * c) * 33 + n;
        u32x4 o; o.x = pk2(sp[0 * 33] * gv[0][0], sp[1 * 33] * gv[0][1]); o.y = pk2(sp[2 * 33] * gv[0][2], sp[3 * 33] * gv[0][3]); o.z = pk2(sp[4 * 33] * gv[1][0], sp[5 * 33] * gv[1][1]); o.w = pk2(sp[6 * 33] * gv[1][2], sp[7 * 33] * gv[1][3]);
        *(GAS u32x4*)(d.dst + (size_t)n * d.K + 8 * c) = o; }
    LDS_WAIT(); asm volatile("" ::: "memory");
}

__constant__ unsigned char c_bucket[128] = {0,1,2,3,4,5,6,7,8,9,10,11,12,13,14,15,16,16,16,17,17,18,18,18,19,19,19,20,20,20,20,21,21,21,21,22,22,22,22,22,23,23,23,23,23,23,24,24,24,24,24,24,25,25,25,25,25,25,25,26,26,26,26,26,26,26,26,27,27,27,27,27,27,27,27,27,27,28,28,28,28,28,28,28,28,28,28,29,29,29,29,29,29,29,29,29,29,29,29,30,30,30,30,30,30,30,30,30,30,30,30,30,30,31,31,31,31,31,31,31,31,31,31,31,31,31,31,31};

__device__ __forceinline__ void tr_stream(Frame& F, LAS float* scr, int first, int step, int count, int base) {
    TrItem cur, nxt; float v[32], vn[32]; f32x4 gv[2], gn[2];
    int it = first; bool have = it < count;
    if (have) { tr_decode(F, base + it, cur); tr_load(cur, F.lane, v, gv); }
    while (have) {
        const int itn = it + step; const bool hn = itn < count;
        if (hn) { tr_decode(F, base + itn, nxt); tr_load(nxt, F.lane, vn, gn); }
        tr_process(cur, F.lane, v, gv, scr);
        cur = nxt; gv[0] = gn[0]; gv[1] = gn[1];
#pragma unroll
        for (int i = 0; i < 32; ++i) v[i] = vn[i];
        it = itn; have = hn;
    }
}
__device__ __forceinline__ void p0_prologue(Frame& F) {
    LAS float* scr = (LAS float*)(F.lds + F.wave * 16384);
    const int gw = F.vcu * NWAVES + F.wave, NGW = F.G * NWAVES;
    tr_stream(F, scr, gw, NGW, TI_TOTAL, 0);
    const float* x = FIN(I_X); bf16_t* xb = (bf16_t*)(F.ws + WS_XB); float* rs1 = (float*)(F.ws + WS_RS1);
    for (int m = gw; m < T; m += 2 * NGW) {
        const int m2 = m + NGW; const bool h2 = m2 < T;
        const GAS f32x4* xr = (const GAS f32x4*)(x + (size_t)m * DM) + F.lane; const GAS f32x4* xr2 = (const GAS f32x4*)(x + (size_t)(h2 ? m2 : m) * DM) + F.lane;
        f32x4 v[4], u[4]; float s = 0.f, s2 = 0.f;
#pragma unroll
        for (int j = 0; j < 4; ++j) { v[j] = xr[64 * j]; u[j] = xr2[64 * j]; }
#pragma unroll
        for (int j = 0; j < 4; ++j) { s += (v[j].x * v[j].x + v[j].y * v[j].y) + (v[j].z * v[j].z + v[j].w * v[j].w); s2 += (u[j].x * u[j].x + u[j].y * u[j].y) + (u[j].z * u[j].z + u[j].w * u[j].w); }
        s = wave_sum(s); s2 = wave_sum(s2);
        GAS u32x2* o8 = (GAS u32x2*)(xb + (size_t)m * DM) + F.lane;
#pragma unroll
        for (int j = 0; j < 4; ++j) { u32x2 w; w.x = pk2(v[j].x, v[j].y); w.y = pk2(v[j].z, v[j].w); o8[64 * j] = w; }
        if (F.lane == 0) rs1[m] = 1.0f / sqrtf(s * (1.0f / DM) + EPS);
        if (h2) { GAS u32x2* o9 = (GAS u32x2*)(xb + (size_t)m2 * DM) + F.lane;
#pragma unroll
            for (int j = 0; j < 4; ++j) { u32x2 w; w.x = pk2(u[j].x, u[j].y); w.y = pk2(u[j].z, u[j].w); o9[64 * j] = w; }
            if (F.lane == 0) rs1[m2] = 1.0f / sqrtf(s2 * (1.0f / DM) + EPS); }
    }
    { const GAS f32x4* p4 = (const GAS f32x4*)FIN(I_P); GAS u32x2* o = (GAS u32x2*)(F.ws + WS_PB); const int n4 = T * PLE / 4;
      for (int i = (F.vcu * NTHREADS + F.tid); i < n4; i += F.G * NTHREADS) { const f32x4 v = p4[i]; u32x2 w; w.x = pk2(v.x, v.y); w.y = pk2(v.z, v.w); o[i] = w; } }
    { bf16_t* Wt = (bf16_t*)(F.ws + WS_WR); const float* g = FIN(I_FFN_NORM); const float* wrg = FIN(I_W_RG); const float* wre = FIN(I_W_RE);
      for (int i = (F.vcu * NTHREADS + F.tid); i < 96 * DM; i += F.G * NTHREADS) { const int n = i / DM, c = i % DM; int o = -1; bool lo = false;
          if (n < 32) o = n; else if (n < 64) { o = n - 32; lo = true; } else if (n < 68) o = 32 + (n - 64); else if (n < 72) { o = 32 + (n - 68); lo = true; }
          unsigned short r = 0;
          if (o >= 0) { const float w = g[c] * ((o < 4) ? wrg[c * 4 + o] : wre[c * 32 + (o - 4)]); const unsigned h = f2bf(w); r = (unsigned short)h;
              if (lo) r = (unsigned short)f2bf(w - bf2f((unsigned short)h)); }
          Wt[i] = r; } }
    { float* tab = (float*)(F.ws + WS_BIAS);
      for (int i = (F.vcu * NTHREADS + F.tid); i < 16 * 132; i += F.G * NTHREADS) { const int hh = i / 132, dd = i % 132; const int bk = dd < 128 ? (int)c_bucket[dd] : 31;
          tab[i] = FIN(I_RELB)[bk * NHQ + hh] * LOG2E; }
    { float* lg = (float*)(F.ws + WS_BIAS + 16 * KiB); const float* rb = FIN(I_RELB);
      for (int i = (F.vcu * NTHREADS + F.tid); i < 16 * 640; i += F.G * NTHREADS) { const int hh = i / 640, e = i % 640, dist = 383 - e; float v;
          if (dist < 0 || e >= 639) v = -1e30f; else if (dist < 128) v = (rb[(int)c_bucket[dist] * NHQ + hh] - (hh >= 8 ? rb[31 * NHQ + hh] : 0.f)) * LOG2E; else v = hh >= 8 ? 0.f : -1e30f;
          lg[i] = v; } }
}
}

using pg8::Unit;
struct EpiQKV {
    static constexpr bool PERM = true;
    bf16_t* qkv; const float* rs1; const float* gq_a; const float* gk_a; const float* gq_b; const float* gk_b; float* kmp;
    __device__ __forceinline__ void operator()(const f32x4 (&acc)[2][2][4][2], const Unit& u, int wr, int wc, int fr, int fq) const {
        const int head = 4 * u.pn + wc;
        const float* gain = nullptr; float qs = 1.f; bool kmean = false;
        if (head < 8) { gain = gq_a; qs = QSCALE; } else if (head < 10) { gain = gk_a; } else if (head < 12) {} else if (head < 20) { gain = gq_b; qs = QSCALE; } else if (head < 22) { gain = gk_b; kmean = true; }
        f32x4 gv[2][2];
#pragma unroll
        for (int bj = 0; bj < 2; ++bj)
#pragma unroll
            for (int n = 0; n < 2; ++n) { if (gain) { gv[bj][n] = *(const f32x4*)(gain + 32 * bj + 8 * fq + 4 * n) * qs; } else gv[bj][n] = (f32x4){1.f, 1.f, 1.f, 1.f}; }
        f32x4 ks[2][2];
#pragma unroll
        for (int bj = 0; bj < 2; ++bj)
#pragma unroll
            for (int n = 0; n < 2; ++n) ks[bj][n] = (f32x4){0.f, 0.f, 0.f, 0.f};
        float rsv[2][4];
#pragma unroll
        for (int ai = 0; ai < 2; ++ai)
#pragma unroll
            for (int m = 0; m < 4; ++m) rsv[ai][m] = rs1[u.pm * 256 + ai * 128 + wr * 64 + m * 16 + fr];
        asm volatile("" ::: "memory");
#pragma unroll
        for (int ai = 0; ai < 2; ++ai)
#pragma unroll
            for (int m = 0; m < 4; ++m) {
                const int row = u.pm * 256 + ai * 128 + wr * 64 + m * 16 + fr; const float rs = rsv[ai][m];
                f32x4 v[2][2]; float ss = 0.f;
#pragma unroll
                for (int bj = 0; bj < 2; ++bj)
#pragma unroll
                    for (int n = 0; n < 2; ++n) { v[bj][n] = acc[ai][bj][m][n] * rs; const f32x4 q = v[bj][n] * v[bj][n]; ss += (q[0] + q[1]) + (q[2] + q[3]); }
                float rn = 1.f;
                if (gain) { ss += __shfl_xor(ss, 16); ss += __shfl_xor(ss, 32); rn = 1.0f / sqrtf(ss * (1.0f / HD) + EPS); }
                bf16_t* rowp = qkv + (size_t)row * INW + 64 * head + 8 * fq;
#pragma unroll
                for (int bj = 0; bj < 2; ++bj) { const f32x4 v0 = v[bj][0] * rn * gv[bj][0], v1 = v[bj][1] * rn * gv[bj][1];
                    if (kmean) { ks[bj][0] += v0; ks[bj][1] += v1; }
                    u32x4 w; w.x = pg8::cvt_pk_bf16(v0[0], v0[1]); w.y = pg8::cvt_pk_bf16(v0[2], v0[3]); w.z = pg8::cvt_pk_bf16(v1[0], v1[1]); w.w = pg8::cvt_pk_bf16(v1[2], v1[3]);
                    *(u32x4*)(rowp + 32 * bj) = w; }
            }
        if (kmean) {
#pragma unroll
            for (int bj = 0; bj < 2; ++bj)
#pragma unroll
                for (int n = 0; n < 2; ++n)
#pragma unroll
                    for (int i = 0; i < 4; ++i) { float s = ks[bj][n][i]; s += __shfl_xor(s, 1); s += __shfl_xor(s, 2); s += __shfl_xor(s, 4); s += __shfl_xor(s, 8);
                        if (fr == 0) kmp[((u.pm * 2 + wr) * 2 + (head - 20)) * 64 + 32 * bj + 8 * fq + 4 * n + i] = s; }
        }
    }
};
struct EpiProj {
    static constexpr bool PERM = true;
    bf16_t* praw; float* ssqp;
    __device__ __forceinline__ void operator()(const f32x4 (&acc)[2][2][4][2], const Unit& u, int wr, int wc, int fr, int fq) const {
#pragma unroll
        for (int ai = 0; ai < 2; ++ai)
#pragma unroll
            for (int m = 0; m < 4; ++m) {
                const int row = u.pm * 256 + ai * 128 + wr * 64 + m * 16 + fr; float ss = 0.f;
                bf16_t* rowp = praw + (size_t)row * DM + u.pn * 256 + wc * 32 + 8 * fq;
#pragma unroll
                for (int bj = 0; bj < 2; ++bj) { const f32x4 v0 = acc[ai][bj][m][0], v1 = acc[ai][bj][m][1];
                    const f32x4 q = v0 * v0 + v1 * v1; ss += (q[0] + q[1]) + (q[2] + q[3]);
                    u32x4 w; w.x = pg8::cvt_pk_bf16(v0[0], v0[1]); w.y = pg8::cvt_pk_bf16(v0[2], v0[3]); w.z = pg8::cvt_pk_bf16(v1[0], v1[1]); w.w = pg8::cvt_pk_bf16(v1[2], v1[3]);
                    *(u32x4*)(rowp + 128 * bj) = w; }
                ss += __shfl_xor(ss, 16); ss += __shfl_xor(ss, 32);
                if (fq == 0) ssqp[(size_t)row * 16 + u.pn * 4 + wc] = ss;
            }
    }
};
struct EpiOut {
    static constexpr bool PERM = true;
    bf16_t* x1b; const LAS f32x2* tab;
    __device__ __forceinline__ void mid(f32x4 (&acc)[2][2][4][2], const Unit& u, int wr, int wc, int fr, int fq) const {
#pragma unroll
        for (int ai = 0; ai < 2; ++ai)
#pragma unroll
            for (int m = 0; m < 4; ++m) { const f32x2 sc = tab[ai * 128 + wr * 64 + m * 16 + fr]; const float r = sc.x / sc.y;
#pragma unroll
                for (int bj = 0; bj < 2; ++bj)
#pragma unroll
                    for (int n = 0; n < 2; ++n) acc[ai][bj][m][n] *= r; }
    }
    __device__ __forceinline__ void operator()(const f32x4 (&acc)[2][2][4][2], const Unit& u, int wr, int wc, int fr, int fq) const {
        const int col0 = u.pn * 256 + wc * 32 + 8 * fq;
#pragma unroll
        for (int ai = 0; ai < 2; ++ai) {
            u32x4 xv[4][2];
#pragma unroll
            for (int m = 0; m < 4; ++m) { const size_t off = (size_t)(u.pm * 256 + ai * 128 + wr * 64 + m * 16 + fr) * DM + col0;
#pragma unroll
                for (int bj = 0; bj < 2; ++bj) xv[m][bj] = *(const u32x4*)(x1b + off + bj * 128); }
            asm volatile("" ::: "memory");
#pragma unroll
            for (int m = 0; m < 4; ++m) { const int r = ai * 128 + wr * 64 + m * 16 + fr; const float sb = tab[r].y; const size_t off = (size_t)(u.pm * 256 + r) * DM + col0;
#pragma unroll
                for (int bj = 0; bj < 2; ++bj) { const u32x4 xw = xv[m][bj];
                    const f32x4 o0 = (f32x4){bflo(xw.x), bfhi(xw.x), bflo(xw.y), bfhi(xw.y)} + acc[ai][bj][m][0] * sb, o1 = (f32x4){bflo(xw.z), bfhi(xw.z), bflo(xw.w), bfhi(xw.w)} + acc[ai][bj][m][1] * sb;
                    u32x4 w; w.x = pg8::cvt_pk_bf16(o0[0], o0[1]); w.y = pg8::cvt_pk_bf16(o0[2], o0[3]); w.z = pg8::cvt_pk_bf16(o1[0], o1[1]); w.w = pg8::cvt_pk_bf16(o1[2], o1[3]);
                    *(u32x4*)(x1b + off + bj * 128) = w; } }
            asm volatile("" ::: "memory");
        }
    }
};
struct MoeOrder {
    const char* A; const char* Bt; const LAS int* tb; const unsigned* cnt; const unsigned* list; int K; size_t wstride; size_t arow_bytes; int G, c; bool gather;
    __device__ __forceinline__ bool next(int i, Unit& u) const {
        const int NT = tb[NEXP]; const int nwg = NT * 4; const long L = (long)i * G + c; if (L >= nwg) return false;
        int wgid = (int)L; { const int q = nwg / 8, r = nwg % 8, xcd = wgid % 8, off = wgid / 8; wgid = (xcd < r ? xcd * (q + 1) : r * (q + 1) + (xcd - r) * q) + off; }
        const int gt = wgid >> 2, pn = wgid & 3; int e = 0;
#pragma unroll 1
        while (e < NEXP - 1 && gt >= tb[e + 1]) ++e;
        const int lt = gt - tb[e]; const int nv = (int)cnt[e] - lt * 256;
        u.pm = gt; u.pn = pn; u.e = e * 16384 + lt * 256; u.nvalid = nv < 256 ? nv : 256;
        u.A = gather ? A : A + (size_t)gt * 256 * arow_bytes; u.B = Bt + (size_t)e * wstride + (size_t)pn * 256 * K * 2; return true;
    }
    __device__ __forceinline__ unsigned row_off(const Unit& u, int r) const {
        const unsigned ent = (r < u.nvalid) ? list[u.e + r] : 0u; return (ent >> 1) * (unsigned)arow_bytes;
    }
};
struct EpiG1 {
    static constexpr bool PERM = true;
    bf16_t* H; const float* r2; const unsigned* list;
    __device__ __forceinline__ void operator()(const f32x4 (&acc)[2][2][4][2], const Unit& u, int wr, int wc, int fr, int fq) const {
        unsigned entv[2][4]; float rsv[2][4];
#pragma unroll
        for (int ai = 0; ai < 2; ++ai)
#pragma unroll
            for (int m = 0; m < 4; ++m) { const int r = ai * 128 + wr * 64 + m * 16 + fr; entv[ai][m] = (r < u.nvalid) ? list[u.e + r] : 0u; }
#pragma unroll
        for (int ai = 0; ai < 2; ++ai)
#pragma unroll
            for (int m = 0; m < 4; ++m) rsv[ai][m] = r2[entv[ai][m] >> 1];
        asm volatile("" ::: "memory");
#pragma unroll
        for (int ai = 0; ai < 2; ++ai)
#pragma unroll
            for (int m = 0; m < 4; ++m) { const int r = ai * 128 + wr * 64 + m * 16 + fr; const float rs = rsv[ai][m];
                float h[8];
#pragma unroll
                for (int n = 0; n < 2; ++n)
#pragma unroll
                    for (int i = 0; i < 4; ++i) { const float g = acc[ai][0][m][n][i] * rs, up = acc[ai][1][m][n][i] * rs; h[4 * n + i] = g / (1.0f + __builtin_amdgcn_exp2f(-g * LOG2E)) * up; }
                u32x4 w; w.x = pg8::cvt_pk_bf16(h[0], h[1]); w.y = pg8::cvt_pk_bf16(h[2], h[3]); w.z = pg8::cvt_pk_bf16(h[4], h[5]); w.w = pg8::cvt_pk_bf16(h[6], h[7]);
                *(u32x4*)(H + (size_t)(u.pm * 256 + r) * DEXP + u.pn * 128 + wc * 32 + 8 * fq) = w; }
    }
};
struct EpiG2 {
    static constexpr bool PERM = true;
    bf16_t* Y; const unsigned* list;
    __device__ __forceinline__ void operator()(const f32x4 (&acc)[2][2][4][2], const Unit& u, int wr, int wc, int fr, int fq) const {
        unsigned entv[2][4];
#pragma unroll
        for (int ai = 0; ai < 2; ++ai)
#pragma unroll
            for (int m = 0; m < 4; ++m) { const int r = ai * 128 + wr * 64 + m * 16 + fr; entv[ai][m] = (r < u.nvalid) ? list[u.e + r] : 0u; }
        asm volatile("" ::: "memory");
#pragma unroll
        for (int ai = 0; ai < 2; ++ai)
#pragma unroll
            for (int m = 0; m < 4; ++m) { const int r = ai * 128 + wr * 64 + m * 16 + fr;
                if (r < u.nvalid) { const unsigned ent = entv[ai][m]; bf16_t* rowp = Y + (size_t)ent * DM + u.pn * 256 + wc * 32 + 8 * fq;
#pragma unroll
                    for (int bj = 0; bj < 2; ++bj) { const f32x4 v0 = acc[ai][bj][m][0], v1 = acc[ai][bj][m][1];
                        u32x4 w; w.x = pg8::cvt_pk_bf16(v0[0], v0[1]); w.y = pg8::cvt_pk_bf16(v0[2], v0[3]); w.z = pg8::cvt_pk_bf16(v1[0], v1[1]); w.w = pg8::cvt_pk_bf16(v1[2], v1[3]);
                        *(u32x4*)(rowp + 128 * bj) = w; } } }
    }
};
struct EpiFinal {
    static constexpr bool PERM = false;
    float* out; const bf16_t* x2b; const bf16_t* praw; const float* gout; const LAS f32x2* tab;
    __device__ __forceinline__ void operator()(const f32x4 (&acc)[2][2][4][2], const Unit& u, int wr, int wc, int fr, int fq) const {
        const int col0 = u.pn * 256 + wc * 32 + 4 * fq;
        f32x4 gv[2][2];
#pragma unroll
        for (int bj = 0; bj < 2; ++bj)
#pragma unroll
            for (int n = 0; n < 2; ++n) gv[bj][n] = *(const f32x4*)(gout + col0 + bj * 128 + n * 16);
#pragma unroll
        for (int am = 0; am < 4; ++am) { const int ai = am >> 1, mb = 2 * (am & 1);
            u32x2 xw[2][2][2], pw[2][2][2];
#pragma unroll
            for (int mm = 0; mm < 2; ++mm) { const size_t off = (size_t)(u.pm * 256 + ai * 128 + wr * 64 + (mb + mm) * 16 + fr) * DM + col0;
#pragma unroll
                for (int bj = 0; bj < 2; ++bj)
#pragma unroll
                    for (int n = 0; n < 2; ++n) { xw[mm][bj][n] = *(const u32x2*)(x2b + off + bj * 128 + n * 16); pw[mm][bj][n] = *(const u32x2*)(praw + off + bj * 128 + n * 16); } }
            asm volatile("" ::: "memory");
#pragma unroll
            for (int mm = 0; mm < 2; ++mm) { const int m = mb + mm; const int r = ai * 128 + wr * 64 + m * 16 + fr; const f32x2 sc = tab[r]; const size_t off = (size_t)(u.pm * 256 + r) * DM + col0;
#pragma unroll
                for (int bj = 0; bj < 2; ++bj)
#pragma unroll
                    for (int n = 0; n < 2; ++n) { const u32x2 a = xw[mm][bj][n], p = pw[mm][bj][n];
                        const f32x4 xv = (f32x4){bflo(a.x), bfhi(a.x), bflo(a.y), bfhi(a.y)}, pv = (f32x4){bflo(p.x), bfhi(p.x), bflo(p.y), bfhi(p.y)}; f32x4 o;
#pragma unroll
                        for (int i = 0; i < 4; ++i) { const float z = acc[ai][bj][m][n][i] * sc.x; const float sg = 1.0f / (1.0f + __builtin_amdgcn_exp2f(-z * LOG2E)); o[i] = xv[i] + sg * (pv[i] * sc.y * gv[bj][n][i]); }
                        *(f32x4*)(out + off + bj * 128 + n * 16) = o; }
                asm volatile("" ::: "memory"); }
        }
    }
};

namespace att {
typedef float f32x16 __attribute__((ext_vector_type(16)));
typedef short s16x4 __attribute__((ext_vector_type(4)));
constexpr int NSLOT = 6, KBUF = 0, VBUF = NSLOT * 8192, LUT_OFF = 2 * NSLOT * 8192, KM_OFF = LUT_OFF + 2048;
constexpr float NEGBIG = -1e30f, MFLOOR = -1e20f;
__device__ __forceinline__ s16x4 vtr(const LAS unsigned char* p) { return __builtin_bit_cast(s16x4, __builtin_amdgcn_ds_read_tr16_b64_v4i16((LAS s16x4*)p)); }
__device__ __forceinline__ unsigned pkbf(float lo, float hi) { f32x2 v = {lo, hi}; typedef __bf16 bf2 __attribute__((ext_vector_type(2))); bf2 b = __builtin_convertvector(v, bf2); return __builtin_bit_cast(unsigned, b); }

template <int TYPE>
__device__ __forceinline__ void attn_unit(Frame& F, int b, int hlp, int n) {
    const int tid = F.tid, lane = F.lane, w = F.wave, r32 = lane & 31, hi = lane >> 5;
    const int hl = TYPE ? hlp : 2 * hlp + (w >> 2);
    const int hh = TYPE * 8 + hl, g = hl >> 2;
    const int colQ = (TYPE ? C_QB : C_QA) + 64 * hl, colK = (TYPE ? C_KB : C_KA) + 64 * g, colV = (TYPE ? C_VB : C_VA) + 64 * g;
    const bf16_t* qkv = (const bf16_t*)(F.ws + WS_QKV); bf16_t* O = (bf16_t*)(F.ws + WS_O); float* ssq = (float*)(F.ws + WS_SSQ);
    const float* tab = (const float*)(F.ws + WS_BIAS); const float* kmp = (const float*)(F.ws + WS_KMP);
    const size_t rowb = (size_t)b * SEQ;
    LAS unsigned char* L = F.lds; LAS float* lut = (LAS float*)(L + LUT_OFF) + (TYPE ? 0 : 316 * (w >> 2)); LAS float* kml = (LAS float*)(L + KM_OFF);
    const int q0w = TYPE ? 256 * n + 32 * w : 128 * n + 32 * (w & 3);
    const int t_lo = TYPE ? 0 : (2 * n - 2 > 0 ? 2 * n - 2 : 0), t_hi = TYPE ? 4 * n + 3 : 2 * n + 1;
    __syncthreads();
    for (int e = tid; e < (TYPE ? 316 : 632); e += NTHREADS) { const int ti = TYPE ? e : e % 316, hx = TYPE ? hh : 2 * hlp + e / 316; const int dist = 221 - ti; float v;
        if (dist < 0) v = NEGBIG; else if (dist < 128) v = tab[hx * 132 + dist] - (TYPE ? tab[hx * 132 + 128] : 0.f); else v = TYPE ? 0.f : NEGBIG;
        ((LAS float*)(L + LUT_OFF))[e] = v; }
    if (TYPE) { const int nb = tid >> 6, d = tid & 63; float v = 0.f;
        if (nb < n) { const int pm = b * 8 + nb; v = kmp[((pm * 2 + 0) * 2 + g) * 64 + d] + kmp[((pm * 2 + 1) * 2 + g) * 64 + d]; }
        kml[tid] = v; }
    bf16x8 qf[4];
    { const bf16_t* qp = qkv + (rowb + q0w + r32) * INW + colQ + 8 * hi;
#pragma unroll
      for (int d0 = 0; d0 < 4; ++d0) qf[d0] = *(const bf16x8*)(qp + 16 * d0); }
    const int srow = 8 * w + (lane >> 3);
    const bf16_t* kg = qkv + (rowb + srow) * INW + colK + 8 * ((lane & 7) ^ ((srow >> 1) & 7));
    const bf16_t* vg = qkv + (rowb + srow) * INW + colV + 8 * ((lane & 7) ^ (((srow >> 1) & 1) << 2));
    const int ntl = t_hi - t_lo + 1;
#define TILE_OF(i) (TYPE ? ((i) < 4 ? 4 * n + (i) : (i) - 4) : t_lo + (i))
#define STAGE(ti, slot) do { const int ti_ = (ti) < ntl ? (ti) : ntl - 1; const size_t go_ = (size_t)TILE_OF(ti_) * 64 * INW; \
        __builtin_amdgcn_global_load_lds((const unsigned*)(kg + go_), (LAS unsigned*)(L + KBUF + (slot) * 8192 + w * 1024), 16, 0, 0); \
        __builtin_amdgcn_global_load_lds((const unsigned*)(vg + go_), (LAS unsigned*)(L + VBUF + (slot) * 8192 + w * 1024), 16, 0, 0); } while (0)
    STAGE(0, 0); STAGE(1, 1); STAGE(2, 2); STAGE(3, 3);
    asm volatile("s_waitcnt vmcnt(4)" ::: "memory");
    asm volatile("s_waitcnt lgkmcnt(0)" ::: "memory"); __builtin_amdgcn_s_barrier(); asm volatile("" ::: "memory");
    unsigned sel = 0u;
    if (TYPE) {
        float gate[8];
#pragma unroll
        for (int nb = 0; nb < 8; ++nb) gate[nb] = 0.f;
#pragma unroll
        for (int d0 = 0; d0 < 4; ++d0) { float q8[8];
#pragma unroll
            for (int j = 0; j < 8; ++j) q8[j] = bf2f((unsigned short)qf[d0][j]);
#pragma unroll
            for (int nb = 0; nb < 7; ++nb) if (nb < n) { const f32x4 k0 = *(const LAS f32x4*)(kml + nb * 64 + 16 * d0 + 8 * hi), k1 = *(const LAS f32x4*)(kml + nb * 64 + 16 * d0 + 8 * hi + 4);
                gate[nb] += (q8[0] * k0[0] + q8[1] * k0[1]) + (q8[2] * k0[2] + q8[3] * k0[3]) + (q8[4] * k1[0] + q8[5] * k1[1]) + (q8[6] * k1[2] + q8[7] * k1[3]); } }
#pragma unroll
        for (int nb = 0; nb < 7; ++nb) gate[nb] += __shfl_xor(gate[nb], 32);
        const int nsel = n < 3 ? n : 3;
        for (int k = 0; k < nsel; ++k) { float best = -3e38f; int bi = 0;
#pragma unroll
            for (int nb = 0; nb < 7; ++nb) { const bool ok = (nb < n) && !((sel >> nb) & 1u) && (gate[nb] > best); if (ok) { best = gate[nb]; bi = nb; } }
            sel |= 1u << bi; }
    }
    float m = TYPE ? 0.f : FIN(I_SINKS)[hl] * LOG2E, l = (TYPE == 0 && hi == 0) ? 1.f : 0.f;
    f32x16 negm;
#pragma unroll
    for (int r = 0; r < 16; ++r) negm[r] = -m;
    f32x16 o0 = {}, o1 = {};
    const int qpos = q0w + r32;
    const int kroff = r32 * 128;  const int ksw = (r32 >> 1) & 7;
    const int q_ = (lane & 15) >> 2, p_ = lane & 3, sw = (q_ >> 1) & 1, clow = 2 * ((lane >> 4) & 1) + (p_ >> 1);
    const int vrow = (4 * hi + q_) * 128 + (p_ & 1) * 8;
    const int vb0 = vrow + ((4 * (0 ^ sw) + clow) << 4), vb1 = vrow + ((4 * (1 ^ sw) + clow) << 4);
    const int vaddr0 = (int)(unsigned)(unsigned long)(L + VBUF) + vb0, vaddr1 = (int)(unsigned)(unsigned long)(L + VBUF) + vb1;
    constexpr float THR = 8.0f;
#define ATT_STEP(IDX, SLOT) do { const int i = (IDX);         const int kt = TILE_OF(i); const int cur = (SLOT); \
        const int k0 = 64 * kt; const int dmax = q0w + 31 - k0, dmin = q0w - k0 - 63; \
        bool active, near, mine = true; \
        if (TYPE == 0) { active = (dmax >= 0) && (dmin <= 127); near = true; } \
        else if (kt >= 4 * n) { active = dmax >= 0; near = dmin < 128; } \
        else { mine = (sel >> (kt >> 2)) & 1u; active = __ballot(mine) != 0ull; near = dmin < 128; } \
        if (active) { \
            const LAS unsigned char* Kb = L + KBUF + cur * 8192; const LAS unsigned char* Vb = L + VBUF + cur * 8192; \
            f32x16 p0, p1, c = negm; \
            if (TYPE && kt < 4 * n) { \
        _Pragma("unroll") \
                for (int r = 0; r < 16; ++r) c[r] = mine ? negm[r] : NEGBIG; } \
            { const int co = ((0 + hi) ^ ksw) << 4; const bf16x8 ka = *(const LAS bf16x8*)(Kb + kroff + co), kb2 = *(const LAS bf16x8*)(Kb + 4096 + kroff + co); \
              p0 = __builtin_amdgcn_mfma_f32_32x32x16_bf16(ka, qf[0], c, 0, 0, 0); p1 = __builtin_amdgcn_mfma_f32_32x32x16_bf16(kb2, qf[0], c, 0, 0, 0); } \
        _Pragma("unroll") \
            for (int d0 = 1; d0 < 4; ++d0) { const int co = ((2 * d0 + hi) ^ ksw) << 4; \
                const bf16x8 ka = *(const LAS bf16x8*)(Kb + kroff + co), kb2 = *(const LAS bf16x8*)(Kb + 4096 + kroff + co); \
                p0 = __builtin_amdgcn_mfma_f32_32x32x16_bf16(ka, qf[d0], p0, 0, 0, 0); p1 = __builtin_amdgcn_mfma_f32_32x32x16_bf16(kb2, qf[d0], p1, 0, 0, 0); } \
            if (near) { const LAS float* lp = lut + (221 - (qpos - k0 - 4 * hi)); \
        _Pragma("unroll") \
                for (int r = 0; r < 16; ++r) { const int ko = (r & 3) + 8 * (r >> 2); p0[r] += lp[ko]; p1[r] += lp[32 + ko]; } } \
            float mx = __builtin_fmaxf(__builtin_fmaxf(p0[0], p1[0]), p0[1]); \
        _Pragma("unroll") \
            for (int r = 1; r < 16; ++r) mx = (r == 1) ? __builtin_fmaxf(mx, p1[1]) : __builtin_fmaxf(__builtin_fmaxf(mx, p0[r]), p1[r]); \
            mx = __builtin_fmaxf(mx, __shfl_xor(mx, 32)); \
            const bool first = (TYPE == 1) && (i == 0); \
            const float delta = first ? mx : (mx > THR ? mx : 0.f); \
            if (__ballot(delta != 0.f) != 0ull) { \
                m += delta; const float alpha = __builtin_amdgcn_exp2f(-delta); l *= alpha; \
        _Pragma("unroll") \
                for (int r = 0; r < 16; ++r) { o0[r] *= alpha; o1[r] *= alpha; negm[r] = -m; p0[r] -= delta; p1[r] -= delta; } \
            } \
            float ps = 0.f; \
        _Pragma("unroll") \
            for (int r = 0; r < 16; ++r) { p0[r] = __builtin_amdgcn_exp2f(p0[r]); p1[r] = __builtin_amdgcn_exp2f(p1[r]); ps += p0[r] + p1[r]; } \
            l += ps; \
            s16x4 ta[4][2], tc[4][2];                                    \
        _Pragma("unroll") \
            for (int s = 0; s < 4; ++s) { \
                asm volatile("ds_read_b64_tr_b16 %0, %1 offset:%c2" : "=&v"(ta[s][0]) : "v"(vaddr0 + cur * 8192), "i"(s * 2048) : "memory"); \
                asm volatile("ds_read_b64_tr_b16 %0, %1 offset:%c2" : "=&v"(ta[s][1]) : "v"(vaddr0 + cur * 8192), "i"(s * 2048 + 1024) : "memory"); \
                asm volatile("ds_read_b64_tr_b16 %0, %1 offset:%c2" : "=&v"(tc[s][0]) : "v"(vaddr1 + cur * 8192), "i"(s * 2048) : "memory"); \
                asm volatile("ds_read_b64_tr_b16 %0, %1 offset:%c2" : "=&v"(tc[s][1]) : "v"(vaddr1 + cur * 8192), "i"(s * 2048 + 1024) : "memory"); } \
            asm volatile("s_waitcnt lgkmcnt(0)" ::: "memory"); __builtin_amdgcn_sched_barrier(0); \
        _Pragma("unroll") \
            for (int s = 0; s < 4; ++s) { \
                u32x4 pw; \
                if (s < 2) { pw.x = pkbf(p0[8 * s + 0], p0[8 * s + 1]); pw.y = pkbf(p0[8 * s + 2], p0[8 * s + 3]); pw.z = pkbf(p0[8 * s + 4], p0[8 * s + 5]); pw.w = pkbf(p0[8 * s + 6], p0[8 * s + 7]); } \
                else { const int s2 = s - 2; pw.x = pkbf(p1[8 * s2 + 0], p1[8 * s2 + 1]); pw.y = pkbf(p1[8 * s2 + 2], p1[8 * s2 + 3]); pw.z = pkbf(p1[8 * s2 + 4], p1[8 * s2 + 5]); pw.w = pkbf(p1[8 * s2 + 6], p1[8 * s2 + 7]); } \
                const bf16x8 pb = __builtin_bit_cast(bf16x8, pw); \
                const s16x4 a0 = ta[s][0], a1 = ta[s][1], c0 = tc[s][0], c1 = tc[s][1]; \
                const bf16x8 va = (bf16x8){a0[0], a0[1], a0[2], a0[3], a1[0], a1[1], a1[2], a1[3]}, vc = (bf16x8){c0[0], c0[1], c0[2], c0[3], c1[0], c1[1], c1[2], c1[3]}; \
                o0 = __builtin_amdgcn_mfma_f32_32x32x16_bf16(va, pb, o0, 0, 0, 0); o1 = __builtin_amdgcn_mfma_f32_32x32x16_bf16(vc, pb, o1, 0, 0, 0); \
            } \
        } \
    } while (0)
    { int sc = 0;
      for (int i2 = 0; i2 < ntl; i2 += 2) {
          const int s4 = (sc + 4 >= NSLOT) ? sc + 4 - NSLOT : sc + 4, s5 = (sc + 5 >= NSLOT) ? sc + 5 - NSLOT : sc + 5, sn = sc + 1;
          STAGE(i2 + 4, s4); STAGE(i2 + 5, s5);
          ATT_STEP(i2, sc); ATT_STEP(i2 + 1, sn);
          asm volatile("s_waitcnt vmcnt(4)" ::: "memory");
          asm volatile("s_waitcnt lgkmcnt(0)" ::: "memory"); __builtin_amdgcn_s_barrier(); asm volatile("" ::: "memory");
          sc = (sc + 2 >= NSLOT) ? sc + 2 - NSLOT : sc + 2; } }
    asm volatile("s_waitcnt vmcnt(0)" ::: "memory");
#undef ATT_STEP
#undef STAGE
#undef TILE_OF
    l += __shfl_xor(l, 32);
    const float rl = 1.0f / l; float q2 = 0.f;
    const size_t t = rowb + qpos; bf16_t* op = O + t * DM + 64 * hh + 4 * hi;
#pragma unroll
    for (int c4 = 0; c4 < 4; ++c4) {
        const float a0 = o0[4 * c4 + 0] * rl, a1 = o0[4 * c4 + 1] * rl, a2 = o0[4 * c4 + 2] * rl, a3 = o0[4 * c4 + 3] * rl;
        const float b0 = o1[4 * c4 + 0] * rl, b1 = o1[4 * c4 + 1] * rl, b2 = o1[4 * c4 + 2] * rl, b3 = o1[4 * c4 + 3] * rl;
        q2 += (a0 * a0 + a1 * a1) + (a2 * a2 + a3 * a3) + (b0 * b0 + b1 * b1) + (b2 * b2 + b3 * b3);
        u32x2 wa; wa.x = pkbf(a0, a1); wa.y = pkbf(a2, a3); *(u32x2*)(op + 8 * c4) = wa;
        u32x2 wb; wb.x = pkbf(b0, b1); wb.y = pkbf(b2, b3); *(u32x2*)(op + 32 + 8 * c4) = wb;
    }
    q2 += __shfl_xor(q2, 32);
    if (hi == 0) ssq[t * 16 + hh] = q2;
}
}
namespace att2 {
typedef float f32x16 __attribute__((ext_vector_type(16)));
typedef short s16x4 __attribute__((ext_vector_type(4)));
typedef short v4i16_t __attribute__((ext_vector_type(4)));
typedef LAS const unsigned char* lds_cptr;
constexpr int NW = 8, QBLK = 32, QB = 256, KVBLK = 64, NSLOT = 3, SLOTB = 8192;
constexpr int LDS_K = 0, LDS_V = NSLOT * SLOTB, LDS_WS = 2 * NSLOT * SLOTB, LDS_OST = LDS_WS + NW * 64 * 4, LDS_LUT = LDS_OST + NW * 4096, LDS_KM = LDS_LUT + 2560, LDS_END = LDS_LUT + 5120;
constexpr int DMAXT = 383, NLUT = 639;
constexpr float NEGBIG = -1e30f;
__device__ __forceinline__ int crow(int r, int hi) { return (r & 3) + 8 * (r >> 2) + 4 * hi; }
#define SBAR() __builtin_amdgcn_sched_barrier(0)
__device__ __forceinline__ void glds16(const void* gsrc, unsigned lds_dst) { unsigned keep;
    asm volatile("s_mov_b32 %0, m0\n\ts_mov_b32 m0, %2\n\ts_nop 0\n\tglobal_load_lds_dwordx4 %1, off\n\ts_mov_b32 m0, %0" : "=&s"(keep) : "v"(gsrc), "s"(lds_dst) : "memory"); }
__device__ __forceinline__ float fadd_s(float a, float b) { float r; asm("v_add_f32_e32 %0, %1, %2" : "=v"(r) : "v"(a), "v"(b)); return r; }
__device__ __forceinline__ float fsub_s(float a, float b) { float r; asm("v_sub_f32_e32 %0, %1, %2" : "=v"(r) : "v"(a), "v"(b)); return r; }
__device__ __forceinline__ unsigned cvtpk_s(float lo, float hi) { f32x2 v = {lo, hi}; typedef __bf16 bf2 __attribute__((ext_vector_type(2))); bf2 b = __builtin_convertvector(v, bf2); return __builtin_bit_cast(unsigned, b); }
#define WAIT_BAR(N) asm volatile("s_waitcnt vmcnt(" #N ") lgkmcnt(0)\n\ts_barrier" ::: "memory")
__device__ __forceinline__ void qkt(f32x16& p0, f32x16& p1, lds_cptr Kslot, const bf16x8* qr, const f32x16& negm, int r32, int hi) {
    lds_cptr kb = Kslot + hi * 1024 + r32 * 16;
#pragma unroll
    for (int d0 = 0; d0 < 4; ++d0) {
        const bf16x8 b0 = *(const LAS bf16x8*)(kb + d0 * 2048), b1 = *(const LAS bf16x8*)(kb + d0 * 2048 + 512);
        if (d0 == 0) { p0 = __builtin_amdgcn_mfma_f32_32x32x16_bf16(b0, qr[0], negm, 0, 0, 0); p1 = __builtin_amdgcn_mfma_f32_32x32x16_bf16(b1, qr[0], negm, 0, 0, 0); }
        else { p0 = __builtin_amdgcn_mfma_f32_32x32x16_bf16(b0, qr[d0], p0, 0, 0, 0); p1 = __builtin_amdgcn_mfma_f32_32x32x16_bf16(b1, qr[d0], p1, 0, 0, 0); } }
}
__device__ __forceinline__ void kload8(bf16x8* kf, lds_cptr kp) {
    kf[0] = *(const LAS bf16x8*)(kp);        kf[1] = *(const LAS bf16x8*)(kp + 512);
    kf[2] = *(const LAS bf16x8*)(kp + 2048); kf[3] = *(const LAS bf16x8*)(kp + 2560);
    kf[4] = *(const LAS bf16x8*)(kp + 4096); kf[5] = *(const LAS bf16x8*)(kp + 4608);
    kf[6] = *(const LAS bf16x8*)(kp + 6144); kf[7] = *(const LAS bf16x8*)(kp + 6656);
}
__device__ __forceinline__ void kload2(bf16x8* kf, lds_cptr kp, int j) { kf[2 * j] = *(const LAS bf16x8*)(kp + j * 2048); kf[2 * j + 1] = *(const LAS bf16x8*)(kp + j * 2048 + 512); }
__device__ __forceinline__ s16x4 vtr(lds_cptr p) { return __builtin_bit_cast(s16x4, __builtin_amdgcn_ds_read_tr16_b64_v4i16((LAS v4i16_t*)p)); }
__device__ __forceinline__ float rowmax(const f32x16& p0, const f32x16& p1) {
    float a = __builtin_fmaxf(__builtin_fmaxf(p0[0], p0[1]), p1[0]), b = __builtin_fmaxf(__builtin_fmaxf(p0[2], p0[3]), p1[1]); a = __builtin_fmaxf(__builtin_fmaxf(a, p1[2]), p1[3]);
#pragma unroll
    for (int r = 4; r < 16; r += 4) { a = __builtin_fmaxf(__builtin_fmaxf(a, p0[r]), p0[r + 1]); b = __builtin_fmaxf(__builtin_fmaxf(b, p0[r + 2]), p0[r + 3]); a = __builtin_fmaxf(__builtin_fmaxf(a, p1[r]), p1[r + 1]); b = __builtin_fmaxf(__builtin_fmaxf(b, p1[r + 2]), p1[r + 3]); }
    const float m = __builtin_fmaxf(a, b);
    auto rr = __builtin_amdgcn_permlane32_swap(__float_as_uint(m), __float_as_uint(m), false, false);
    return __builtin_fmaxf(__uint_as_float(rr[0]), __uint_as_float(rr[1]));
}
__device__ __forceinline__ float xsum(float v) { auto rr = __builtin_amdgcn_permlane32_swap(__float_as_uint(v), __float_as_uint(v), false, false); return __uint_as_float(rr[0]) + __uint_as_float(rr[1]); }
__device__ __forceinline__ void pv(f32x16* o, int vb, bf16x8 pa0, bf16x8 pa1, bf16x8 pa2, bf16x8 pa3) {
#pragma unroll
    for (int d0 = 0; d0 < 2; ++d0) { s16x4 lo[4], hi[4];
#pragma unroll
        for (int ks = 0; ks < 4; ++ks) {
            asm volatile("ds_read_b64_tr_b16 %0,%1 offset:%c2" : "=&v"(lo[ks]) : "v"(vb), "i"(d0 * 4096 + ks * 1024) : "memory");
            asm volatile("ds_read_b64_tr_b16 %0,%1 offset:%c2" : "=&v"(hi[ks]) : "v"(vb), "i"(d0 * 4096 + ks * 1024 + 512) : "memory"); }
        asm volatile("s_waitcnt lgkmcnt(0)" ::: "memory"); SBAR();
#define PK(k) (bf16x8){lo[k][0], lo[k][1], lo[k][2], lo[k][3], hi[k][0], hi[k][1], hi[k][2], hi[k][3]}
        o[d0] = __builtin_amdgcn_mfma_f32_32x32x16_bf16(pa0, PK(0), o[d0], 0, 0, 0);
        o[d0] = __builtin_amdgcn_mfma_f32_32x32x16_bf16(pa1, PK(1), o[d0], 0, 0, 0);
        o[d0] = __builtin_amdgcn_mfma_f32_32x32x16_bf16(pa2, PK(2), o[d0], 0, 0, 0);
        o[d0] = __builtin_amdgcn_mfma_f32_32x32x16_bf16(pa3, PK(3), o[d0], 0, 0, 0);
#undef PK
    }
}

template <int TYPE, int THRL>
__device__ __forceinline__ void attn_unit(Frame& F, int b, int hlp, int n) {
    int tid_ = F.tid; asm volatile("" : "+v"(tid_));
    const int tid = tid_, lane = tid & 63, r32 = lane & 31, hi = lane >> 5; const int wid = F.wave;
    const int hl = TYPE ? hlp : 2 * hlp + (wid >> 2);
    const int hh = TYPE * 8 + hl, g = hl >> 2;
    const int colQ = (TYPE ? C_QB : C_QA) + 64 * hl, colK = (TYPE ? C_KB : C_KA) + 64 * g, colV = (TYPE ? C_VB : C_VA) + 64 * g;
    const bf16_t* qkv = (const bf16_t*)(F.ws + WS_QKV); bf16_t* O = (bf16_t*)(F.ws + WS_O); float* ssq = (float*)(F.ws + WS_SSQ);
    const float* tab = (const float*)(F.ws + WS_BIAS); const float* kmp = (const float*)(F.ws + WS_KMP);
    const long rowbase = (long)b * SEQ; const int q0 = TYPE ? n * QB : n * 128 + 0;
    const int qw0 = q0 + (TYPE ? wid : (wid & 3)) * QBLK;
    const lds_cptr shm3 = (lds_cptr)F.lds; LAS unsigned char* shmw = F.lds;
    const unsigned lds0 = (unsigned)(unsigned long)F.lds;
    LAS float* wsf = (LAS float*)(shmw + LDS_WS) + wid * 64;
    LAS float* lut = (LAS float*)(shmw + LDS_LUT) + (TYPE ? 0 : (wid >> 2) * 640); LAS float* kml = (LAS float*)(shmw + LDS_KM);
    const int t_lo = (2 * n - 2 > 0) ? 2 * n - 2 : 0;
    const int NT = TYPE ? 4 * n + 4 : 4;
#define TILE_OF(t) (TYPE ? ((t) < 4 ? 4 * n + (t) : (t) - 4) : t_lo + (t))
    const bf16_t* Qw = qkv + (rowbase + qw0) * INW + colQ;
    const bf16_t* Kh = qkv + rowbase * INW + colK; const bf16_t* Vh = qkv + rowbase * INW + colV;
    const bf16_t* ksrc = Kh + (long)lane * INW + wid * 8;
    const bf16_t* vsrc = Vh + (long)(16 * (wid & 3) + (lane >> 2)) * INW + (wid >> 2) * 32 + (lane & 3) * 8;
    const unsigned kdst = lds0 + LDS_K + wid * 1024, vdst = lds0 + LDS_V + wid * 1024;
#define DMA_K(t, slot) glds16(ksrc + (long)TILE_OF(t) * KVBLK * INW, (unsigned)__builtin_amdgcn_readfirstlane(kdst + (slot)))
#define DMA_V(t, slot) glds16(vsrc + (long)TILE_OF(t) * KVBLK * INW, (unsigned)__builtin_amdgcn_readfirstlane(vdst + (slot)))
    const int vb0 = (int)(lds0 + LDS_V) + ((lane >> 4) & 1) * 32 + (lane & 3) * 8 + (4 * hi + ((lane & 15) >> 2)) * 64;
    bf16x8 kf[8];
    const lds_cptr kp0 = shm3 + LDS_K + hi * 1024 + r32 * 16; const lds_cptr vp0 = shm3 + LDS_V + ((lane >> 4) & 1) * 32 + (lane & 3) * 8 + (4 * hi + ((lane & 15) >> 2)) * 64;
    DMA_K(0, 0); DMA_V(0, 0); DMA_K(1, SLOTB);
    bf16x8 qr[4];
#pragma unroll
    for (int d0 = 0; d0 < 4; ++d0) qr[d0] = *(const bf16x8*)(&Qw[(long)r32 * INW + d0 * 16 + hi * 8]);
    { const float* lg = (const float*)(F.ws + WS_BIAS + 16 * KiB);
      for (int e = tid; e < (TYPE ? 640 : 1280); e += NTHREADS) ((LAS float*)(shmw + LDS_LUT))[e] = lg[(TYPE ? hh : 2 * hlp) * 640 + e]; }
    if (TYPE) { const int nb = tid >> 6, d = tid & 63; float v = 0.f;
        if (nb < n) { const int pm = b * 8 + nb; v = kmp[((pm * 2 + 0) * 2 + g) * 64 + d] + kmp[((pm * 2 + 1) * 2 + g) * 64 + d]; }
        kml[tid] = v; }
    float mhat = TYPE ? 0.f : FIN(I_SINKS)[hl] * LOG2E, l_reg = (TYPE == 0 && hi == 0) ? 1.f : 0.f;
    f32x16 o[2]; o[0] = f32x16{}; o[1] = f32x16{}; f32x16 negm;
#pragma unroll
    for (int r = 0; r < 16; ++r) negm[r] = -mhat;
    asm volatile("" : "+v"(negm));
    const int qpos = qw0 + r32;
    const LAS float* lutq = lut + (DMAXT - qpos + 4 * hi);
#define LUTADD(P0, P1, t) do { const LAS float* lp_ = lutq + 64 * TILE_OF(t); \
        _Pragma("unroll") for (int r = 0; r < 16; ++r) { const int ko_ = (r & 3) + 8 * (r >> 2); P0[r] += lp_[ko_]; P1[r] += lp_[32 + ko_]; } } while (0)
#define NEAR(t) (TYPE == 0 || (t) < 4 || (t) >= NT - 2)
    unsigned sel = 0u;
#define PASTMASKED(tt) (TYPE == 1 && (tt) >= 4 && !((sel >> (((tt) - 4) >> 2)) & 1u))
    bool resc = false;
#define START(P0, P1) do { const float rm = rowmax(P0, P1); resc = false; \
        { const float dl = TYPE ? rm : (rm > (float)THRL ? rm : 0.f); mhat = fadd_s(mhat, dl); l_reg *= __builtin_amdgcn_exp2f(-dl); \
          _Pragma("unroll") for (int r = 0; r < 16; ++r) { P0[r] = fsub_s(P0[r], dl); P1[r] = fsub_s(P1[r], dl); } \
          _Pragma("unroll") for (int r = 0; r < 16; ++r) negm[r] = -mhat; asm volatile("" : "+v"(negm)); } \
        _Pragma("unroll") for (int r = 0; r < 16; ++r) P0[r] = __builtin_amdgcn_exp2f(P0[r]); } while (0)
#define RESC() do { if (resc) { asm volatile("s_waitcnt lgkmcnt(0)" ::: "memory"); \
        _Pragma("unroll") for (int d_ = 0; d_ < 2; ++d_) _Pragma("unroll") for (int r = 0; r < 16; ++r) o[d_][r] *= wsf[crow(r, hi)]; } } while (0)
    f32x16 pA0, pA1, pB0, pB1;
    int sl_prev = 0, sl_cur = 0, sl_next = SLOTB;
#define ROT() do { sl_prev = sl_cur; sl_cur = sl_next; sl_next = (sl_next == (NSLOT - 1) * SLOTB) ? 0 : sl_next + SLOTB; } while (0)
    DMA_K(2, 2 * SLOTB);
    WAIT_BAR(3);
    qkt(pA0, pA1, shm3 + LDS_K, qr, negm, r32, hi); asm volatile("s_nop 15\n\ts_nop 7" : "+v"(pA0), "+v"(pA1)); LUTADD(pA0, pA1, 0);
    START(pA0, pA1);
#pragma unroll
    for (int r = 0; r < 16; ++r) pA1[r] = __builtin_amdgcn_exp2f(pA1[r]);
    if (TYPE) {
        float gate[8];
#pragma unroll
        for (int nb = 0; nb < 8; ++nb) gate[nb] = 0.f;
#pragma unroll
        for (int d0 = 0; d0 < 4; ++d0) { float q8[8];
#pragma unroll
            for (int j = 0; j < 8; ++j) q8[j] = bf2f((unsigned short)qr[d0][j]);
#pragma unroll
            for (int nb = 0; nb < 7; ++nb) if (nb < n) { const f32x4 k0 = *(const LAS f32x4*)(kml + nb * 64 + 16 * d0 + 8 * hi), k1 = *(const LAS f32x4*)(kml + nb * 64 + 16 * d0 + 8 * hi + 4);
                gate[nb] += (q8[0] * k0[0] + q8[1] * k0[1]) + (q8[2] * k0[2] + q8[3] * k0[3]) + (q8[4] * k1[0] + q8[5] * k1[1]) + (q8[6] * k1[2] + q8[7] * k1[3]); } }
#pragma unroll
        for (int nb = 0; nb < 7; ++nb) gate[nb] = xsum(gate[nb]);
        const int nsel = n < 3 ? n : 3;
        for (int k = 0; k < nsel; ++k) { float best = -3e38f; int bi = 0;
#pragma unroll
            for (int nb = 0; nb < 7; ++nb) { const bool ok = (nb < n) && !((sel >> nb) & 1u) && (gate[nb] > best); if (ok) { best = gate[nb]; bi = nb; } }
            sel |= 1u << bi; }
    }
    WAIT_BAR(0);
    DMA_K(3, 0); DMA_V(1, SLOTB);
    ROT();
    kload8(kf, kp0 + sl_cur);
    WAIT_BAR(2);
    s16x4 vlo[8], vhi[8]; u32x4 pw0, pw1, pw2, pw3;
#define PKW(P, B) cvtpk_s(P[B], P[B + 1])
#define PAF(k) __builtin_bit_cast(bf16x8, pw##k)
#define VFR(i) (bf16x8){vlo[i][0], vlo[i][1], vlo[i][2], vlo[i][3], vhi[i][0], vhi[i][1], vhi[i][2], vhi[i][3]}
#define PIN(x) asm volatile("" : "+v"(x))
#define MX3(a, b, c) __builtin_fmaxf(__builtin_fmaxf((a), (b)), (c))
#define GAPA(MF, A0, A1, A2, A3, W0, W1, PW) do { MF; sacc += A0; sacc += A1; sacc += A2; sacc += A3; PIN(sacc); W0; W1; PIN(PW); SBAR(); } while (0)
#define EX(v) __builtin_amdgcn_exp2f(v)
#define GAPB(MF, X, B) do { MF; X[B] = EX(X[B]); X[B + 1] = EX(X[B + 1]); X[B + 2] = EX(X[B + 2]); X[B + 3] = EX(X[B + 3]); PIN(X); SBAR(); } while (0)
#define VRD(i) do { vlo[i] = vtr(vp_ + (((i) >> 2) * 4096 + ((i) & 3) * 1024)); vhi[i] = vtr(vp_ + (((i) >> 2) * 4096 + ((i) & 3) * 1024 + 512)); } while (0)
#define KRD(G, j) do { if (G) { kload2(kf, kp0 + sl_next, j); SBAR(); } } while (0)
#define STEP(C0, C1, P0, P1, t, GK, GV, GL, MASKED) do { SBAR(); \
    const lds_cptr vp_ = vp0 + sl_prev; \
    VRD(0); SBAR(); float sacc = (P0[0] + P0[1]); \
    GAPA(C0 = __builtin_amdgcn_mfma_f32_32x32x16_bf16(kf[0], qr[0], negm, 0, 0, 0), P0[2], P0[3], P0[4], P0[5],     pw0[0] = PKW(P0, 0), pw0[1] = PKW(P0, 2), pw0); \
    VRD(4); SBAR(); GAPA(C1 = __builtin_amdgcn_mfma_f32_32x32x16_bf16(kf[1], qr[0], negm, 0, 0, 0), P0[6], P0[7], P0[8], P0[9],     pw0[2] = PKW(P0, 4), pw0[3] = PKW(P0, 6), pw0); \
    VRD(1); SBAR(); GAPA(C0 = __builtin_amdgcn_mfma_f32_32x32x16_bf16(kf[2], qr[1], C0, 0, 0, 0),   P0[10], P0[11], P0[12], P0[13], pw1[0] = PKW(P0, 8), pw1[1] = PKW(P0, 10), pw1); \
    VRD(5); SBAR(); GAPA(C1 = __builtin_amdgcn_mfma_f32_32x32x16_bf16(kf[3], qr[1], C1, 0, 0, 0),   P0[14], P0[15], P1[0], P1[1],   pw1[2] = PKW(P0, 12), pw1[3] = PKW(P0, 14), pw1); \
    VRD(2); SBAR(); GAPA(C0 = __builtin_amdgcn_mfma_f32_32x32x16_bf16(kf[4], qr[2], C0, 0, 0, 0),   P1[2], P1[3], P1[4], P1[5],     pw2[0] = PKW(P1, 0), pw2[1] = PKW(P1, 2), pw2); \
    VRD(6); SBAR(); GAPA(C1 = __builtin_amdgcn_mfma_f32_32x32x16_bf16(kf[5], qr[2], C1, 0, 0, 0),   P1[6], P1[7], P1[8], P1[9],     pw2[2] = PKW(P1, 4), pw2[3] = PKW(P1, 6), pw2); \
    VRD(3); SBAR(); GAPA(C0 = __builtin_amdgcn_mfma_f32_32x32x16_bf16(kf[6], qr[3], C0, 0, 0, 0),   P1[10], P1[11], P1[12], P1[13], pw3[0] = PKW(P1, 8), pw3[1] = PKW(P1, 10), pw3); \
    VRD(7); SBAR(); GAPA(C1 = __builtin_amdgcn_mfma_f32_32x32x16_bf16(kf[7], qr[3], C1, 0, 0, 0),   P1[14], P1[15], 0.f, 0.f,       pw3[2] = PKW(P1, 12), pw3[3] = PKW(P1, 14), pw3); \
    l_reg += sacc; \
    if (GK) { DMA_K((t) + 3, sl_cur); } if (GV) { DMA_V((t) + 1, sl_next); } \
    if (MASKED) { if (NEAR(t)) LUTADD(C0, C1, t); } \
    { float a = MX3(C0[0], C0[1], C1[0]), b_ = MX3(C0[2], C0[3], C1[1]); a = MX3(a, C1[2], C1[3]); \
      _Pragma("unroll") for (int r = 4; r < 16; r += 4) { a = MX3(a, C0[r], C0[r + 1]); b_ = MX3(b_, C0[r + 2], C0[r + 3]); a = MX3(a, C1[r], C1[r + 1]); b_ = MX3(b_, C1[r + 2], C1[r + 3]); } \
      float rm = __builtin_fmaxf(a, b_); { auto rr = __builtin_amdgcn_permlane32_swap(__float_as_uint(rm), __float_as_uint(rm), false, false); rm = __builtin_fmaxf(__uint_as_float(rr[0]), __uint_as_float(rr[1])); } \
      resc = false; \
      if (__builtin_expect(__any(rm > (float)THRL), 0)) { const float dl = __builtin_fmaxf(rm, 0.f); mhat += dl; \
        _Pragma("unroll") for (int r = 0; r < 16; ++r) { C0[r] -= dl; C1[r] -= dl; } \
        const float f = __builtin_amdgcn_exp2f(-dl); l_reg *= f; if (hi == 0) wsf[r32] = f; resc = true; } \
        \
      if (resc || (TYPE == 1 && ((t) + 1) >= 4 && ((((t) + 1) & 3) == 0))) { const float cv_ = PASTMASKED((t) + 1) ? NEGBIG : -mhat; \
        _Pragma("unroll") for (int r = 0; r < 16; ++r) negm[r] = cv_; asm volatile("" : "+v"(negm)); } } \
    SBAR(); \
    GAPB(o[0] = __builtin_amdgcn_mfma_f32_32x32x16_bf16(PAF(0), VFR(0), o[0], 0, 0, 0), C0, 0); \
    GAPB(o[1] = __builtin_amdgcn_mfma_f32_32x32x16_bf16(PAF(0), VFR(4), o[1], 0, 0, 0), C0, 4); \
    KRD(GL, 0); GAPB(o[0] = __builtin_amdgcn_mfma_f32_32x32x16_bf16(PAF(1), VFR(1), o[0], 0, 0, 0), C0, 8); \
    KRD(GL, 1); GAPB(o[1] = __builtin_amdgcn_mfma_f32_32x32x16_bf16(PAF(1), VFR(5), o[1], 0, 0, 0), C0, 12); \
    KRD(GL, 2); GAPB(o[0] = __builtin_amdgcn_mfma_f32_32x32x16_bf16(PAF(2), VFR(2), o[0], 0, 0, 0), C1, 0); \
    KRD(GL, 3); GAPB(o[1] = __builtin_amdgcn_mfma_f32_32x32x16_bf16(PAF(2), VFR(6), o[1], 0, 0, 0), C1, 4); \
    GAPB(o[0] = __builtin_amdgcn_mfma_f32_32x32x16_bf16(PAF(3), VFR(3), o[0], 0, 0, 0), C1, 8); \
    GAPB(o[1] = __builtin_amdgcn_mfma_f32_32x32x16_bf16(PAF(3), VFR(7), o[1], 0, 0, 0), C1, 12); \
    } while (0)
    int t = 1;
    for (; t < 5 && t + 5 < NT; t += 2) {
        STEP(pB0, pB1, pA0, pA1, t, true, true, true, true);     WAIT_BAR(2); RESC(); ROT();
        STEP(pA0, pA1, pB0, pB1, t + 1, true, true, true, true); WAIT_BAR(2); RESC(); ROT();
    }
    for (; t + 5 < NT; t += 2) {
        STEP(pB0, pB1, pA0, pA1, t, true, true, true, false);     WAIT_BAR(2); RESC(); ROT();
        STEP(pA0, pA1, pB0, pB1, t + 1, true, true, true, false); WAIT_BAR(2); RESC(); ROT();
    }
#define ENDW(tt) do { if ((tt) + 3 < NT) { WAIT_BAR(2); } else if ((tt) + 2 < NT) { WAIT_BAR(1); } else { WAIT_BAR(0); } } while (0)
    for (; t + 1 < NT; t += 2) {
        STEP(pB0, pB1, pA0, pA1, t, (t + 3 < NT), (t + 1 < NT), (t + 1 < NT), true);         ENDW(t);     RESC(); ROT();
        STEP(pA0, pA1, pB0, pB1, t + 1, (t + 4 < NT), (t + 2 < NT), (t + 2 < NT), true);     ENDW(t + 1); RESC(); ROT();
    }
    STEP(pB0, pB1, pA0, pA1, NT - 1, false, false, false, true); RESC();
    { float sacc = pB0[0] + pB0[1];
#pragma unroll
      for (int r = 2; r < 16; ++r) sacc += pB0[r];
#pragma unroll
      for (int r = 0; r < 16; ++r) sacc += pB1[r];
      l_reg += sacc;
      pw0 = (u32x4){PKW(pB0, 0), PKW(pB0, 2), PKW(pB0, 4), PKW(pB0, 6)}; pw1 = (u32x4){PKW(pB0, 8), PKW(pB0, 10), PKW(pB0, 12), PKW(pB0, 14)};
      pw2 = (u32x4){PKW(pB1, 0), PKW(pB1, 2), PKW(pB1, 4), PKW(pB1, 6)}; pw3 = (u32x4){PKW(pB1, 8), PKW(pB1, 10), PKW(pB1, 12), PKW(pB1, 14)};
      SBAR(); pv(o, vb0 + sl_cur, PAF(0), PAF(1), PAF(2), PAF(3)); }
#undef ENDW
#undef STEP
#undef KRD
#undef VRD
#undef GAPB
#undef EX
#undef GAPA
#undef MX3
#undef PIN
#undef VFR
#undef PAF
#undef PKW
    l_reg = xsum(l_reg);
    int lane_e = lane; asm volatile("" : "+v"(lane_e));
    if (hi == 0) wsf[32 + r32] = l_reg; asm volatile("s_waitcnt lgkmcnt(0)" ::: "memory");
    float rli[16];
#pragma unroll
    for (int r = 0; r < 16; ++r) rli[r] = __builtin_amdgcn_rcpf(wsf[32 + crow(r, hi)]);
    bf16_t* Ow = O + (rowbase + qw0) * DM + 64 * hh;
    { LAS bf16_t* stg = (LAS bf16_t*)(shmw + LDS_OST) + wid * 2048;
#pragma unroll
      for (int r = 0; r < 16; ++r) { const int orow = crow(r, hi);
#pragma unroll
          for (int d0 = 0; d0 < 2; ++d0) stg[orow * 64 + d0 * 32 + r32] = (bf16_t)f2bf(o[d0][r] * rli[r]); }
      asm volatile("s_waitcnt lgkmcnt(0)" ::: "memory");
#pragma unroll
      for (int i = 0; i < 4; ++i) { const int row = i * 8 + (lane_e >> 3), ch = lane_e & 7; const u32x4 v = *(const LAS u32x4*)(stg + row * 64 + ch * 8);
          *(u32x4*)(Ow + (long)row * DM + ch * 8) = v;
          float q2 = bflo(v.x) * bflo(v.x) + bfhi(v.x) * bfhi(v.x) + bflo(v.y) * bflo(v.y) + bfhi(v.y) * bfhi(v.y) + bflo(v.z) * bflo(v.z) + bfhi(v.z) * bfhi(v.z) + bflo(v.w) * bflo(v.w) + bfhi(v.w) * bfhi(v.w);
          q2 += __shfl_xor(q2, 1); q2 += __shfl_xor(q2, 2); q2 += __shfl_xor(q2, 4);
          if (ch == 0) ssq[(size_t)(rowbase + qw0 + row) * 16 + hh] = q2; } }
    asm volatile("s_waitcnt lgkmcnt(0)\n\ts_barrier" ::: "memory");
#undef DMA_K
#undef DMA_V
#undef LUTADD
#undef NEAR
#undef PASTMASKED
#undef START
#undef RESC
#undef ROT
#undef TILE_OF
}
#undef SBAR
#undef WAIT_BAR
}

__device__ __forceinline__ void p2_attention(Frame& F) {
    for (int j = F.vcu; j < 512; j += F.G) {
        if (j < 256) { const int b = j >> 5, hm = (j >> 2) & 7, pi = j & 3;
#pragma unroll 1
            for (int k = 0; k < 2; ++k) att2::attn_unit<1, 8>(F, b, hm, k ? pi : 7 - pi); }
        else { const int id = 2 * (j - 256);
#pragma unroll 1
            for (int k = 0; k < 2; ++k) { const int u = id + k; att2::attn_unit<0, 8>(F, u >> 6, (u >> 4) & 3, u & 15); } }
    }
    __syncthreads();
}

__device__ __forceinline__ void p4_router(Frame& F) {
    typedef float f32x16 __attribute__((ext_vector_type(16)));
    const bf16_t* x1b = (const bf16_t*)(F.ws + WS_X1B); float* r2 = (float*)(F.ws + WS_R2); const bf16_t* Wt = (const bf16_t*)(F.ws + WS_WR);
    LAS float* part = (LAS float*)F.lds;
    LAS float* sspart = (LAS float*)(F.lds + 98304);
    LAS int* lcnt = (LAS int*)(F.lds + MISC_OFF);
    LAS int* trec = (LAS int*)(F.lds + MISC_OFF + 512);
    unsigned* cnt = (unsigned*)(F.ctl + CW_CNT); unsigned* list = (unsigned*)(F.ws + WS_LIST); int* tok = (int*)(F.ws + WS_TOK);
    if (F.tid < 64) lcnt[F.tid] = 0;
    const int per = T / F.G;
    const int t0 = F.vcu * per;
    {
        const int tg = F.wave >> 2, kq = F.wave & 3, r32 = F.lane & 31, hi = F.lane >> 5;
        const bf16_t* ap = x1b + (size_t)(t0 + 32 * tg + r32) * DM + 256 * kq + 8 * hi;
        const bf16_t* bp = Wt + (size_t)r32 * DM + 256 * kq + 8 * hi;
        f32x16 a0 = {}, a1 = {}, a2 = {}; float ss = 0.f;
#pragma unroll 4
        for (int s = 0; s < 16; ++s) {
            const bf16x8 a = *(const bf16x8*)(ap + 16 * s);
            const bf16x8 b0 = *(const bf16x8*)(bp + 16 * s), b1 = *(const bf16x8*)(bp + (size_t)32 * DM + 16 * s), b2 = *(const bf16x8*)(bp + (size_t)64 * DM + 16 * s);
            a0 = __builtin_amdgcn_mfma_f32_32x32x16_bf16(a, b0, a0, 0, 0, 0); a1 = __builtin_amdgcn_mfma_f32_32x32x16_bf16(a, b1, a1, 0, 0, 0); a2 = __builtin_amdgcn_mfma_f32_32x32x16_bf16(a, b2, a2, 0, 0, 0);
#pragma unroll
            for (int j = 0; j < 8; ++j) { const float v = bf2f((unsigned short)a[j]); ss += v * v; }
        }
        LAS float* pp = part + ((tg * 4 + kq) * 32) * 96 + r32;
#pragma unroll
        for (int r = 0; r < 16; ++r) { const int tk = (r & 3) + 8 * (r >> 2) + 4 * hi; pp[tk * 96] = a0[r]; pp[tk * 96 + 32] = a1[r]; pp[tk * 96 + 64] = a2[r]; }
        sspart[((tg * 4 + kq) * 2 + hi) * 32 + r32] = ss;
    }
    __syncthreads();
    if (F.tid < per) {
        const int lt = F.tid, tg = lt >> 5, tk = lt & 31, t = t0 + lt;
        float lg[36]; float ssq = 0.f;
#pragma unroll
        for (int o = 0; o < 36; ++o) lg[o] = 0.f;
#pragma unroll
        for (int kq = 0; kq < 4; ++kq) { const LAS float* pr = part + ((tg * 4 + kq) * 32 + tk) * 96;
#pragma unroll
            for (int o = 0; o < 32; ++o) lg[o] += pr[o] + pr[32 + o];
#pragma unroll
            for (int o = 0; o < 4; ++o) lg[32 + o] += pr[64 + o] + pr[68 + o];
            ssq += sspart[((tg * 4 + kq) * 2 + 0) * 32 + tk] + sspart[((tg * 4 + kq) * 2 + 1) * 32 + tk]; }
        const float rs = 1.0f / sqrtf(ssq * (1.0f / DM) + EPS);
#pragma unroll
        for (int o = 0; o < 36; ++o) lg[o] *= rs;
        const float* brg = FIN(I_B_RG); const float* bre = FIN(I_B_RE);
        lg[0] += brg[0]; lg[1] += brg[1]; lg[2] += brg[2]; lg[3] += brg[3];
        int gsel = 0; float gm = lg[0];
#pragma unroll
        for (int o = 1; o < 4; ++o) if (lg[o] > gm) { gm = lg[o]; gsel = o; }
        float den = 0.f;
#pragma unroll
        for (int o = 0; o < 4; ++o) den += __expf(lg[o] - gm);
        const float gwt = 1.0f / den;
        float el[8];
#pragma unroll
        for (int j = 0; j < 8; ++j) { float a = lg[4 + j];
#pragma unroll
            for (int gq = 1; gq < 4; ++gq) a = (gsel == gq) ? lg[4 + 8 * gq + j] : a;
            el[j] = a + bre[gsel * 8 + j]; }
        int i0 = 0; float v0 = el[0];
#pragma unroll
        for (int j = 1; j < 8; ++j) if (el[j] > v0) { v0 = el[j]; i0 = j; }
        int i1 = -1; float v1 = -3e38f;
#pragma unroll
        for (int j = 0; j < 8; ++j) if (j != i0 && el[j] > v1) { v1 = el[j]; i1 = j; }
        const float e1 = __expf(v1 - v0); const float w0 = gwt / (1.0f + e1), w1 = gwt * e1 / (1.0f + e1);
        const int e0 = gsel * 8 + i0, e1i = gsel * 8 + i1;
        const int lr0 = __hip_atomic_fetch_add(&lcnt[e0], 1, __ATOMIC_RELAXED, __HIP_MEMORY_SCOPE_WORKGROUP);
        const int lr1 = __hip_atomic_fetch_add(&lcnt[e1i], 1, __ATOMIC_RELAXED, __HIP_MEMORY_SCOPE_WORKGROUP);
        trec[lt * 8 + 0] = e0; trec[lt * 8 + 1] = e1i; trec[lt * 8 + 2] = lr0; trec[lt * 8 + 3] = lr1;
        trec[lt * 8 + 4] = __builtin_bit_cast(int, w0); trec[lt * 8 + 5] = __builtin_bit_cast(int, w1);
        r2[t] = rs;
    }
    __syncthreads();
    if (F.tid < 32) { const int c = lcnt[F.tid]; int base = 0; if (c > 0) base = (int)__hip_atomic_fetch_add(&cnt[F.tid], (unsigned)c, __ATOMIC_RELAXED, __HIP_MEMORY_SCOPE_AGENT); lcnt[32 + F.tid] = base; }
    __syncthreads();
    for (int lt = F.tid; lt < per; lt += NTHREADS) {
        const int t = t0 + lt; const int e0 = trec[lt * 8 + 0], e1 = trec[lt * 8 + 1];
        const int rk0 = lcnt[32 + e0] + trec[lt * 8 + 2], rk1 = lcnt[32 + e1] + trec[lt * 8 + 3];
        list[e0 * 16384 + rk0] = (unsigned)(t * 2); list[e1 * 16384 + rk1] = (unsigned)(t * 2 + 1);
        int* tr = tok + (size_t)t * 8; tr[0] = e0; tr[1] = e1; tr[2] = rk0; tr[3] = rk1; tr[4] = trec[lt * 8 + 4]; tr[5] = trec[lt * 8 + 5];
    }
    __syncthreads();
}

__device__ __forceinline__ void build_tile_table(Frame& F, LAS int* tb) {
    if (F.tid < 64) {
        const unsigned* cnt = (const unsigned*)(F.ctl + CW_CNT);
        const int nt = (F.lane < NEXP) ? (int)((__hip_atomic_load(&cnt[F.lane & 31], __ATOMIC_RELAXED, __HIP_MEMORY_SCOPE_AGENT) + 255u) >> 8) : 0;
        int inc = nt;
#pragma unroll
        for (int o = 1; o < 32; o <<= 1) { const int v = __shfl_up(inc, o); if ((F.lane & 31) >= o) inc += v; }
        if (F.lane < NEXP) { tb[F.lane] = inc - nt; if (F.lane == NEXP - 1) tb[NEXP] = inc; }
    }
    __syncthreads();
}

__device__ __forceinline__ void p7_combine(Frame& F) {
    const bf16_t* x1b = (const bf16_t*)(F.ws + WS_X1B); const bf16_t* Y = (const bf16_t*)(F.ws + WS_Y); bf16_t* x2b = (bf16_t*)(F.ws + WS_X2B); float* r3 = (float*)(F.ws + WS_R3); const int* tok = (const int*)(F.ws + WS_TOK);
    const int gw = F.vcu * NWAVES + F.wave, NGW = F.G * NWAVES;
    for (int t = gw; t < T; t += 2 * NGW) {
        const int tb_ = (t + NGW < T) ? t + NGW : t; const bool two = tb_ != t;
        const f32x2 wa = *(const f32x2*)(tok + (size_t)t * 8 + 4), wb = *(const f32x2*)(tok + (size_t)tb_ * 8 + 4);
        u32x2 xa[2][4], ya[2][4], yb[2][4];
#pragma unroll
        for (int k = 0; k < 2; ++k) { const int tt = k ? tb_ : t;
            const GAS u32x2* xr = (const GAS u32x2*)(x1b + (size_t)tt * DM) + F.lane;
            const GAS u32x2* y0 = (const GAS u32x2*)(Y + (size_t)(2 * tt) * DM) + F.lane; const GAS u32x2* y1 = (const GAS u32x2*)(Y + (size_t)(2 * tt + 1) * DM) + F.lane;
#pragma unroll
            for (int j = 0; j < 4; ++j) { xa[k][j] = xr[64 * j]; ya[k][j] = y0[64 * j]; yb[k][j] = y1[64 * j]; } }
#pragma unroll
        for (int k = 0; k < 2; ++k) { const int tt = k ? tb_ : t; const float w0 = k ? wb.x : wa.x, w1 = k ? wb.y : wa.y;
            GAS u32x2* ob = (GAS u32x2*)(x2b + (size_t)tt * DM) + F.lane; float s = 0.f;
#pragma unroll
            for (int j = 0; j < 4; ++j) { f32x4 v;
                v.x = bflo(xa[k][j].x) + (w0 * bflo(ya[k][j].x) + w1 * bflo(yb[k][j].x)); v.y = bfhi(xa[k][j].x) + (w0 * bfhi(ya[k][j].x) + w1 * bfhi(yb[k][j].x));
                v.z = bflo(xa[k][j].y) + (w0 * bflo(ya[k][j].y) + w1 * bflo(yb[k][j].y)); v.w = bfhi(xa[k][j].y) + (w0 * bfhi(ya[k][j].y) + w1 * bfhi(yb[k][j].y));
                u32x2 w; w.x = pk2(v.x, v.y); w.y = pk2(v.z, v.w); if (k == 0 || two) ob[64 * j] = w; s += (v.x * v.x + v.y * v.y) + (v.z * v.z + v.w * v.w); }
            s = wave_sum(s);
            if (F.lane == 0 && (k == 0 || two)) r3[tt] = 1.0f / sqrtf(s * (1.0f / DM) + EPS); }
    }
}

#define XB_TMO      128
#define XB_XCNT(j)  (256  + 64 * (j))
#define XB_XSUB(j)  (1280 + 64 * (j))
#define XB_XGEN(j)  (2304 + 64 * (j))
#define XB_TOP      3328
#define XB_TOPGEN   3392
#define XCD_BAR_WORDS 3456
#define XB_SPIN_CAP (1u << 18)
__device__ __forceinline__ unsigned xb_ld(unsigned* p)              { return __hip_atomic_load(p, __ATOMIC_RELAXED, __HIP_MEMORY_SCOPE_AGENT); }
__device__ __forceinline__ unsigned xb_add(unsigned* p, unsigned v) { return __hip_atomic_fetch_add(p, v, __ATOMIC_RELAXED, __HIP_MEMORY_SCOPE_AGENT); }
__device__ __forceinline__ unsigned xb_xcc_id() { return (unsigned)__builtin_amdgcn_s_getreg((3 << 11) | 20) & 0xFu; }
#define XB_SPIN(cond, bar) do { unsigned _sp = 0; while (cond) { __builtin_amdgcn_s_sleep(1); \
    if ((++_sp & 255u) == 0u) { if (xb_ld(&(bar)[XB_TMO])) break; if (_sp > XB_SPIN_CAP) { atomicAdd(&(bar)[XB_TMO], 1u); break; } } } } while (0)
struct XcdBarrier { unsigned* bar; unsigned x; volatile LAS unsigned* st; };
__device__ __forceinline__ XcdBarrier xcd_barrier_post(unsigned* bar, volatile LAS unsigned* st) {
    XcdBarrier b; b.bar = bar; b.x = xb_xcc_id(); b.st = st;
    if (threadIdx.x == 0) (void)xb_add(&bar[XB_XCNT(b.x)], 1u);
    return b;
}
__device__ __forceinline__ void xcd_barrier_complete(unsigned* bar, unsigned x, unsigned& nloc, unsigned& nx) {
    const unsigned G = gridDim.x * gridDim.y * gridDim.z;
    unsigned sum, cnt, mine, sp = 0u;
    for (;;) {
        sum = 0u; cnt = 0u; mine = 0u;
#pragma unroll
        for (unsigned j = 0; j < 16; ++j) { const unsigned c = xb_ld(&bar[XB_XCNT(j)]); sum += c; cnt += (c > 0u) ? 1u : 0u; mine = (j == x) ? c : mine; }
        if (sum == G) break;
        __builtin_amdgcn_s_sleep(1);
        if ((++sp & 255u) == 0u) { if (xb_ld(&bar[XB_TMO])) break; if (sp > XB_SPIN_CAP) { atomicAdd(&bar[XB_TMO], 1u); break; } }
    }
    nloc = mine > 0u ? mine : 1u; nx = cnt > 0u ? cnt : 1u;
}
__device__ __forceinline__ void xcd_barrier(const XcdBarrier& b) {
    asm volatile("s_waitcnt vmcnt(0)" ::: "memory");
    __syncthreads();
    if (threadIdx.x == 0) {
        unsigned* bar = b.bar;
        __builtin_amdgcn_s_waitcnt(0);
        unsigned nloc = b.st[0], nx = b.st[1];
        if (nloc == 0u) { xcd_barrier_complete(bar, b.x, nloc, nx); b.st[0] = nloc; b.st[1] = nx; }
        const unsigned old = xb_add(&bar[XB_XSUB(b.x)], 1u);
        const unsigned gen = old / nloc;
        if (old + 1u == (gen + 1u) * nloc) {
            __builtin_amdgcn_fence(__ATOMIC_RELEASE, "agent");
            asm volatile("s_waitcnt vmcnt(0)" ::: "memory");
            const unsigned og = xb_add(&bar[XB_TOP], 1u);
            const unsigned tg = og / nx;
            if (og + 1u == (tg + 1u) * nx) xb_add(&bar[XB_TOPGEN], 1u);
            else XB_SPIN(xb_ld(&bar[XB_TOPGEN]) == tg, bar);
            __builtin_amdgcn_fence(__ATOMIC_ACQUIRE, "agent");
            xb_add(&bar[XB_XGEN(b.x)], 1u);
            asm volatile("s_waitcnt vmcnt(0)" ::: "memory");
        } else {
            XB_SPIN(xb_ld(&bar[XB_XGEN(b.x)]) == gen, bar);
            __builtin_amdgcn_fence(__ATOMIC_ACQUIRE, "agent");
            asm volatile("s_waitcnt vmcnt(0)" ::: "memory");
        }
    }
    __syncthreads();
}

__global__ void __launch_bounds__(NTHREADS, 2) hymba_fwd(Args args) {
    extern __shared__ __attribute__((aligned(16))) unsigned char lds[];
    Frame F;
    F.lds = (LAS unsigned char*)lds; unsigned char* ws;
#define REFRESH_IDS() do { int t_ = threadIdx.x; asm volatile("" : "+v"(t_)); F.tid = t_; F.lane = t_ & 63; F.wave = __builtin_amdgcn_readfirstlane(t_ >> 6); \
        unsigned char* w_ = args.ws; const __attribute__((address_space(4))) char* k_ = (const __attribute__((address_space(4))) char*)__builtin_amdgcn_kernarg_segment_ptr(); float* o_ = args.out; asm volatile("" : "+s"(w_), "+s"(k_), "+s"(o_)); \
        F.ws = w_; F.ka = k_; F.out = o_; F.ctl = (GAS unsigned*)(w_ + WS_CTL); ws = w_; } while (0)
    REFRESH_IDS();
    F.G = gridDim.x; { const int bx = blockIdx.x; F.vcu = (F.G % 8 == 0) ? (bx % 8) * (F.G / 8) + bx / 8 : bx; }
    const int lo = args.ph_lo, hi = args.ph_hi;
#ifdef ONLY_PHASE
#define IN(k) ((k) == ONLY_PHASE && lo <= (k) && (k) < hi)
#else
#define IN(k) (lo <= (k) && (k) < hi)
#endif
    LAS int* tb = (LAS int*)(F.lds + MISC_OFF + 8192);
    LAS f32x2* rowtab = (LAS f32x2*)(F.lds + MISC_OFF + 4096);
    volatile LAS unsigned* bst = (volatile LAS unsigned*)(F.lds + MISC_OFF + 12288);
    if (F.tid < 2) bst[F.tid] = 0u;
    __syncthreads();
    XcdBarrier bar; bar.bar = (unsigned*)(F.ctl + CW_BAR); bar.x = 0; bar.st = bst;
    if (hi - lo > 1) bar = xcd_barrier_post((unsigned*)(F.ctl + CW_BAR), bst);
#define SEAM(k) do { if (IN(k) && IN((k) + 1)) xcd_barrier(bar); } while (0)

    for (int rep = 0; rep < 1 + ((REPEAT_MASK >> 0) & 1); ++rep) { if (rep) xcd_barrier(bar);
    if (IN(0)) { REFRESH_IDS(); p0_prologue(F); }
    }
    SEAM(0);
    for (int rep = 0; rep < 1 + ((REPEAT_MASK >> 1) & 1); ++rep) { if (rep) xcd_barrier(bar);
    if (IN(1)) {
        REFRESH_IDS();
        { pg8::DenseOrder S{(const char*)(ws + WS_XB), (const char*)(ws + WS_WIN), T / 256, INW / 256, DM, F.G, (int)blockIdx.x};
          EpiQKV E{(bf16_t*)(ws + WS_QKV), (const float*)(ws + WS_RS1), FIN(I_SWA_QN), FIN(I_SWA_KN), FIN(I_MOBA_QN), FIN(I_MOBA_KN), (float*)(ws + WS_KMP)};
          pg8::gemm_phase<EpiQKV, pg8::DenseOrder, true, false, false>(F.lds, DM, S, E); }
        { const int hg = F.G / 2; const bool second = (int)blockIdx.x >= hg;
          pg8::DenseOrder S{(const char*)(ws + WS_PB), (const char*)(ws + WS_WPP), T / 256, DM / 256, PLE, second ? hg : (1 << 30), second ? (int)blockIdx.x - hg : (1 << 30)};
          EpiProj E{(bf16_t*)(ws + WS_PRAW), (float*)(ws + WS_SSQP)};
          pg8::gemm_phase<EpiProj, pg8::DenseOrder, true, false, false>(F.lds, PLE, S, E); }
    }
    }
    SEAM(1);
    for (int rep = 0; rep < 1 + ((REPEAT_MASK >> 2) & 1); ++rep) { if (rep) xcd_barrier(bar);
    if (IN(2)) { REFRESH_IDS(); p2_attention(F); }
    }
    SEAM(2);
    for (int rep = 0; rep < 1 + ((REPEAT_MASK >> 3) & 1); ++rep) { if (rep) xcd_barrier(bar);
    if (IN(3)) {
        pg8::DenseOrder S{(const char*)(ws + WS_O), (const char*)(ws + WS_WOUT), T / 256, DM / 256, DM, F.G, (int)blockIdx.x};
        REFRESH_IDS();
        { pg8::Unit u0; if (S.next(0, u0) && F.tid < 256) {
              const f32x4* p = (const f32x4*)((const float*)(ws + WS_SSQ) + (size_t)(u0.pm * 256 + F.tid) * 16); const f32x4 a0 = p[0], a1 = p[1], b0 = p[2], b1 = p[3];
              const float qa = ((a0[0] + a0[1]) + (a0[2] + a0[3])) + ((a1[0] + a1[1]) + (a1[2] + a1[3])), qb = ((b0[0] + b0[1]) + (b0[2] + b0[3])) + ((b1[0] + b1[1]) + (b1[2] + b1[3]));
              rowtab[F.tid] = (f32x2){1.0f / sqrtf(qa * (1.0f / 512.f) + EPS), 1.0f / sqrtf(qb * (1.0f / 512.f) + EPS)}; }
          __syncthreads(); }
        EpiOut E{(bf16_t*)(ws + WS_X1B), (const LAS f32x2*)rowtab};
        pg8::gemm_phase<EpiOut, pg8::DenseOrder, false, false, true>(F.lds, DM, S, E);
    }
    }
    SEAM(3);
    if (IN(4)) { REFRESH_IDS(); p4_router(F); }
    SEAM(4);
    for (int rep = 0; rep < 1 + ((REPEAT_MASK >> 5) & 1); ++rep) { if (rep) xcd_barrier(bar);
    if (IN(5)) {
        REFRESH_IDS(); build_tile_table(F, tb);
        MoeOrder S{(const char*)(ws + WS_X1B), (const char*)(ws + WS_WGU), tb, (const unsigned*)(F.ctl + CW_CNT), (const unsigned*)(ws + WS_LIST), DM, (size_t)DM * DM * 2, (size_t)DM * 2, F.G, (int)blockIdx.x, true};
        EpiG1 E{(bf16_t*)(ws + WS_H), (const float*)(ws + WS_R2), (const unsigned*)(ws + WS_LIST)};
        pg8::gemm_phase<EpiG1, MoeOrder, true, true, false>(F.lds, DM, S, E);
        { REFRESH_IDS();
          const int nwg = tb[NEXP] * 4, G = F.G, c = (int)blockIdx.x;
          const int maxnu = (nwg + G - 1) / G, nu = (nwg - c + G - 1) / G;
          const int nfull = nwg - (maxnu - 1) * G;
          const bool all = (nfull >= G);
          const int W = all ? G : G - nfull, rank = all ? c : c - nfull;
          if (all || nu < maxnu) { LAS float* scr = (LAS float*)(F.lds + F.wave * 16384); tr_stream(F, scr, rank * NWAVES + F.wave, W * NWAVES, TI_DOWN, TI_DOWN_BASE); } }
    }
    }
    SEAM(5);
    for (int rep = 0; rep < 1 + ((REPEAT_MASK >> 6) & 1); ++rep) { if (rep) xcd_barrier(bar);
    if (IN(6)) {
        REFRESH_IDS(); build_tile_table(F, tb);
        MoeOrder S{(const char*)(ws + WS_H), (const char*)(ws + WS_WD), tb, (const unsigned*)(F.ctl + CW_CNT), (const unsigned*)(ws + WS_LIST), DEXP, (size_t)DM * DEXP * 2, (size_t)DEXP * 2, F.G, (int)blockIdx.x, false};
        EpiG2 E{(bf16_t*)(ws + WS_Y), (const unsigned*)(ws + WS_LIST)};
        pg8::gemm_phase<EpiG2, MoeOrder, true, false, false>(F.lds, DEXP, S, E);
    }
    }
    SEAM(6);
    if (IN(7)) { REFRESH_IDS(); p7_combine(F); }
    SEAM(7);
    if (IN(8)) {
        pg8::DenseOrder S{(const char*)(ws + WS_X2B), (const char*)(ws + WS_WPG), T / 256, DM / 256, DM, F.G, (int)blockIdx.x};
        REFRESH_IDS();
        { pg8::Unit u0; if (S.next(0, u0) && F.tid < 256) {
              const int row = u0.pm * 256 + F.tid; const f32x4* sp = (const f32x4*)((const float*)(ws + WS_SSQP) + (size_t)row * 16); const f32x4 s0 = sp[0], s1 = sp[1], s2 = sp[2], s3 = sp[3];
              const float q = (((s0[0] + s0[1]) + (s0[2] + s0[3])) + ((s1[0] + s1[1]) + (s1[2] + s1[3]))) + (((s2[0] + s2[1]) + (s2[2] + s2[3])) + ((s3[0] + s3[1]) + (s3[2] + s3[3])));
              rowtab[F.tid] = (f32x2){((const float*)(ws + WS_R3))[row], 1.0f / sqrtf(q * (1.0f / DM) + EPS)}; }
          __syncthreads(); }
        EpiFinal E{F.out, (const bf16_t*)(ws + WS_X2B), (const bf16_t*)(ws + WS_PRAW), FIN(I_PLE_ON), (const LAS f32x2*)rowtab};
        pg8::gemm_phase<EpiFinal, pg8::DenseOrder, false, false, false>(F.lds, DM, S, E);
    }
#undef IN
#undef SEAM
}

extern "C" void kernel_launch(void* const* d_in, const int* in_sizes, int n_in, void* d_out, int out_size, void* d_ws, size_t ws_size, hipStream_t stream) {
    static int grid = 0;
    if (grid == 0) {
        if (n_in != 25 || in_sizes[0] != T * DM || out_size != T * DM || ws_size < WS_END) { fprintf(stderr, "kernel_launch: unexpected shapes (n_in %d, in0 %d, out %d, ws %zu)\n", n_in, n_in > 0 ? in_sizes[0] : -1, out_size, ws_size); grid = -1; return; }
        int dev = 0, cus = 0, per_cu = 0;
        if (hipGetDevice(&dev) != hipSuccess || hipDeviceGetAttribute(&cus, hipDeviceAttributeMultiprocessorCount, dev) != hipSuccess) { grid = -1; return; }
        if (hipFuncSetAttribute((const void*)hymba_fwd, hipFuncAttributeMaxDynamicSharedMemorySize, LDS_BYTES) != hipSuccess) { fprintf(stderr, "kernel_launch: hipFuncSetAttribute failed\n"); grid = -1; return; }
        if (hipOccupancyMaxActiveBlocksPerMultiprocessor(&per_cu, (const void*)hymba_fwd, NTHREADS, LDS_BYTES) != hipSuccess || per_cu < 1) { fprintf(stderr, "kernel_launch: occupancy query says %d\n", per_cu); per_cu = 1; }
        (void)hipGetLastError();
        grid = cus;
        if (grid != 256) { fprintf(stderr, "kernel_launch: %d CUs; this kernel is built for 256 (one 256x256 tile per workgroup in the N=1024 GEMM phases)\n", grid); grid = -1; return; }
    }
    if (grid < 0) return;
    (void)hipMemsetAsync((char*)d_ws + WS_CTL, 0, CTL_ZERO_BYTES, stream);
    Args a{};
    for (int i = 0; i < 25; ++i) a.in[i] = (const float*)d_in[i];
    a.out = (float*)d_out; a.ws = (unsigned char*)d_ws;
    constexpr int NPH = 9;
    for (int li = 0; li < MK_N_LAUNCHES; ++li) {
        a.ph_lo = (MK_N_LAUNCHES == NPH) ? li : 0; a.ph_hi = (MK_N_LAUNCHES == NPH) ? li + 1 : NPH; a.li = li;
        hipLaunchKernelGGL(hymba_fwd, dim3(grid), dim3(NTHREADS), LDS_BYTES, stream, a);
    }
}
```

```cpp
#include <hip/hip_runtime.h>
#include <cstdio>
#include <cstdint>

#ifndef MK_N_LAUNCHES
#define MK_N_LAUNCHES 1
#endif

#ifndef REPEAT_MASK
#define REPEAT_MASK 0
#endif
#define LAS __attribute__((address_space(3)))
#define GAS __attribute__((address_space(1)))
typedef unsigned short bf16_t;
typedef short bf16x8 __attribute__((ext_vector_type(8)));
typedef float f32x4 __attribute__((ext_vector_type(4)));
typedef float f32x2 __attribute__((ext_vector_type(2)));
typedef unsigned u32x4 __attribute__((ext_vector_type(4)));
typedef unsigned u32x2 __attribute__((ext_vector_type(2)));

constexpr int BATCH = 8, SEQ = 2048, DM = 1024, T = BATCH * SEQ;
constexpr int INW = 1536, NHQ = 16, HD = 64;
constexpr int NEXP = 32, DEXP = 512, PLE = 256;
constexpr int MAXTILES = 160;
constexpr float EPS = 1e-6f;
constexpr float LOG2E = 1.4426950408889634f;
constexpr float QSCALE = 0.125f * LOG2E;
constexpr int NWAVES = 8, NTHREADS = 512;

constexpr int C_QA = 0, C_KA = 512, C_VA = 640, C_QB = 768, C_KB = 1280, C_VB = 1408;

constexpr size_t KiB = 1024, MiB = 1u << 20;
constexpr size_t WS_CTL = 0, CTL_ZERO_BYTES = 1 * MiB;
constexpr size_t WS_RS1 = 1 * MiB, WS_R2 = WS_RS1 + 64 * KiB, WS_R3 = WS_R2 + 64 * KiB, WS_KMP = WS_R3 + 64 * KiB;
constexpr size_t WS_WR = WS_KMP + 64 * KiB;
constexpr size_t WS_BIAS = WS_WR + 192 * KiB;
constexpr size_t WS_TOK = 1 * MiB + 512 * KiB;
constexpr size_t WS_SSQ = 2 * MiB;
constexpr size_t WS_SSQP = 3 * MiB;
constexpr size_t WS_LIST = 4 * MiB;
constexpr size_t WS_WIN = 8 * MiB, WS_WOUT = 11 * MiB, WS_WPG = 13 * MiB, WS_WPP = 15 * MiB;
constexpr size_t WS_WGU = 16 * MiB;
constexpr size_t WS_WD = 80 * MiB;
constexpr size_t WS_PRAW = 112 * MiB;
constexpr size_t WS_X1B = 144 * MiB;
constexpr size_t WS_X2B = WS_X1B;
constexpr size_t WS_H = 176 * MiB;
constexpr size_t WS_Y = 216 * MiB;
constexpr size_t WS_QKV = 176 * MiB;
constexpr size_t WS_O = 224 * MiB;
constexpr size_t WS_PB = 240 * MiB;
constexpr size_t WS_XB = WS_X1B;
constexpr size_t WS_END = 280 * MiB;
constexpr int CW_CNT = 64;
constexpr int CW_BAR = 4096;

constexpr int RING_BYTES = 131072;
constexpr int MISC_OFF = 147456;
constexpr int LDS_BYTES = 163840;

__device__ __forceinline__ unsigned f2bf(float f) { unsigned u = __builtin_bit_cast(unsigned, f); return (u + 0x7fffu + ((u >> 16) & 1u)) >> 16; }
__device__ __forceinline__ unsigned pk2(float lo, float hi) { return f2bf(lo) | (f2bf(hi) << 16); }
__device__ __forceinline__ float bf2f(unsigned short h) { return __builtin_bit_cast(float, (unsigned)h << 16); }
__device__ __forceinline__ float bflo(unsigned w) { return __builtin_bit_cast(float, w << 16); }
__device__ __forceinline__ float bfhi(unsigned w) { return __builtin_bit_cast(float, w & 0xffff0000u); }
__device__ __forceinline__ float wave_sum(float v) {
#pragma unroll
    for (int o = 1; o < 64; o <<= 1) v += __shfl_xor(v, o);
    return v;
}
__device__ __forceinline__ float wave_max(float v) {
#pragma unroll
    for (int o = 1; o < 64; o <<= 1) v = fmaxf(v, __shfl_xor(v, o));
    return v;
}
#define LDS_WAIT() asm volatile("s_waitcnt lgkmcnt(0)" ::: "memory")
#define VM_WAIT() asm volatile("s_waitcnt vmcnt(0)" ::: "memory")

namespace pg8 {
constexpr int BM = 256, BK = 64, HALF = 128, HTB = HALF * BK * 2, STAGE_BYTES = 8 * HTB, NXCD = 8, WGM = 8;
__host__ __device__ __forceinline__ int lds_byte(int r, int c) { const int st = (r >> 4) * 2 + (c >> 5), rr = r & 15, cc = c & 31, ob = rr * 64 + cc * 2; return st * 1024 + (ob ^ (((ob >> 9) & 1) << 5)); }
__host__ __device__ __forceinline__ void stage_rc(int b, int& R, int& C) { const int st = b / 1024, sb = b % 1024, swz = sb ^ (((sb >> 9) & 1) << 5); R = (st >> 1) * 16 + swz / 64; C = (st & 1) * 32 + (swz % 64) / 2; }
__host__ __device__ __forceinline__ int perm32(int rho) { const int n = rho >> 4, i = rho & 15; return 8 * (i >> 2) + 4 * n + (i & 3); }

struct Unit { const char* A; const char* B; int pm, pn, e, nvalid; };

__device__ __forceinline__ bool static_tile(int i, int G, int c, int nM, int nN, int& pm, int& pn) {
    const int nwg = nM * nN; const long L = (long)i * G + c; if (L >= nwg) return false;
    int wgid = (int)L; { const int q = nwg / NXCD, r = nwg % NXCD, xcd = wgid % NXCD, off = wgid / NXCD; wgid = (xcd < r ? xcd * (q + 1) : r * (q + 1) + (xcd - r) * q) + off; }
    const int nig = WGM * nN, gid = wgid / nig, fm = gid * WGM, gsz = (nM - fm) < WGM ? (nM - fm) : WGM;
    pm = fm + ((wgid % nig) % gsz); pn = (wgid % nig) / gsz; return true;
}
struct DenseOrder {
    const char* A; const char* Bt; int nM, nN, K, G, c;
    __device__ __forceinline__ bool next(int i, Unit& u) const {
        int pm, pn; if (!static_tile(i, G, c, nM, nN, pm, pn)) return false;
        u.pm = pm; u.pn = pn; u.e = 0; u.nvalid = 256; u.A = A + (size_t)pm * 256 * K * 2; u.B = Bt + (size_t)pn * 256 * K * 2; return true;
    }
    __device__ __forceinline__ unsigned row_off(const Unit&, int) const { return 0u; }
};

__device__ __forceinline__ unsigned cvt_pk_bf16(float lo, float hi) { unsigned r; asm volatile("v_cvt_pk_bf16_f32 %0, %1, %2" : "=v"(r) : "v"(lo), "v"(hi)); return r; }

template <class Epi, class Sched, bool ALIGN_EPI, bool GATHER, bool MID>
__device__ __forceinline__ void gemm_phase(LAS unsigned char* lds, const int K, const Sched& S, const Epi& E) {
    int tid_ = threadIdx.x; asm volatile("" : "+v"(tid_));
    const int tid = tid_, wid = __builtin_amdgcn_readfirstlane(tid >> 6), lane = tid & 63, wr = wid >> 2, wc = wid & 3, fr = lane & 15, fq = lane >> 4;
    const int nt = K / BK;
    int Rst[2], Cst[2]; unsigned voffB[2];
#pragma unroll
    for (int i = 0; i < 2; ++i) { int R, C; stage_rc(tid * 16 + i * 8192, R, C); Rst[i] = R; Cst[i] = C; const int Rb = Epi::PERM ? ((R & ~31) + perm32(R & 31)) : R; voffB[i] = (unsigned)(Rb * K + C) * 2u; }
    const size_t kstep = (size_t)(BK * 2);
    const size_t hstep = (size_t)HALF * K * 2;
    const unsigned ldsw = (unsigned)wid * 1024u;
    const int aoff = lds_byte(wr * 64 + fr, fq * 8), boff = lds_byte(wc * 32 + fr, fq * 8);
#define PG8_SA(b, h) (((b) * 2 + (h)) * HTB)
#define PG8_SB(b, h) ((4 + (b) * 2 + (h)) * HTB)
#define PG8_STAGE(bufoff, gbase, voff) do { _Pragma("unroll") for (int _i = 0; _i < 2; ++_i) \
        __builtin_amdgcn_global_load_lds((const unsigned*)((const char*)(gbase) + (voff)[_i]), (LAS unsigned*)(lds + (bufoff) + ldsw + _i * 8192), 16, 0, 0); } while (0)
#define PG8_LDA(dst, b, h) do { _Pragma("unroll") for (int m = 0; m < 4; ++m) _Pragma("unroll") for (int k = 0; k < 2; ++k) dst[m][k] = *(const LAS bf16x8*)(lds + PG8_SA(b, h) + aoff + m * 2048 + k * 1024); } while (0)
#define PG8_LDB(dst, b, h) do { _Pragma("unroll") for (int n = 0; n < 2; ++n) _Pragma("unroll") for (int k = 0; k < 2; ++k) dst[n][k] = *(const LAS bf16x8*)(lds + PG8_SB(b, h) + boff + n * 2048 + k * 1024); } while (0)
#define PG8_MMA(ai, bj, At, Bt) do { __builtin_amdgcn_s_setprio(1); _Pragma("unroll") for (int m = 0; m < 4; ++m) _Pragma("unroll") for (int n = 0; n < 2; ++n) _Pragma("unroll") for (int k = 0; k < 2; ++k) \
        acc[ai][bj][m][n] = __builtin_amdgcn_mfma_f32_16x16x32_bf16(Bt[n][k], At[m][k], acc[ai][bj][m][n], 0, 0, 0); __builtin_amdgcn_s_setprio(0); } while (0)
#define PG8_WAIT_V(n) asm volatile("s_waitcnt vmcnt(" #n ")" ::: "memory")
#define PG8_WAIT_L(n) asm volatile("s_waitcnt lgkmcnt(" #n ")" ::: "memory")
#define PG8_BAR __builtin_amdgcn_s_barrier()
#define PG8_SCHED __builtin_amdgcn_sched_barrier(0)
#define PG8_AOFFS(dst, u) do { _Pragma("unroll") for (int _h = 0; _h < 2; ++_h) _Pragma("unroll") for (int _i = 0; _i < 2; ++_i) { \
        if constexpr (GATHER) dst[_h][_i] = S.row_off(u, _h * HALF + Rst[_i]) + (unsigned)Cst[_i] * 2u; \
        else dst[_h][_i] = (unsigned)((_h * HALF + Rst[_i]) * K + Cst[_i]) * 2u; } \
        if constexpr (GATHER) { asm volatile("" : "+v"(dst[0][0]), "+v"(dst[0][1]), "+v"(dst[1][0]), "+v"(dst[1][1]) :: "memory"); } } while (0)
    Unit cur, nxt; int ui = 0;
    if (!S.next(0, cur)) return;
    bool has_next = S.next(1, nxt);
    unsigned vA[2][2], vN[2][2];
    PG8_AOFFS(vA, cur);
    if constexpr (GATHER) { if (has_next) { PG8_AOFFS(vN, nxt); } else {
#pragma unroll
        for (int h = 0; h < 2; ++h) { vN[h][0] = vA[h][0]; vN[h][1] = vA[h][1]; } } }
    f32x4 acc[2][2][4][2];
#pragma unroll
    for (int a = 0; a < 2; ++a)
#pragma unroll
        for (int b = 0; b < 2; ++b)
#pragma unroll
            for (int m = 0; m < 4; ++m)
#pragma unroll
                for (int n = 0; n < 2; ++n) acc[a][b][m][n] = (f32x4){0.f, 0.f, 0.f, 0.f};
    bf16x8 At[4][2], B0[2][2], B1[2][2];
    const char* cA = cur.A; const char* cB = cur.B;
    PG8_STAGE(PG8_SB(0, 0), cB, voffB); PG8_STAGE(PG8_SB(0, 1), cB + hstep, voffB); PG8_STAGE(PG8_SA(0, 0), cA, vA[0]); PG8_STAGE(PG8_SA(0, 1), cA, vA[1]);
    if (wr == 1) PG8_BAR;
    PG8_WAIT_V(2); PG8_BAR;
    PG8_STAGE(PG8_SB(1, 0), cB + kstep, voffB); PG8_STAGE(PG8_SA(1, 0), cA + kstep, vA[0]); PG8_STAGE(PG8_SB(1, 1), cB + hstep + kstep, voffB);
    PG8_WAIT_V(6); PG8_BAR;
    for (;;) {
        const char* nA = has_next ? nxt.A : cA; const char* nB = has_next ? nxt.B : cB;
#pragma unroll 1
        for (int t = 0; t < nt; t += 2) {
            const bool last = (t == nt - 2);
            if constexpr (MID) { if (t == nt / 2) { int frE = fr, fqE = fq; asm volatile("" : "+v"(frE), "+v"(fqE)); E.mid(acc, cur, wr, wc, frE, fqE); } }
            const char* a1 = cA + (size_t)(t + 1) * kstep;
            const char* a2 = last ? nA : cA + (size_t)(t + 2) * kstep; const char* b2 = last ? nB : cB + (size_t)(t + 2) * kstep;
            const char* a3 = a2 + kstep; const char* b3 = b2 + kstep;
            unsigned v2[2][2];
#pragma unroll
            for (int h = 0; h < 2; ++h) { if constexpr (GATHER) { v2[h][0] = last ? vN[h][0] : vA[h][0]; v2[h][1] = last ? vN[h][1] : vA[h][1]; } else { v2[h][0] = vA[h][0]; v2[h][1] = vA[h][1]; } }
            PG8_LDB(B0, 0, 0); PG8_LDB(B1, 0, 1); PG8_SCHED; PG8_LDA(At, 0, 0); PG8_STAGE(PG8_SA(1, 1), a1, vA[1]);
            PG8_WAIT_V(8); PG8_WAIT_L(0); PG8_BAR; PG8_MMA(0, 0, At, B0); PG8_MMA(0, 1, At, B1); PG8_BAR; PG8_SCHED;
            PG8_LDA(At, 0, 1); PG8_STAGE(PG8_SB(0, 0), b2, voffB); PG8_STAGE(PG8_SB(0, 1), b2 + hstep, voffB); PG8_STAGE(PG8_SA(0, 0), a2, v2[0]);
            PG8_WAIT_V(8); PG8_WAIT_L(0); PG8_BAR; PG8_MMA(1, 0, At, B0); PG8_MMA(1, 1, At, B1); PG8_BAR; PG8_SCHED;
            PG8_LDB(B0, 1, 0); PG8_LDB(B1, 1, 1); PG8_SCHED; PG8_LDA(At, 1, 0); PG8_STAGE(PG8_SA(0, 1), a2, v2[1]);
            PG8_WAIT_V(8); PG8_WAIT_L(0); PG8_BAR; PG8_MMA(0, 0, At, B0); PG8_MMA(0, 1, At, B1); PG8_BAR; PG8_SCHED;
            PG8_LDA(At, 1, 1); PG8_STAGE(PG8_SB(1, 0), b3, voffB); PG8_STAGE(PG8_SB(1, 1), b3 + hstep, voffB); PG8_STAGE(PG8_SA(1, 0), a3, v2[0]);
            PG8_WAIT_V(8); PG8_WAIT_L(0); PG8_BAR; PG8_MMA(1, 0, At, B0); PG8_MMA(1, 1, At, B1); PG8_BAR; PG8_SCHED;
        }
        if constexpr (ALIGN_EPI) { if (wr == 0) PG8_BAR; }
        { int frE = fr, fqE = fq; asm volatile("" : "+v"(frE), "+v"(fqE));
          E(acc, cur, wr, wc, frE, fqE); }
        if (!has_next) break;
#pragma unroll
        for (int a = 0; a < 2; ++a)
#pragma unroll
            for (int b = 0; b < 2; ++b)
#pragma unroll
                for (int m = 0; m < 4; ++m)
#pragma unroll
                    for (int n = 0; n < 2; ++n) acc[a][b][m][n] = (f32x4){0.f, 0.f, 0.f, 0.f};
        cur = nxt; cA = nA; cB = nB; ++ui;
        if constexpr (GATHER) {
#pragma unroll
            for (int h = 0; h < 2; ++h) { vA[h][0] = vN[h][0]; vA[h][1] = vN[h][1]; } }
        has_next = S.next(ui + 1, nxt);
        if constexpr (GATHER) { if (has_next) { PG8_AOFFS(vN, nxt); } }
        if constexpr (ALIGN_EPI) { if (wr == 1) PG8_BAR; }
    }
    PG8_WAIT_V(0);
    if constexpr (!ALIGN_EPI) { if (wr == 0) PG8_BAR; }
    PG8_BAR;
#undef PG8_SA
#undef PG8_SB
#undef PG8_STAGE
#undef PG8_LDA
#undef PG8_LDB
#undef PG8_MMA
#undef PG8_WAIT_V
#undef PG8_WAIT_L
#undef PG8_BAR
#undef PG8_SCHED
#undef PG8_AOFFS
}
}

struct Args { const float* in[25]; float* out; unsigned char* ws; int ph_lo, ph_hi, li, pad; };
struct Frame {
    LAS unsigned char* lds; unsigned char* ws; GAS unsigned* ctl;
    int tid, lane, wave, vcu, G;
    float* out; const __attribute__((address_space(4))) char* ka;
};
#define FIN(i) (((const float* const __attribute__((address_space(4)))*)F.ka)[i])
enum { I_X = 0, I_P, I_RELB, I_ATTN_NORM, I_W_IN, I_SWA_QN, I_SWA_KN, I_SINKS, I_MOBA_QN, I_MOBA_KN, I_SWA_ON, I_MOBA_ON, I_W_OUT, I_FFN_NORM,
       I_W_RG, I_B_RG, I_W_RE, I_B_RE, I_W_EG, I_W_EU, I_W_ED, I_PLE_NORM, I_W_PG, I_W_PP, I_PLE_ON };

struct TrItem { const float* src; bf16_t* dst; const float* gk; int N, K; };
__device__ __forceinline__ int map_in(int n0) { const int head = n0 >> 6, d = n0 & 63; return 256 * (head >> 2) + 128 * (d >> 5) + 32 * (head & 3) + (d & 31); }
__device__ __forceinline__ int map_gu(int n0, int up) { return 256 * (n0 >> 7) + 128 * up + (n0 & 127); }
constexpr int TI_IN = (DM / 64) * (INW / 32), TI_OUT = (DM / 64) * (DM / 32), TI_PG = TI_OUT, TI_PP = (PLE / 64) * (DM / 32);
constexpr int TI_G1 = (DM / 64) * (DEXP / 32), TI_D1 = (DEXP / 64) * (DM / 32);
constexpr int TI_TOTAL = TI_IN + TI_OUT + TI_PG + TI_PP + NEXP * (2 * TI_G1);
constexpr int TI_DOWN_BASE = 1 << 20, TI_DOWN = NEXP * TI_D1;
__device__ __forceinline__ void tr_decode(const Frame& F, int it, TrItem& d) {
    unsigned char* ws = F.ws;
    const float* W; bf16_t* WT; const float* g = nullptr; int K, N, mode = 0, up = 0; int r = it;
    if (it >= TI_DOWN_BASE) r = 1 << 28;
    if (r < TI_IN) { W = FIN(I_W_IN); WT = (bf16_t*)(ws + WS_WIN); K = DM; N = INW; g = FIN(I_ATTN_NORM); mode = 1; }
    else if ((r -= TI_IN) < TI_OUT) { W = FIN(I_W_OUT); WT = (bf16_t*)(ws + WS_WOUT); K = DM; N = DM; mode = 3; }
    else if ((r -= TI_OUT) < TI_PG) { W = FIN(I_W_PG); WT = (bf16_t*)(ws + WS_WPG); K = DM; N = DM; g = FIN(I_PLE_NORM); }
    else if ((r -= TI_PG) < TI_PP) { W = FIN(I_W_PP); WT = (bf16_t*)(ws + WS_WPP); K = PLE; N = DM; }
    else if (it >= TI_DOWN_BASE) { r = it - TI_DOWN_BASE; const int e = r / TI_D1; r -= e * TI_D1; W = FIN(I_W_ED) + (size_t)e * DEXP * DM; WT = (bf16_t*)(ws + WS_WD) + (size_t)e * DM * DEXP; K = DEXP; N = DM; }
    else { r -= TI_PP; const int e = r / (2 * TI_G1); r -= e * (2 * TI_G1);
        if (r < TI_G1) { W = FIN(I_W_EG) + (size_t)e * DM * DEXP; WT = (bf16_t*)(ws + WS_WGU) + (size_t)e * DM * DM; K = DM; N = DEXP; g = FIN(I_FFN_NORM); mode = 2; up = 0; }
        else { r -= TI_G1; W = FIN(I_W_EU) + (size_t)e * DM * DEXP; WT = (bf16_t*)(ws + WS_WGU) + (size_t)e * DM * DM; K = DM; N = DEXP; g = FIN(I_FFN_NORM); mode = 2; up = 1; } }
    const int nblk = N / 32, kb = r / nblk, nb = r % nblk, k0 = 64 * kb, n0 = 32 * nb;
    if (mode == 3) g = (k0 < 512) ? FIN(I_SWA_ON) : (FIN(I_MOBA_ON) - 512);
    const int drow0 = mode == 1 ? map_in(n0) : mode == 2 ? map_gu(n0, up) : n0;
    d.src = W + (size_t)k0 * N + n0; d.dst = WT + (size_t)drow0 * K + k0; d.gk = g ? g + k0 : nullptr; d.N = N; d.K = K;
}
__device__ __forceinline__ void tr_load(const TrItem& d, int lane, float (&v)[32], f32x4 (&gv)[2]) {
    const float* p = d.src + (size_t)(lane >> 5) * d.N + (lane & 31);
#pragma unroll
    for (int i = 0; i < 32; ++i) v[i] = __builtin_nontemporal_load(p + (size_t)(2 * i) * d.N);
    const int c = lane & 7;
    if (d.gk) { gv[0] = *(const f32x4*)(d.gk + 8 * c); gv[1] = *(const f32x4*)(d.gk + 8 * c + 4); } else { gv[0] = (f32x4){1.f, 1.f, 1.f, 1.f}; gv[1] = gv[0]; }
}
__device__ __forceinline__ void tr_process(const TrItem& d, int lane, const float (&v)[32], const f32x4 (&gv)[2], LAS float* scr) {
#pragma unroll
    for (int i = 0; i < 32; ++i) scr[(2 * i + (lane >> 5)) * 33 + (lane & 31)] = v[i];
    LDS_WAIT(); asm volatile("" ::: "memory");
    const int c = lane & 7;
#pragma unroll
    for (int j = 0; j < 4; ++j) { const int n = (lane >> 3) + 8 * j; const LAS float* sp = scr + (8 * c) * 33 + n;
        u32x4 o; o.x = pk2(sp[0 * 33] * gv[0][0], sp[1 * 33] * gv[0][1]); o.y = pk2(sp[2 * 33] * gv[0][2], sp[3 * 33] * gv[0][3]); o.z = pk2(sp[4 * 33] * gv[1][0], sp[5 * 33] * gv[1][1]); o.w = pk2(sp[6 * 33] * gv[1][2], sp[7 * 33] * gv[1][3]);
        *(GAS u32x4*)(d.dst + (size_t)n * d.K + 8 * c) = o; }
    LDS_WAIT(); asm volatile("" ::: "memory");
}

__constant__ unsigned char c_bucket[128] = {0,1,2,3,4,5,6,7,8,9,10,11,12,13,14,15,16,16,16,17,17,18,18,18,19,19,19,20,20,20,20,21,21,21,21,22,22,22,22,22,23,23,23,23,23,23,24,24,24,24,24,24,25,25,25,25,25,25,25,26,26,26,26,26,26,26,26,27,27,27,27,27,27,27,27,27,27,28,28,28,28,28,28,28,28,28,28,29,29,29,29,29,29,29,29,29,29,29,29,30,30,30,30,30,30,30,30,30,30,30,30,30,30,31,31,31,31,31,31,31,31,31,31,31,31,31,31,31};

__device__ __forceinline__ void tr_stream(Frame& F, LAS float* scr, int first, int step, int count, int base) {
    TrItem cur, nxt; float v[32], vn[32]; f32x4 gv[2], gn[2];
    int it = first; bool have = it < count;
    if (have) { tr_decode(F, base + it, cur); tr_load(cur, F.lane, v, gv); }
    while (have) {
        const int itn = it + step; const bool hn = itn < count;
        if (hn) { tr_decode(F, base + itn, nxt); tr_load(nxt, F.lane, vn, gn); }
        tr_process(cur, F.lane, v, gv, scr);
        cur = nxt; gv[0] = gn[0]; gv[1] = gn[1];
#pragma unroll
        for (int i = 0; i < 32; ++i) v[i] = vn[i];
        it = itn; have = hn;
    }
}
__device__ __forceinline__ void p0_prologue(Frame& F) {
    LAS float* scr = (LAS float*)(F.lds + F.wave * 16384);
    const int gw = F.vcu * NWAVES + F.wave, NGW = F.G * NWAVES;
    tr_stream(F, scr, gw, NGW, TI_TOTAL, 0);
    const float* x = FIN(I_X); bf16_t* xb = (bf16_t*)(F.ws + WS_XB); float* rs1 = (float*)(F.ws + WS_RS1);
    for (int m = gw; m < T; m += 2 * NGW) {
        const int m2 = m + NGW; const bool h2 = m2 < T;
        const GAS f32x4* xr = (const GAS f32x4*)(x + (size_t)m * DM) + F.lane; const GAS f32x4* xr2 = (const GAS f32x4*)(x + (size_t)(h2 ? m2 : m) * DM) + F.lane;
        f32x4 v[4], u[4]; float s = 0.f, s2 = 0.f;
#pragma unroll
        for (int j = 0; j < 4; ++j) { v[j] = __builtin_nontemporal_load(xr + 64 * j); u[j] = __builtin_nontemporal_load(xr2 + 64 * j); }
#pragma unroll
        for (int j = 0; j < 4; ++j) { s += (v[j].x * v[j].x + v[j].y * v[j].y) + (v[j].z * v[j].z + v[j].w * v[j].w); s2 += (u[j].x * u[j].x + u[j].y * u[j].y) + (u[j].z * u[j].z + u[j].w * u[j].w); }
        s = wave_sum(s); s2 = wave_sum(s2);
        GAS u32x2* o8 = (GAS u32x2*)(xb + (size_t)m * DM) + F.lane;
#pragma unroll
        for (int j = 0; j < 4; ++j) { u32x2 w; w.x = pk2(v[j].x, v[j].y); w.y = pk2(v[j].z, v[j].w); o8[64 * j] = w; }
        if (F.lane == 0) rs1[m] = 1.0f / sqrtf(s * (1.0f / DM) + EPS);
        if (h2) { GAS u32x2* o9 = (GAS u32x2*)(xb + (size_t)m2 * DM) + F.lane;
#pragma unroll
            for (int j = 0; j < 4; ++j) { u32x2 w; w.x = pk2(u[j].x, u[j].y); w.y = pk2(u[j].z, u[j].w); o9[64 * j] = w; }
            if (F.lane == 0) rs1[m2] = 1.0f / sqrtf(s2 * (1.0f / DM) + EPS); }
    }
    { const GAS f32x4* p4 = (const GAS f32x4*)FIN(I_P); GAS u32x2* o = (GAS u32x2*)(F.ws + WS_PB); const int n4 = T * PLE / 4;
      for (int i = (F.vcu * NTHREADS + F.tid); i < n4; i += F.G * NTHREADS) { const f32x4 v = __builtin_nontemporal_load(p4 + i); u32x2 w; w.x = pk2(v.x, v.y); w.y = pk2(v.z, v.w); o[i] = w; } }
    { bf16_t* Wt = (bf16_t*)(F.ws + WS_WR); const float* g = FIN(I_FFN_NORM); const float* wrg = FIN(I_W_RG); const float* wre = FIN(I_W_RE);
      for (int i = (F.vcu * NTHREADS + F.tid); i < 96 * DM; i += F.G * NTHREADS) { const int n = i / DM, c = i % DM; int o = -1; bool lo = false;
          if (n < 32) o = n; else if (n < 64) { o = n - 32; lo = true; } else if (n < 68) o = 32 + (n - 64); else if (n < 72) { o = 32 + (n - 68); lo = true; }
          unsigned short r = 0;
          if (o >= 0) { const float w = g[c] * ((o < 4) ? wrg[c * 4 + o] : wre[c * 32 + (o - 4)]); const unsigned h = f2bf(w); r = (unsigned short)h;
              if (lo) r = (unsigned short)f2bf(w - bf2f((unsigned short)h)); }
          Wt[i] = r; } }
    { float* tab = (float*)(F.ws + WS_BIAS);
      for (int i = (F.vcu * NTHREADS + F.tid); i < 16 * 132; i += F.G * NTHREADS) { const int hh = i / 132, dd = i % 132; const int bk = dd < 128 ? (int)c_bucket[dd] : 31;
          tab[i] = FIN(I_RELB)[bk * NHQ + hh] * LOG2E; }
    { float* lg = (float*)(F.ws + WS_BIAS + 16 * KiB); const float* rb = FIN(I_RELB);
      for (int i = (F.vcu * NTHREADS + F.tid); i < 16 * 640; i += F.G * NTHREADS) { const int hh = i / 640, e = i % 640, dist = 383 - e; float v;
          if (dist < 0 || e >= 639) v = -1e30f; else if (dist < 128) v = (rb[(int)c_bucket[dist] * NHQ + hh] - (hh >= 8 ? rb[31 * NHQ + hh] : 0.f)) * LOG2E; else v = hh >= 8 ? 0.f : -1e30f;
          lg[i] = v; } }
}
}

using pg8::Unit;
struct EpiQKV {
    static constexpr bool PERM = true;
    bf16_t* qkv; const float* rs1; const float* gq_a; const float* gk_a; const float* gq_b; const float* gk_b; float* kmp;
    __device__ __forceinline__ void operator()(const f32x4 (&acc)[2][2][4][2], const Unit& u, int wr, int wc, int fr, int fq) const {
        const int head = 4 * u.pn + wc;
        const float* gain = nullptr; float qs = 1.f; bool kmean = false;
        if (head < 8) { gain = gq_a; qs = QSCALE; } else if (head < 10) { gain = gk_a; } else if (head < 12) {} else if (head < 20) { gain = gq_b; qs = QSCALE; } else if (head < 22) { gain = gk_b; kmean = true; }
        f32x4 gv[2][2];
#pragma unroll
        for (int bj = 0; bj < 2; ++bj)
#pragma unroll
            for (int n = 0; n < 2; ++n) { if (gain) { gv[bj][n] = *(const f32x4*)(gain + 32 * bj + 8 * fq + 4 * n) * qs; } else gv[bj][n] = (f32x4){1.f, 1.f, 1.f, 1.f}; }
        f32x4 ks[2][2];
#pragma unroll
        for (int bj = 0; bj < 2; ++bj)
#pragma unroll
            for (int n = 0; n < 2; ++n) ks[bj][n] = (f32x4){0.f, 0.f, 0.f, 0.f};
        float rsv[2][4];
#pragma unroll
        for (int ai = 0; ai < 2; ++ai)
#pragma unroll
            for (int m = 0; m < 4; ++m) rsv[ai][m] = rs1[u.pm * 256 + ai * 128 + wr * 64 + m * 16 + fr];
        asm volatile("" ::: "memory");
#pragma unroll
        for (int ai = 0; ai < 2; ++ai)
#pragma unroll
            for (int m = 0; m < 4; ++m) {
                const int row = u.pm * 256 + ai * 128 + wr * 64 + m * 16 + fr; const float rs = rsv[ai][m];
                f32x4 v[2][2]; float ss = 0.f;
#pragma unroll
                for (int bj = 0; bj < 2; ++bj)
#pragma unroll
                    for (int n = 0; n < 2; ++n) { v[bj][n] = acc[ai][bj][m][n] * rs; const f32x4 q = v[bj][n] * v[bj][n]; ss += (q[0] + q[1]) + (q[2] + q[3]); }
                float rn = 1.f;
                if (gain) { ss += __shfl_xor(ss, 16); ss += __shfl_xor(ss, 32); rn = 1.0f / sqrtf(ss * (1.0f / HD) + EPS); }
                bf16_t* rowp = qkv + (size_t)row * INW + 64 * head + 8 * fq;
#pragma unroll
                for (int bj = 0; bj < 2; ++bj) { const f32x4 v0 = v[bj][0] * rn * gv[bj][0], v1 = v[bj][1] * rn * gv[bj][1];
                    if (kmean) { ks[bj][0] += v0; ks[bj][1] += v1; }
                    u32x4 w; w.x = pg8::cvt_pk_bf16(v0[0], v0[1]); w.y = pg8::cvt_pk_bf16(v0[2], v0[3]); w.z = pg8::cvt_pk_bf16(v1[0], v1[1]); w.w = pg8::cvt_pk_bf16(v1[2], v1[3]);
                    *(u32x4*)(rowp + 32 * bj) = w; }
            }
        if (kmean) {
#pragma unroll
            for (int bj = 0; bj < 2; ++bj)
#pragma unroll
                for (int n = 0; n < 2; ++n)
#pragma unroll
                    for (int i = 0; i < 4; ++i) { float s = ks[bj][n][i]; s += __shfl_xor(s, 1); s += __shfl_xor(s, 2); s += __shfl_xor(s, 4); s += __shfl_xor(s, 8);
                        if (fr == 0) kmp[((u.pm * 2 + wr) * 2 + (head - 20)) * 64 + 32 * bj + 8 * fq + 4 * n + i] = s; }
        }
    }
};
struct EpiProj {
    static constexpr bool PERM = true;
    bf16_t* praw; float* ssqp;
    __device__ __forceinline__ void operator()(const f32x4 (&acc)[2][2][4][2], const Unit& u, int wr, int wc, int fr, int fq) const {
#pragma unroll
        for (int ai = 0; ai < 2; ++ai)
#pragma unroll
            for (int m = 0; m < 4; ++m) {
                const int row = u.pm * 256 + ai * 128 + wr * 64 + m * 16 + fr; float ss = 0.f;
                bf16_t* rowp = praw + (size_t)row * DM + u.pn * 256 + wc * 32 + 8 * fq;
#pragma unroll
                for (int bj = 0; bj < 2; ++bj) { const f32x4 v0 = acc[ai][bj][m][0], v1 = acc[ai][bj][m][1];
                    const f32x4 q = v0 * v0 + v1 * v1; ss += (q[0] + q[1]) + (q[2] + q[3]);
                    u32x4 w; w.x = pg8::cvt_pk_bf16(v0[0], v0[1]); w.y = pg8::cvt_pk_bf16(v0[2], v0[3]); w.z = pg8::cvt_pk_bf16(v1[0], v1[1]); w.w = pg8::cvt_pk_bf16(v1[2], v1[3]);
                    *(u32x4*)(rowp + 128 * bj) = w; }
                ss += __shfl_xor(ss, 16); ss += __shfl_xor(ss, 32);
                if (fq == 0) ssqp[(size_t)row * 16 + u.pn * 4 + wc] = ss;
            }
    }
};
struct EpiOut {
    static constexpr bool PERM = true;
    bf16_t* x1b; const LAS f32x2* tab;
    __device__ __forceinline__ void mid(f32x4 (&acc)[2][2][4][2], const Unit& u, int wr, int wc, int fr, int fq) const {
#pragma unroll
        for (int ai = 0; ai < 2; ++ai)
#pragma unroll
            for (int m = 0; m < 4; ++m) { const f32x2 sc = tab[ai * 128 + wr * 64 + m * 16 + fr]; const float r = sc.x / sc.y;
#pragma unroll
                for (int bj = 0; bj < 2; ++bj)
#pragma unroll
                    for (int n = 0; n < 2; ++n) acc[ai][bj][m][n] *= r; }
    }
    __device__ __forceinline__ void operator()(const f32x4 (&acc)[2][2][4][2], const Unit& u, int wr, int wc, int fr, int fq) const {
        const int col0 = u.pn * 256 + wc * 32 + 8 * fq;
#pragma unroll
        for (int ai = 0; ai < 2; ++ai) {
            u32x4 xv[4][2];
#pragma unroll
            for (int m = 0; m < 4; ++m) { const size_t off = (size_t)(u.pm * 256 + ai * 128 + wr * 64 + m * 16 + fr) * DM + col0;
#pragma unroll
                for (int bj = 0; bj < 2; ++bj) xv[m][bj] = *(const u32x4*)(x1b + off + bj * 128); }
            asm volatile("" ::: "memory");
#pragma unroll
            for (int m = 0; m < 4; ++m) { const int r = ai * 128 + wr * 64 + m * 16 + fr; const float sb = tab[r].y; const size_t off = (size_t)(u.pm * 256 + r) * DM + col0;
#pragma unroll
                for (int bj = 0; bj < 2; ++bj) { const u32x4 xw = xv[m][bj];
                    const f32x4 o0 = (f32x4){bflo(xw.x), bfhi(xw.x), bflo(xw.y), bfhi(xw.y)} + acc[ai][bj][m][0] * sb, o1 = (f32x4){bflo(xw.z), bfhi(xw.z), bflo(xw.w), bfhi(xw.w)} + acc[ai][bj][m][1] * sb;
                    u32x4 w; w.x = pg8::cvt_pk_bf16(o0[0], o0[1]); w.y = pg8::cvt_pk_bf16(o0[2], o0[3]); w.z = pg8::cvt_pk_bf16(o1[0], o1[1]); w.w = pg8::cvt_pk_bf16(o1[2], o1[3]);
                    *(u32x4*)(x1b + off + bj * 128) = w; } }
            asm volatile("" ::: "memory");
        }
    }
};
struct MoeOrder {
    const char* A; const char* Bt; const LAS int* tb; const unsigned* cnt; const unsigned* list; int K; size_t wstride; size_t arow_bytes; int G, c; bool gather;
    __device__ __forceinline__ bool next(int i, Unit& u) const {
        const int NT = tb[NEXP]; const int nwg = NT * 4; const long L = (long)i * G + c; if (L >= nwg) return false;
        int wgid = (int)L; { const int q = nwg / 8, r = nwg % 8, xcd = wgid % 8, off = wgid / 8; wgid = (xcd < r ? xcd * (q + 1) : r * (q + 1) + (xcd - r) * q) + off; }
        const int gt = wgid >> 2, pn = wgid & 3; int e = 0;
#pragma unroll 1
        while (e < NEXP - 1 && gt >= tb[e + 1]) ++e;
        const int lt = gt - tb[e]; const int nv = (int)cnt[e] - lt * 256;
        u.pm = gt; u.pn = pn; u.e = e * 16384 + lt * 256; u.nvalid = nv < 256 ? nv : 256;
        u.A = gather ? A : A + (size_t)gt * 256 * arow_bytes; u.B = Bt + (size_t)e * wstride + (size_t)pn * 256 * K * 2; return true;
    }
    __device__ __forceinline__ unsigned row_off(const Unit& u, int r) const {
        const unsigned ent = (r < u.nvalid) ? list[u.e + r] : 0u; return (ent >> 1) * (unsigned)arow_bytes;
    }
};
struct EpiG1 {
    static constexpr bool PERM = true;
    bf16_t* H; const float* r2; const unsigned* list;
    __device__ __forceinline__ void operator()(const f32x4 (&acc)[2][2][4][2], const Unit& u, int wr, int wc, int fr, int fq) const {
        unsigned entv[2][4]; float rsv[2][4];
#pragma unroll
        for (int ai = 0; ai < 2; ++ai)
#pragma unroll
            for (int m = 0; m < 4; ++m) { const int r = ai * 128 + wr * 64 + m * 16 + fr; entv[ai][m] = (r < u.nvalid) ? list[u.e + r] : 0u; }
#pragma unroll
        for (int ai = 0; ai < 2; ++ai)
#pragma unroll
            for (int m = 0; m < 4; ++m) rsv[ai][m] = r2[entv[ai][m] >> 1];
        asm volatile("" ::: "memory");
#pragma unroll
        for (int ai = 0; ai < 2; ++ai)
#pragma unroll
            for (int m = 0; m < 4; ++m) { const int r = ai * 128 + wr * 64 + m * 16 + fr; const float rs = rsv[ai][m];
                float h[8];
#pragma unroll
                for (int n = 0; n < 2; ++n)
#pragma unroll
                    for (int i = 0; i < 4; ++i) { const float g = acc[ai][0][m][n][i] * rs, up = acc[ai][1][m][n][i] * rs; h[4 * n + i] = g / (1.0f + __builtin_amdgcn_exp2f(-g * LOG2E)) * up; }
                u32x4 w; w.x = pg8::cvt_pk_bf16(h[0], h[1]); w.y = pg8::cvt_pk_bf16(h[2], h[3]); w.z = pg8::cvt_pk_bf16(h[4], h[5]); w.w = pg8::cvt_pk_bf16(h[6], h[7]);
                *(u32x4*)(H + (size_t)(u.pm * 256 + r) * DEXP + u.pn * 128 + wc * 32 + 8 * fq) = w; }
    }
};
struct EpiG2 {
    static constexpr bool PERM = true;
    bf16_t* Y; const unsigned* list;
    __device__ __forceinline__ void operator()(const f32x4 (&acc)[2][2][4][2], const Unit& u, int wr, int wc, int fr, int fq) const {
        unsigned entv[2][4];
#pragma unroll
        for (int ai = 0; ai < 2; ++ai)
#pragma unroll
            for (int m = 0; m < 4; ++m) { const int r = ai * 128 + wr * 64 + m * 16 + fr; entv[ai][m] = (r < u.nvalid) ? list[u.e + r] : 0u; }
        asm volatile("" ::: "memory");
#pragma unroll
        for (int ai = 0; ai < 2; ++ai)
#pragma unroll
            for (int m = 0; m < 4; ++m) { const int r = ai * 128 + wr * 64 + m * 16 + fr;
                if (r < u.nvalid) { const unsigned ent = entv[ai][m]; bf16_t* rowp = Y + (size_t)ent * DM + u.pn * 256 + wc * 32 + 8 * fq;
#pragma unroll
                    for (int bj = 0; bj < 2; ++bj) { const f32x4 v0 = acc[ai][bj][m][0], v1 = acc[ai][bj][m][1];
                        u32x4 w; w.x = pg8::cvt_pk_bf16(v0[0], v0[1]); w.y = pg8::cvt_pk_bf16(v0[2], v0[3]); w.z = pg8::cvt_pk_bf16(v1[0], v1[1]); w.w = pg8::cvt_pk_bf16(v1[2], v1[3]);
                        *(u32x4*)(rowp + 128 * bj) = w; } } }
    }
};
struct EpiFinal {
    static constexpr bool PERM = false;
    float* out; const bf16_t* x2b; const bf16_t* praw; const float* gout; const LAS f32x2* tab;
    __device__ __forceinline__ void operator()(const f32x4 (&acc)[2][2][4][2], const Unit& u, int wr, int wc, int fr, int fq) const {
        const int col0 = u.pn * 256 + wc * 32 + 4 * fq;
        f32x4 gv[2][2];
#pragma unroll
        for (int bj = 0; bj < 2; ++bj)
#pragma unroll
            for (int n = 0; n < 2; ++n) gv[bj][n] = *(const f32x4*)(gout + col0 + bj * 128 + n * 16);
#pragma unroll
        for (int am = 0; am < 4; ++am) { const int ai = am >> 1, mb = 2 * (am & 1);
            u32x2 xw[2][2][2], pw[2][2][2];
#pragma unroll
            for (int mm = 0; mm < 2; ++mm) { const size_t off = (size_t)(u.pm * 256 + ai * 128 + wr * 64 + (mb + mm) * 16 + fr) * DM + col0;
#pragma unroll
                for (int bj = 0; bj < 2; ++bj)
#pragma unroll
                    for (int n = 0; n < 2; ++n) { xw[mm][bj][n] = *(const u32x2*)(x2b + off + bj * 128 + n * 16); pw[mm][bj][n] = *(const u32x2*)(praw + off + bj * 128 + n * 16); } }
            asm volatile("" ::: "memory");
#pragma unroll
            for (int mm = 0; mm < 2; ++mm) { const int m = mb + mm; const int r = ai * 128 + wr * 64 + m * 16 + fr; const f32x2 sc = tab[r]; const size_t off = (size_t)(u.pm * 256 + r) * DM + col0;
#pragma unroll
                for (int bj = 0; bj < 2; ++bj)
#pragma unroll
                    for (int n = 0; n < 2; ++n) { const u32x2 a = xw[mm][bj][n], p = pw[mm][bj][n];
                        const f32x4 xv = (f32x4){bflo(a.x), bfhi(a.x), bflo(a.y), bfhi(a.y)}, pv = (f32x4){bflo(p.x), bfhi(p.x), bflo(p.y), bfhi(p.y)}; f32x4 o;
#pragma unroll
                        for (int i = 0; i < 4; ++i) { const float z = acc[ai][bj][m][n][i] * sc.x; const float sg = 1.0f / (1.0f + __builtin_amdgcn_exp2f(-z * LOG2E)); o[i] = xv[i] + sg * (pv[i] * sc.y * gv[bj][n][i]); }
                        *(f32x4*)(out + off + bj * 128 + n * 16) = o; }
                asm volatile("" ::: "memory"); }
        }
    }
};

namespace att {
typedef float f32x16 __attribute__((ext_vector_type(16)));
typedef short s16x4 __attribute__((ext_vector_type(4)));
constexpr int NSLOT = 6, KBUF = 0, VBUF = NSLOT * 8192, LUT_OFF = 2 * NSLOT * 8192, KM_OFF = LUT_OFF + 2048;
constexpr float NEGBIG = -1e30f, MFLOOR = -1e20f;
__device__ __forceinline__ s16x4 vtr(const LAS unsigned char* p) { return __builtin_bit_cast(s16x4, __builtin_amdgcn_ds_read_tr16_b64_v4i16((LAS s16x4*)p)); }
__device__ __forceinline__ unsigned pkbf(float lo, float hi) { f32x2 v = {lo, hi}; typedef __bf16 bf2 __attribute__((ext_vector_type(2))); bf2 b = __builtin_convertvector(v, bf2); return __builtin_bit_cast(unsigned, b); }

template <int TYPE>
__device__ __forceinline__ void attn_unit(Frame& F, int b, int hlp, int n) {
    const int tid = F.tid, lane = F.lane, w = F.wave, r32 = lane & 31, hi = lane >> 5;
    const int hl = TYPE ? hlp : 2 * hlp + (w >> 2);
    const int hh = TYPE * 8 + hl, g = hl >> 2;
    const int colQ = (TYPE ? C_QB : C_QA) + 64 * hl, colK = (TYPE ? C_KB : C_KA) + 64 * g, colV = (TYPE ? C_VB : C_VA) + 64 * g;
    const bf16_t* qkv = (const bf16_t*)(F.ws + WS_QKV); bf16_t* O = (bf16_t*)(F.ws + WS_O); float* ssq = (float*)(F.ws + WS_SSQ);
    const float* tab = (const float*)(F.ws + WS_BIAS); const float* kmp = (const float*)(F.ws + WS_KMP);
    const size_t rowb = (size_t)b * SEQ;
    LAS unsigned char* L = F.lds; LAS float* lut = (LAS float*)(L + LUT_OFF) + (TYPE ? 0 : 316 * (w >> 2)); LAS float* kml = (LAS float*)(L + KM_OFF);
    const int q0w = TYPE ? 256 * n + 32 * w : 128 * n + 32 * (w & 3);
    const int t_lo = TYPE ? 0 : (2 * n - 2 > 0 ? 2 * n - 2 : 0), t_hi = TYPE ? 4 * n + 3 : 2 * n + 1;
    __syncthreads();
    for (int e = tid; e < (TYPE ? 316 : 632); e += NTHREADS) { const int ti = TYPE ? e : e % 316, hx = TYPE ? hh : 2 * hlp + e / 316; const int dist = 221 - ti; float v;
        if (dist < 0) v = NEGBIG; else if (dist < 128) v = tab[hx * 132 + dist] - (TYPE ? tab[hx * 132 + 128] : 0.f); else v = TYPE ? 0.f : NEGBIG;
        ((LAS float*)(L + LUT_OFF))[e] = v; }
    if (TYPE) { const int nb = tid >> 6, d = tid & 63; float v = 0.f;
        if (nb < n) { const int pm = b * 8 + nb; v = kmp[((pm * 2 + 0) * 2 + g) * 64 + d] + kmp[((pm * 2 + 1) * 2 + g) * 64 + d]; }
        kml[tid] = v; }
    bf16x8 qf[4];
    { const bf16_t* qp = qkv + (rowb + q0w + r32) * INW + colQ + 8 * hi;
#pragma unroll
      for (int d0 = 0; d0 < 4; ++d0) qf[d0] = *(const bf16x8*)(qp + 16 * d0); }
    const int srow = 8 * w + (lane >> 3);
    const bf16_t* kg = qkv + (rowb + srow) * INW + colK + 8 * ((lane & 7) ^ ((srow >> 1) & 7));
    const bf16_t* vg = qkv + (rowb + srow) * INW + colV + 8 * ((lane & 7) ^ (((srow >> 1) & 1) << 2));
    const int ntl = t_hi - t_lo + 1;
#define TILE_OF(i) (TYPE ? ((i) < 4 ? 4 * n + (i) : (i) - 4) : t_lo + (i))
#define STAGE(ti, slot) do { const int ti_ = (ti) < ntl ? (ti) : ntl - 1; const size_t go_ = (size_t)TILE_OF(ti_) * 64 * INW; \
        __builtin_amdgcn_global_load_lds((const unsigned*)(kg + go_), (LAS unsigned*)(L + KBUF + (slot) * 8192 + w * 1024), 16, 0, 0); \
        __builtin_amdgcn_global_load_lds((const unsigned*)(vg + go_), (LAS unsigned*)(L + VBUF + (slot) * 8192 + w * 1024), 16, 0, 0); } while (0)
    STAGE(0, 0); STAGE(1, 1); STAGE(2, 2); STAGE(3, 3);
    asm volatile("s_waitcnt vmcnt(4)" ::: "memory");
    asm volatile("s_waitcnt lgkmcnt(0)" ::: "memory"); __builtin_amdgcn_s_barrier(); asm volatile("" ::: "memory");
    unsigned sel = 0u;
    if (TYPE) {
        float gate[8];
#pragma unroll
        for (int nb = 0; nb < 8; ++nb) gate[nb] = 0.f;
#pragma unroll
        for (int d0 = 0; d0 < 4; ++d0) { float q8[8];
#pragma unroll
            for (int j = 0; j < 8; ++j) q8[j] = bf2f((unsigned short)qf[d0][j]);
#pragma unroll
            for (int nb = 0; nb < 7; ++nb) if (nb < n) { const f32x4 k0 = *(const LAS f32x4*)(kml + nb * 64 + 16 * d0 + 8 * hi), k1 = *(const LAS f32x4*)(kml + nb * 64 + 16 * d0 + 8 * hi + 4);
                gate[nb] += (q8[0] * k0[0] + q8[1] * k0[1]) + (q8[2] * k0[2] + q8[3] * k0[3]) + (q8[4] * k1[0] + q8[5] * k1[1]) + (q8[6] * k1[2] + q8[7] * k1[3]); } }
#pragma unroll
        for (int nb = 0; nb < 7; ++nb) gate[nb] += __shfl_xor(gate[nb], 32);
        const int nsel = n < 3 ? n : 3;
        for (int k = 0; k < nsel; ++k) { float best = -3e38f; int bi = 0;
#pragma unroll
            for (int nb = 0; nb < 7; ++nb) { const bool ok = (nb < n) && !((sel >> nb) & 1u) && (gate[nb] > best); if (ok) { best = gate[nb]; bi = nb; } }
            sel |= 1u << bi; }
    }
    float m = TYPE ? 0.f : FIN(I_SINKS)[hl] * LOG2E, l = (TYPE == 0 && hi == 0) ? 1.f : 0.f;
    f32x16 negm;
#pragma unroll
    for (int r = 0; r < 16; ++r) negm[r] = -m;
    f32x16 o0 = {}, o1 = {};
    const int qpos = q0w + r32;
    const int kroff = r32 * 128;  const int ksw = (r32 >> 1) & 7;
    const int q_ = (lane & 15) >> 2, p_ = lane & 3, sw = (q_ >> 1) & 1, clow = 2 * ((lane >> 4) & 1) + (p_ >> 1);
    const int vrow = (4 * hi + q_) * 128 + (p_ & 1) * 8;
    const int vb0 = vrow + ((4 * (0 ^ sw) + clow) << 4), vb1 = vrow + ((4 * (1 ^ sw) + clow) << 4);
    const int vaddr0 = (int)(unsigned)(unsigned long)(L + VBUF) + vb0, vaddr1 = (int)(unsigned)(unsigned long)(L + VBUF) + vb1;
    constexpr float THR = 8.0f;
#define ATT_STEP(IDX, SLOT) do { const int i = (IDX);         const int kt = TILE_OF(i); const int cur = (SLOT); \
        const int k0 = 64 * kt; const int dmax = q0w + 31 - k0, dmin = q0w - k0 - 63; \
        bool active, near, mine = true; \
        if (TYPE == 0) { active = (dmax >= 0) && (dmin <= 127); near = true; } \
        else if (kt >= 4 * n) { active = dmax >= 0; near = dmin < 128; } \
        else { mine = (sel >> (kt >> 2)) & 1u; active = __ballot(mine) != 0ull; near = dmin < 128; } \
        if (active) { \
            const LAS unsigned char* Kb = L + KBUF + cur * 8192; const LAS unsigned char* Vb = L + VBUF + cur * 8192; \
            f32x16 p0, p1, c = negm; \
            if (TYPE && kt < 4 * n) { \
        _Pragma("unroll") \
                for (int r = 0; r < 16; ++r) c[r] = mine ? negm[r] : NEGBIG; } \
            { const int co = ((0 + hi) ^ ksw) << 4; const bf16x8 ka = *(const LAS bf16x8*)(Kb + kroff + co), kb2 = *(const LAS bf16x8*)(Kb + 4096 + kroff + co); \
              p0 = __builtin_amdgcn_mfma_f32_32x32x16_bf16(ka, qf[0], c, 0, 0, 0); p1 = __builtin_amdgcn_mfma_f32_32x32x16_bf16(kb2, qf[0], c, 0, 0, 0); } \
        _Pragma("unroll") \
            for (int d0 = 1; d0 < 4; ++d0) { const int co = ((2 * d0 + hi) ^ ksw) << 4; \
                const bf16x8 ka = *(const LAS bf16x8*)(Kb + kroff + co), kb2 = *(const LAS bf16x8*)(Kb + 4096 + kroff + co); \
                p0 = __builtin_amdgcn_mfma_f32_32x32x16_bf16(ka, qf[d0], p0, 0, 0, 0); p1 = __builtin_amdgcn_mfma_f32_32x32x16_bf16(kb2, qf[d0], p1, 0, 0, 0); } \
            if (near) { const LAS float* lp = lut + (221 - (qpos - k0 - 4 * hi)); \
        _Pragma("unroll") \
                for (int r = 0; r < 16; ++r) { const int ko = (r & 3) + 8 * (r >> 2); p0[r] += lp[ko]; p1[r] += lp[32 + ko]; } } \
            float mx = __builtin_fmaxf(__builtin_fmaxf(p0[0], p1[0]), p0[1]); \
        _Pragma("unroll") \
            for (int r = 1; r < 16; ++r) mx = (r == 1) ? __builtin_fmaxf(mx, p1[1]) : __builtin_fmaxf(__builtin_fmaxf(mx, p0[r]), p1[r]); \
            mx = __builtin_fmaxf(mx, __shfl_xor(mx, 32)); \
            const bool first = (TYPE == 1) && (i == 0); \
            const float delta = first ? mx : (mx > THR ? mx : 0.f); \
            if (__ballot(delta != 0.f) != 0ull) { \
                m += delta; const float alpha = __builtin_amdgcn_exp2f(-delta); l *= alpha; \
        _Pragma("unroll") \
                for (int r = 0; r < 16; ++r) { o0[r] *= alpha; o1[r] *= alpha; negm[r] = -m; p0[r] -= delta; p1[r] -= delta; } \
            } \
            float ps = 0.f; \
        _Pragma("unroll") \
            for (int r = 0; r < 16; ++r) { p0[r] = __builtin_amdgcn_exp2f(p0[r]); p1[r] = __builtin_amdgcn_exp2f(p1[r]); ps += p0[r] + p1[r]; } \
            l += ps; \
            s16x4 ta[4][2], tc[4][2];                                    \
        _Pragma("unroll") \
            for (int s = 0; s < 4; ++s) { \
                asm volatile("ds_read_b64_tr_b16 %0, %1 offset:%c2" : "=&v"(ta[s][0]) : "v"(vaddr0 + cur * 8192), "i"(s * 2048) : "memory"); \
                asm volatile("ds_read_b64_tr_b16 %0, %1 offset:%c2" : "=&v"(ta[s][1]) : "v"(vaddr0 + cur * 8192), "i"(s * 2048 + 1024) : "memory"); \
                asm volatile("ds_read_b64_tr_b16 %0, %1 offset:%c2" : "=&v"(tc[s][0]) : "v"(vaddr1 + cur * 8192), "i"(s * 2048) : "memory"); \
                asm volatile("ds_read_b64_tr_b16 %0, %1 offset:%c2" : "=&v"(tc[s][1]) : "v"(vaddr1 + cur * 8192), "i"(s * 2048 + 1024) : "memory"); } \
            asm volatile("s_waitcnt lgkmcnt(0)" ::: "memory"); __builtin_amdgcn_sched_barrier(0); \
        _Pragma("unroll") \
            for (int s = 0; s < 4; ++s) { \
                u32x4 pw; \
                if (s < 2) { pw.x = pkbf(p0[8 * s + 0], p0[8 * s + 1]); pw.y = pkbf(p0[8 * s + 2], p0[8 * s + 3]); pw.z = pkbf(p0[8 * s + 4], p0[8 * s + 5]); pw.w = pkbf(p0[8 * s + 6], p0[8 * s + 7]); } \
                else { const int s2 = s - 2; pw.x = pkbf(p1[8 * s2 + 0], p1[8 * s2 + 1]); pw.y = pkbf(p1[8 * s2 + 2], p1[8 * s2 + 3]); pw.z = pkbf(p1[8 * s2 + 4], p1[8 * s2 + 5]); pw.w = pkbf(p1[8 * s2 + 6], p1[8 * s2 + 7]); } \
                const bf16x8 pb = __builtin_bit_cast(bf16x8, pw); \
                const s16x4 a0 = ta[s][0], a1 = ta[s][1], c0 = tc[s][0], c1 = tc[s][1]; \
                const bf16x8 va = (bf16x8){a0[0], a0[1], a0[2], a0[3], a1[0], a1[1], a1[2], a1[3]}, vc = (bf16x8){c0[0], c0[1], c0[2], c0[3], c1[0], c1[1], c1[2], c1[3]}; \
                o0 = __builtin_amdgcn_mfma_f32_32x32x16_bf16(va, pb, o0, 0, 0, 0); o1 = __builtin_amdgcn_mfma_f32_32x32x16_bf16(vc, pb, o1, 0, 0, 0); \
            } \
        } \
    } while (0)
    { int sc = 0;
      for (int i2 = 0; i2 < ntl; i2 += 2) {
          const int s4 = (sc + 4 >= NSLOT) ? sc + 4 - NSLOT : sc + 4, s5 = (sc + 5 >= NSLOT) ? sc + 5 - NSLOT : sc + 5, sn = sc + 1;
          STAGE(i2 + 4, s4); STAGE(i2 + 5, s5);
          ATT_STEP(i2, sc); ATT_STEP(i2 + 1, sn);
          asm volatile("s_waitcnt vmcnt(4)" ::: "memory");
          asm volatile("s_waitcnt lgkmcnt(0)" ::: "memory"); __builtin_amdgcn_s_barrier(); asm volatile("" ::: "memory");
          sc = (sc + 2 >= NSLOT) ? sc + 2 - NSLOT : sc + 2; } }
    asm volatile("s_waitcnt vmcnt(0)" ::: "memory");
#undef ATT_STEP
#undef STAGE
#undef TILE_OF
    l += __shfl_xor(l, 32);
    const float rl = 1.0f / l; float q2 = 0.f;
    const size_t t = rowb + qpos; bf16_t* op = O + t * DM + 64 * hh + 4 * hi;
#pragma unroll
    for (int c4 = 0; c4 < 4; ++c4) {
        const float a0 = o0[4 * c4 + 0] * rl, a1 = o0[4 * c4 + 1] * rl, a2 = o0[4 * c4 + 2] * rl, a3 = o0[4 * c4 + 3] * rl;
        const float b0 = o1[4 * c4 + 0] * rl, b1 = o1[4 * c4 + 1] * rl, b2 = o1[4 * c4 + 2] * rl, b3 = o1[4 * c4 + 3] * rl;
        q2 += (a0 * a0 + a1 * a1) + (a2 * a2 + a3 * a3) + (b0 * b0 + b1 * b1) + (b2 * b2 + b3 * b3);
        u32x2 wa; wa.x = pkbf(a0, a1); wa.y = pkbf(a2, a3); *(u32x2*)(op + 8 * c4) = wa;
        u32x2 wb; wb.x = pkbf(b0, b1); wb.y = pkbf(b2, b3); *(u32x2*)(op + 32 + 8 * c4) = wb;
    }
    q2 += __shfl_xor(q2, 32);
    if (hi == 0) ssq[t * 16 + hh] = q2;
}
}
namespace att2 {
typedef float f32x16 __attribute__((ext_vector_type(16)));
typedef short s16x4 __attribute__((ext_vector_type(4)));
typedef short v4i16_t __attribute__((ext_vector_type(4)));
typedef LAS const unsigned char* lds_cptr;
constexpr int NW = 8, QBLK = 32, QB = 256, KVBLK = 64, NSLOT = 3, SLOTB = 8192;
constexpr int LDS_K = 0, LDS_V = NSLOT * SLOTB, LDS_WS = 2 * NSLOT * SLOTB, LDS_OST = LDS_WS + NW * 64 * 4, LDS_LUT = LDS_OST + NW * 4096, LDS_KM = LDS_LUT + 2560, LDS_END = LDS_LUT + 5120;
constexpr int DMAXT = 383, NLUT = 639;
constexpr float NEGBIG = -1e30f;
__device__ __forceinline__ int crow(int r, int hi) { return (r & 3) + 8 * (r >> 2) + 4 * hi; }
#define SBAR() __builtin_amdgcn_sched_barrier(0)
__device__ __forceinline__ void glds16(const void* gsrc, unsigned lds_dst) { unsigned keep;
    asm volatile("s_mov_b32 %0, m0\n\ts_mov_b32 m0, %2\n\ts_nop 0\n\tglobal_load_lds_dwordx4 %1, off\n\ts_mov_b32 m0, %0" : "=&s"(keep) : "v"(gsrc), "s"(lds_dst) : "memory"); }
__device__ __forceinline__ float fadd_s(float a, float b) { float r; asm("v_add_f32_e32 %0, %1, %2" : "=v"(r) : "v"(a), "v"(b)); return r; }
__device__ __forceinline__ float fsub_s(float a, float b) { float r; asm("v_sub_f32_e32 %0, %1, %2" : "=v"(r) : "v"(a), "v"(b)); return r; }
__device__ __forceinline__ unsigned cvtpk_s(float lo, float hi) { f32x2 v = {lo, hi}; typedef __bf16 bf2 __attribute__((ext_vector_type(2))); bf2 b = __builtin_convertvector(v, bf2); return __builtin_bit_cast(unsigned, b); }
#define WAIT_BAR(N) asm volatile("s_waitcnt vmcnt(" #N ") lgkmcnt(0)\n\ts_barrier" ::: "memory")
__device__ __forceinline__ void qkt(f32x16& p0, f32x16& p1, lds_cptr Kslot, const bf16x8* qr, const f32x16& negm, int r32, int hi) {
    lds_cptr kb = Kslot + hi * 1024 + r32 * 16;
#pragma unroll
    for (int d0 = 0; d0 < 4; ++d0) {
        const bf16x8 b0 = *(const LAS bf16x8*)(kb + d0 * 2048), b1 = *(const LAS bf16x8*)(kb + d0 * 2048 + 512);
        if (d0 == 0) { p0 = __builtin_amdgcn_mfma_f32_32x32x16_bf16(b0, qr[0], negm, 0, 0, 0); p1 = __builtin_amdgcn_mfma_f32_32x32x16_bf16(b1, qr[0], negm, 0, 0, 0); }
        else { p0 = __builtin_amdgcn_mfma_f32_32x32x16_bf16(b0, qr[d0], p0, 0, 0, 0); p1 = __builtin_amdgcn_mfma_f32_32x32x16_bf16(b1, qr[d0], p1, 0, 0, 0); } }
}
__device__ __forceinline__ void kload8(bf16x8* kf, lds_cptr kp) {
    kf[0] = *(const LAS bf16x8*)(kp);        kf[1] = *(const LAS bf16x8*)(kp + 512);
    kf[2] = *(const LAS bf16x8*)(kp + 2048); kf[3] = *(const LAS bf16x8*)(kp + 2560);
    kf[4] = *(const LAS bf16x8*)(kp + 4096); kf[5] = *(const LAS bf16x8*)(kp + 4608);
    kf[6] = *(const LAS bf16x8*)(kp + 6144); kf[7] = *(const LAS bf16x8*)(kp + 6656);
}
__device__ __forceinline__ void kload2(bf16x8* kf, lds_cptr kp, int j) { kf[2 * j] = *(const LAS bf16x8*)(kp + j * 2048); kf[2 * j + 1] = *(const LAS bf16x8*)(kp + j * 2048 + 512); }
__device__ __forceinline__ s16x4 vtr(lds_cptr p) { return __builtin_bit_cast(s16x4, __builtin_amdgcn_ds_read_tr16_b64_v4i16((LAS v4i16_t*)p)); }
__device__ __forceinline__ float rowmax(const f32x16& p0, const f32x16& p1) {
    float a = __builtin_fmaxf(__builtin_fmaxf(p0[0], p0[1]), p1[0]), b = __builtin_fmaxf(__builtin_fmaxf(p0[2], p0[3]), p1[1]); a = __builtin_fmaxf(__builtin_fmaxf(a, p1[2]), p1[3]);
#pragma unroll
    for (int r = 4; r < 16; r += 4) { a = __builtin_fmaxf(__builtin_fmaxf(a, p0[r]), p0[r + 1]); b = __builtin_fmaxf(__builtin_fmaxf(b, p0[r + 2]), p0[r + 3]); a = __builtin_fmaxf(__builtin_fmaxf(a, p1[r]), p1[r + 1]); b = __builtin_fmaxf(__builtin_fmaxf(b, p1[r + 2]), p1[r + 3]); }
    const float m = __builtin_fmaxf(a, b);
    auto rr = __builtin_amdgcn_permlane32_swap(__float_as_uint(m), __float_as_uint(m), false, false);
    return __builtin_fmaxf(__uint_as_float(rr[0]), __uint_as_float(rr[1]));
}
__device__ __forceinline__ float xsum(float v) { auto rr = __builtin_amdgcn_permlane32_swap(__float_as_uint(v), __float_as_uint(v), false, false); return __uint_as_float(rr[0]) + __uint_as_float(rr[1]); }
__device__ __forceinline__ void pv(f32x16* o, int vb, bf16x8 pa0, bf16x8 pa1, bf16x8 pa2, bf16x8 pa3) {
#pragma unroll
    for (int d0 = 0; d0 < 2; ++d0) { s16x4 lo[4], hi[4];
#pragma unroll
        for (int ks = 0; ks < 4; ++ks) {
            asm volatile("ds_read_b64_tr_b16 %0,%1 offset:%c2" : "=&v"(lo[ks]) : "v"(vb), "i"(d0 * 4096 + ks * 1024) : "memory");
            asm volatile("ds_read_b64_tr_b16 %0,%1 offset:%c2" : "=&v"(hi[ks]) : "v"(vb), "i"(d0 * 4096 + ks * 1024 + 512) : "memory"); }
        asm volatile("s_waitcnt lgkmcnt(0)" ::: "memory"); SBAR();
#define PK(k) (bf16x8){lo[k][0], lo[k][1], lo[k][2], lo[k][3], hi[k][0], hi[k][1], hi[k][2], hi[k][3]}
        o[d0] = __builtin_amdgcn_mfma_f32_32x32x16_bf16(pa0, PK(0), o[d0], 0, 0, 0);
        o[d0] = __builtin_amdgcn_mfma_f32_32x32x16_bf16(pa1, PK(1), o[d0], 0, 0, 0);
        o[d0] = __builtin_amdgcn_mfma_f32_32x32x16_bf16(pa2, PK(2), o[d0], 0, 0, 0);
        o[d0] = __builtin_amdgcn_mfma_f32_32x32x16_bf16(pa3, PK(3), o[d0], 0, 0, 0);
#undef PK
    }
}

template <int TYPE, int THRL>
__device__ __forceinline__ void attn_unit(Frame& F, int b, int hlp, int n) {
    int tid_ = F.tid; asm volatile("" : "+v"(tid_));
    const int tid = tid_, lane = tid & 63, r32 = lane & 31, hi = lane >> 5; const int wid = F.wave;
    const int hl = TYPE ? hlp : 2 * hlp + (wid >> 2);
    const int hh = TYPE * 8 + hl, g = hl >> 2;
    const int colQ = (TYPE ? C_QB : C_QA) + 64 * hl, colK = (TYPE ? C_KB : C_KA) + 64 * g, colV = (TYPE ? C_VB : C_VA) + 64 * g;
    const bf16_t* qkv = (const bf16_t*)(F.ws + WS_QKV); bf16_t* O = (bf16_t*)(F.ws + WS_O); float* ssq = (float*)(F.ws + WS_SSQ);
    const float* tab = (const float*)(F.ws + WS_BIAS); const float* kmp = (const float*)(F.ws + WS_KMP);
    const long rowbase = (long)b * SEQ; const int q0 = TYPE ? n * QB : n * 128 + 0;
    const int qw0 = q0 + (TYPE ? wid : (wid & 3)) * QBLK;
    const lds_cptr shm3 = (lds_cptr)F.lds; LAS unsigned char* shmw = F.lds;
    const unsigned lds0 = (unsigned)(unsigned long)F.lds;
    LAS float* wsf = (LAS float*)(shmw + LDS_WS) + wid * 64;
    LAS float* lut = (LAS float*)(shmw + LDS_LUT) + (TYPE ? 0 : (wid >> 2) * 640); LAS float* kml = (LAS float*)(shmw + LDS_KM);
    const int t_lo = (2 * n - 2 > 0) ? 2 * n - 2 : 0;
    const int NT = TYPE ? 4 * n + 4 : 4;
#define TILE_OF(t) (TYPE ? ((t) < 4 ? 4 * n + (t) : (t) - 4) : t_lo + (t))
    const bf16_t* Qw = qkv + (rowbase + qw0) * INW + colQ;
    const bf16_t* Kh = qkv + rowbase * INW + colK; const bf16_t* Vh = qkv + rowbase * INW + colV;
    const bf16_t* ksrc = Kh + (long)lane * INW + wid * 8;
    const bf16_t* vsrc = Vh + (long)(16 * (wid & 3) + (lane >> 2)) * INW + (wid >> 2) * 32 + (lane & 3) * 8;
    const unsigned kdst = lds0 + LDS_K + wid * 1024, vdst = lds0 + LDS_V + wid * 1024;
#define DMA_K(t, slot) glds16(ksrc + (long)TILE_OF(t) * KVBLK * INW, (unsigned)__builtin_amdgcn_readfirstlane(kdst + (slot)))
#define DMA_V(t, slot) glds16(vsrc + (long)TILE_OF(t) * KVBLK * INW, (unsigned)__builtin_amdgcn_readfirstlane(vdst + (slot)))
    const int vb0 = (int)(lds0 + LDS_V) + ((lane >> 4) & 1) * 32 + (lane & 3) * 8 + (4 * hi + ((lane & 15) >> 2)) * 64;
    bf16x8 kf[8];
    const lds_cptr kp0 = shm3 + LDS_K + hi * 1024 + r32 * 16; const lds_cptr vp0 = shm3 + LDS_V + ((lane >> 4) & 1) * 32 + (lane & 3) * 8 + (4 * hi + ((lane & 15) >> 2)) * 64;
    DMA_K(0, 0); DMA_V(0, 0); DMA_K(1, SLOTB);
    bf16x8 qr[4];
#pragma unroll
    for (int d0 = 0; d0 < 4; ++d0) qr[d0] = *(const bf16x8*)(&Qw[(long)r32 * INW + d0 * 16 + hi * 8]);
    { const float* lg = (const float*)(F.ws + WS_BIAS + 16 * KiB);
      for (int e = tid; e < (TYPE ? 640 : 1280); e += NTHREADS) ((LAS float*)(shmw + LDS_LUT))[e] = lg[(TYPE ? hh : 2 * hlp) * 640 + e]; }
    if (TYPE) { const int nb = tid >> 6, d = tid & 63; float v = 0.f;
        if (nb < n) { const int pm = b * 8 + nb; v = kmp[((pm * 2 + 0) * 2 + g) * 64 + d] + kmp[((pm * 2 + 1) * 2 + g) * 64 + d]; }
        kml[tid] = v; }
    float mhat = TYPE ? 0.f : FIN(I_SINKS)[hl] * LOG2E, l_reg = (TYPE == 0 && hi == 0) ? 1.f : 0.f;
    f32x16 o[2]; o[0] = f32x16{}; o[1] = f32x16{}; f32x16 negm;
#pragma unroll
    for (int r = 0; r < 16; ++r) negm[r] = -mhat;
    asm volatile("" : "+v"(negm));
    const int qpos = qw0 + r32;
    const LAS float* lutq = lut + (DMAXT - qpos + 4 * hi);
#define LUTADD(P0, P1, t) do { const LAS float* lp_ = lutq + 64 * TILE_OF(t); \
        _Pragma("unroll") for (int r = 0; r < 16; ++r) { const int ko_ = (r & 3) + 8 * (r >> 2); P0[r] += lp_[ko_]; P1[r] += lp_[32 + ko_]; } } while (0)
#define NEAR(t) (TYPE == 0 || (t) < 4 || (t) >= NT - 2)
    unsigned sel = 0u;
#define PASTMASKED(tt) (TYPE == 1 && (tt) >= 4 && !((sel >> (((tt) - 4) >> 2)) & 1u))
    bool resc = false;
#define START(P0, P1) do { const float rm = rowmax(P0, P1); resc = false; \
        { const float dl = TYPE ? rm : (rm > (float)THRL ? rm : 0.f); mhat = fadd_s(mhat, dl); l_reg *= __builtin_amdgcn_exp2f(-dl); \
          _Pragma("unroll") for (int r = 0; r < 16; ++r) { P0[r] = fsub_s(P0[r], dl); P1[r] = fsub_s(P1[r], dl); } \
          _Pragma("unroll") for (int r = 0; r < 16; ++r) negm[r] = -mhat; asm volatile("" : "+v"(negm)); } \
        _Pragma("unroll") for (int r = 0; r < 16; ++r) P0[r] = __builtin_amdgcn_exp2f(P0[r]); } while (0)
#define RESC() do { if (resc) { asm volatile("s_waitcnt lgkmcnt(0)" ::: "memory"); \
        _Pragma("unroll") for (int d_ = 0; d_ < 2; ++d_) _Pragma("unroll") for (int r = 0; r < 16; ++r) o[d_][r] *= wsf[crow(r, hi)]; } } while (0)
    f32x16 pA0, pA1, pB0, pB1;
    int sl_prev = 0, sl_cur = 0, sl_next = SLOTB;
#define ROT() do { sl_prev = sl_cur; sl_cur = sl_next; sl_next = (sl_next == (NSLOT - 1) * SLOTB) ? 0 : sl_next + SLOTB; } while (0)
    DMA_K(2, 2 * SLOTB);
    WAIT_BAR(3);
    qkt(pA0, pA1, shm3 + LDS_K, qr, negm, r32, hi); asm volatile("s_nop 15\n\ts_nop 7" : "+v"(pA0), "+v"(pA1)); LUTADD(pA0, pA1, 0);
    START(pA0, pA1);
#pragma unroll
    for (int r = 0; r < 16; ++r) pA1[r] = __builtin_amdgcn_exp2f(pA1[r]);
    if (TYPE) {
        float gate[8];
#pragma unroll
        for (int nb = 0; nb < 8; ++nb) gate[nb] = 0.f;
#pragma unroll
        for (int d0 = 0; d0 < 4; ++d0) { float q8[8];
#pragma unroll
            for (int j = 0; j < 8; ++j) q8[j] = bf2f((unsigned short)qr[d0][j]);
#pragma unroll
            for (int nb = 0; nb < 7; ++nb) if (nb < n) { const f32x4 k0 = *(const LAS f32x4*)(kml + nb * 64 + 16 * d0 + 8 * hi), k1 = *(const LAS f32x4*)(kml + nb * 64 + 16 * d0 + 8 * hi + 4);
                gate[nb] += (q8[0] * k0[0] + q8[1] * k0[1]) + (q8[2] * k0[2] + q8[3] * k0[3]) + (q8[4] * k1[0] + q8[5] * k1[1]) + (q8[6] * k1[2] + q8[7] * k1[3]); } }
#pragma unroll
        for (int nb = 0; nb < 7; ++nb) gate[nb] = xsum(gate[nb]);
        const int nsel = n < 3 ? n : 3;
        for (int k = 0; k < nsel; ++k) { float best = -3e38f; int bi = 0;
#pragma unroll
            for (int nb = 0; nb < 7; ++nb) { const bool ok = (nb < n) && !((sel >> nb) & 1u) && (gate[nb] > best); if (ok) { best = gate[nb]; bi = nb; } }
            sel |= 1u << bi; }
    }
    WAIT_BAR(0);
    DMA_K(3, 0); DMA_V(1, SLOTB);
    ROT();
    kload8(kf, kp0 + sl_cur);
    WAIT_BAR(2);
    s16x4 vlo[8], vhi[8]; u32x4 pw0, pw1, pw2, pw3;
#define PKW(P, B) cvtpk_s(P[B], P[B + 1])
#define PAF(k) __builtin_bit_cast(bf16x8, pw##k)
#define VFR(i) (bf16x8){vlo[i][0], vlo[i][1], vlo[i][2], vlo[i][3], vhi[i][0], vhi[i][1], vhi[i][2], vhi[i][3]}
#define PIN(x) asm volatile("" : "+v"(x))
#define MX3(a, b, c) __builtin_fmaxf(__builtin_fmaxf((a), (b)), (c))
#define GAPA(MF, A0, A1, A2, A3, W0, W1, PW) do { MF; sacc += A0; sacc += A1; sacc += A2; sacc += A3; PIN(sacc); W0; W1; PIN(PW); SBAR(); } while (0)
#define EX(v) __builtin_amdgcn_exp2f(v)
#define GAPB(MF, X, B) do { MF; X[B] = EX(X[B]); X[B + 1] = EX(X[B + 1]); X[B + 2] = EX(X[B + 2]); X[B + 3] = EX(X[B + 3]); PIN(X); SBAR(); } while (0)
#define VRD(i) do { vlo[i] = vtr(vp_ + (((i) >> 2) * 4096 + ((i) & 3) * 1024)); vhi[i] = vtr(vp_ + (((i) >> 2) * 4096 + ((i) & 3) * 1024 + 512)); } while (0)
#define KRD(G, j) do { if (G) { kload2(kf, kp0 + sl_next, j); SBAR(); } } while (0)
#define STEP(C0, C1, P0, P1, t, GK, GV, GL, MASKED) do { SBAR(); \
    const lds_cptr vp_ = vp0 + sl_prev; \
    VRD(0); SBAR(); float sacc = (P0[0] + P0[1]); \
    GAPA(C0 = __builtin_amdgcn_mfma_f32_32x32x16_bf16(kf[0], qr[0], negm, 0, 0, 0), P0[2], P0[3], P0[4], P0[5],     pw0[0] = PKW(P0, 0), pw0[1] = PKW(P0, 2), pw0); \
    VRD(4); SBAR(); GAPA(C1 = __builtin_amdgcn_mfma_f32_32x32x16_bf16(kf[1], qr[0], negm, 0, 0, 0), P0[6], P0[7], P0[8], P0[9],     pw0[2] = PKW(P0, 4), pw0[3] = PKW(P0, 6), pw0); \
    VRD(1); SBAR(); GAPA(C0 = __builtin_amdgcn_mfma_f32_32x32x16_bf16(kf[2], qr[1], C0, 0, 0, 0),   P0[10], P0[11], P0[12], P0[13], pw1[0] = PKW(P0, 8), pw1[1] = PKW(P0, 10), pw1); \
    VRD(5); SBAR(); GAPA(C1 = __builtin_amdgcn_mfma_f32_32x32x16_bf16(kf[3], qr[1], C1, 0, 0, 0),   P0[14], P0[15], P1[0], P1[1],   pw1[2] = PKW(P0, 12), pw1[3] = PKW(P0, 14), pw1); \
    VRD(2); SBAR(); GAPA(C0 = __builtin_amdgcn_mfma_f32_32x32x16_bf16(kf[4], qr[2], C0, 0, 0, 0),   P1[2], P1[3], P1[4], P1[5],     pw2[0] = PKW(P1, 0), pw2[1] = PKW(P1, 2), pw2); \
    VRD(6); SBAR(); GAPA(C1 = __builtin_amdgcn_mfma_f32_32x32x16_bf16(kf[5], qr[2], C1, 0, 0, 0),   P1[6], P1[7], P1[8], P1[9],     pw2[2] = PKW(P1, 4), pw2[3] = PKW(P1, 6), pw2); \
    VRD(3); SBAR(); GAPA(C0 = __builtin_amdgcn_mfma_f32_32x32x16_bf16(kf[6], qr[3], C0, 0, 0, 0),   P1[10], P1[11], P1[12], P1[13], pw3[0] = PKW(P1, 8), pw3[1] = PKW(P1, 10), pw3); \
    VRD(7); SBAR(); GAPA(C1 = __builtin_amdgcn_mfma_f32_32x32x16_bf16(kf[7], qr[3], C1, 0, 0, 0),   P1[14], P1[15], 0.f, 0.f,       pw3[2] = PKW(P1, 12), pw3[3] = PKW(P1, 14), pw3); \
    l_reg += sacc; \
    if (GK) { DMA_K((t) + 3, sl_cur); } if (GV) { DMA_V((t) + 1, sl_next); } \
    if (MASKED) { if (NEAR(t)) LUTADD(C0, C1, t); } \
    { float a = MX3(C0[0], C0[1], C1[0]), b_ = MX3(C0[2], C0[3], C1[1]); a = MX3(a, C1[2], C1[3]); \
      _Pragma("unroll") for (int r = 4; r < 16; r += 4) { a = MX3(a, C0[r], C0[r + 1]); b_ = MX3(b_, C0[r + 2], C0[r + 3]); a = MX3(a, C1[r], C1[r + 1]); b_ = MX3(b_, C1[r + 2], C1[r + 3]); } \
      float rm = __builtin_fmaxf(a, b_); { auto rr = __builtin_amdgcn_permlane32_swap(__float_as_uint(rm), __float_as_uint(rm), false, false); rm = __builtin_fmaxf(__uint_as_float(rr[0]), __uint_as_float(rr[1])); } \
      resc = false; \
      if (__builtin_expect(__any(rm > (float)THRL), 0)) { const float dl = __builtin_fmaxf(rm, 0.f); mhat += dl; \
        _Pragma("unroll") for (int r = 0; r < 16; ++r) { C0[r] -= dl; C1[r] -= dl; } \
        const float f = __builtin_amdgcn_exp2f(-dl); l_reg *= f; if (hi == 0) wsf[r32] = f; resc = true; } \
        \
      if (resc || (TYPE == 1 && ((t) + 1) >= 4 && ((((t) + 1) & 3) == 0))) { const float cv_ = PASTMASKED((t) + 1) ? NEGBIG : -mhat; \
        _Pragma("unroll") for (int r = 0; r < 16; ++r) negm[r] = cv_; asm volatile("" : "+v"(negm)); } } \
    SBAR(); \
    GAPB(o[0] = __builtin_amdgcn_mfma_f32_32x32x16_bf16(PAF(0), VFR(0), o[0], 0, 0, 0), C0, 0); \
    GAPB(o[1] = __builtin_amdgcn_mfma_f32_32x32x16_bf16(PAF(0), VFR(4), o[1], 0, 0, 0), C0, 4); \
    KRD(GL, 0); GAPB(o[0] = __builtin_amdgcn_mfma_f32_32x32x16_bf16(PAF(1), VFR(1), o[0], 0, 0, 0), C0, 8); \
    KRD(GL, 1); GAPB(o[1] = __builtin_amdgcn_mfma_f32_32x32x16_bf16(PAF(1), VFR(5), o[1], 0, 0, 0), C0, 12); \
    KRD(GL, 2); GAPB(o[0] = __builtin_amdgcn_mfma_f32_32x32x16_bf16(PAF(2), VFR(2), o[0], 0, 0, 0), C1, 0); \
    KRD(GL, 3); GAPB(o[1] = __builtin_amdgcn_mfma_f32_32x32x16_bf16(PAF(2), VFR(6), o[1], 0, 0, 0), C1, 4); \
    GAPB(o[0] = __builtin_amdgcn_mfma_f32_32x32x16_bf16(PAF(3), VFR(3), o[0], 0, 0, 0), C1, 8); \
    GAPB(o[1] = __builtin_amdgcn_mfma_f32_32x32x16_bf16(PAF(3), VFR(7), o[1], 0, 0, 0), C1, 12); \
    } while (0)
    int t = 1;
    for (; t < 5 && t + 5 < NT; t += 2) {
        STEP(pB0, pB1, pA0, pA1, t, true, true, true, true);     WAIT_BAR(2); RESC(); ROT();
        STEP(pA0, pA1, pB0, pB1, t + 1, true, true, true, true); WAIT_BAR(2); RESC(); ROT();
    }
    for (; t + 5 < NT; t += 2) {
        STEP(pB0, pB1, pA0, pA1, t, true, true, true, false);     WAIT_BAR(2); RESC(); ROT();
        STEP(pA0, pA1, pB0, pB1, t + 1, true, true, true, false); WAIT_BAR(2); RESC(); ROT();
    }
#define ENDW(tt) do { if ((tt) + 3 < NT) { WAIT_BAR(2); } else if ((tt) + 2 < NT) { WAIT_BAR(1); } else { WAIT_BAR(0); } } while (0)
    for (; t + 1 < NT; t += 2) {
        STEP(pB0, pB1, pA0, pA1, t, (t + 3 < NT), (t + 1 < NT), (t + 1 < NT), true);         ENDW(t);     RESC(); ROT();
        STEP(pA0, pA1, pB0, pB1, t + 1, (t + 4 < NT), (t + 2 < NT), (t + 2 < NT), true);     ENDW(t + 1); RESC(); ROT();
    }
    STEP(pB0, pB1, pA0, pA1, NT - 1, false, false, false, true); RESC();
    { float sacc = pB0[0] + pB0[1];
#pragma unroll
      for (int r = 2; r < 16; ++r) sacc += pB0[r];
#pragma unroll
      for (int r = 0; r < 16; ++r) sacc += pB1[r];
      l_reg += sacc;
      pw0 = (u32x4){PKW(pB0, 0), PKW(pB0, 2), PKW(pB0, 4), PKW(pB0, 6)}; pw1 = (u32x4){PKW(pB0, 8), PKW(pB0, 10), PKW(pB0, 12), PKW(pB0, 14)};
      pw2 = (u32x4){PKW(pB1, 0), PKW(pB1, 2), PKW(pB1, 4), PKW(pB1, 6)}; pw3 = (u32x4){PKW(pB1, 8), PKW(pB1, 10), PKW(pB1, 12), PKW(pB1, 14)};
      SBAR(); pv(o, vb0 + sl_cur, PAF(0), PAF(1), PAF(2), PAF(3)); }
#undef ENDW
#undef STEP
#undef KRD
#undef VRD
#undef GAPB
#undef EX
#undef GAPA
#undef MX3
#undef PIN
#undef VFR
#undef PAF
#undef PKW
    l_reg = xsum(l_reg);
    int lane_e = lane; asm volatile("" : "+v"(lane_e));
    if (hi == 0) wsf[32 + r32] = l_reg; asm volatile("s_waitcnt lgkmcnt(0)" ::: "memory");
    float rli[16];
#pragma unroll
    for (int r = 0; r < 16; ++r) rli[r] = __builtin_amdgcn_rcpf(wsf[32 + crow(r, hi)]);
    bf16_t* Ow = O + (rowbase + qw0) * DM + 64 * hh;
    { LAS bf16_t* stg = (LAS bf16_t*)(shmw + LDS_OST) + wid * 2048;
#pragma unroll
      for (int r = 0; r < 16; ++r) { const int orow = crow(r, hi);
#pragma unroll
          for (int d0 = 0; d0 < 2; ++d0) stg[orow * 64 + d0 * 32 + r32] = (bf16_t)f2bf(o[d0][r] * rli[r]); }
      asm volatile("s_waitcnt lgkmcnt(0)" ::: "memory");
#pragma unroll
      for (int i = 0; i < 4; ++i) { const int row = i * 8 + (lane_e >> 3), ch = lane_e & 7; const u32x4 v = *(const LAS u32x4*)(stg + row * 64 + ch * 8);
          *(u32x4*)(Ow + (long)row * DM + ch * 8) = v;
          float q2 = bflo(v.x) * bflo(v.x) + bfhi(v.x) * bfhi(v.x) + bflo(v.y) * bflo(v.y) + bfhi(v.y) * bfhi(v.y) + bflo(v.z) * bflo(v.z) + bfhi(v.z) * bfhi(v.z) + bflo(v.w) * bflo(v.w) + bfhi(v.w) * bfhi(v.w);
          q2 += __shfl_xor(q2, 1); q2 += __shfl_xor(q2, 2); q2 += __shfl_xor(q2, 4);
          if (ch == 0) ssq[(size_t)(rowbase + qw0 + row) * 16 + hh] = q2; } }
    asm volatile("s_waitcnt lgkmcnt(0)\n\ts_barrier" ::: "memory");
#undef DMA_K
#undef DMA_V
#undef LUTADD
#undef NEAR
#undef PASTMASKED
#undef START
#undef RESC
#undef ROT
#undef TILE_OF
}
#undef SBAR
#undef WAIT_BAR
}

__device__ __forceinline__ void p2_attention(Frame& F) {
    for (int j = F.vcu; j < 512; j += F.G) {
        if (j < 256) { const int b = j >> 5, hm = (j >> 2) & 7, pi = j & 3;
#pragma unroll 1
            for (int k = 0; k < 2; ++k) att2::attn_unit<1, 8>(F, b, hm, k ? pi : 7 - pi); }
        else { const int id = 2 * (j - 256);
#pragma unroll 1
            for (int k = 0; k < 2; ++k) { const int u = id + k; att2::attn_unit<0, 8>(F, u >> 6, (u >> 4) & 3, u & 15); } }
    }
    __syncthreads();
}

__device__ __forceinline__ void p4_router(Frame& F) {
    typedef float f32x16 __attribute__((ext_vector_type(16)));
    const bf16_t* x1b = (const bf16_t*)(F.ws + WS_X1B); float* r2 = (float*)(F.ws + WS_R2); const bf16_t* Wt = (const bf16_t*)(F.ws + WS_WR);
    LAS float* part = (LAS float*)F.lds;
    LAS float* sspart = (LAS float*)(F.lds + 98304);
    LAS int* lcnt = (LAS int*)(F.lds + MISC_OFF);
    LAS int* trec = (LAS int*)(F.lds + MISC_OFF + 512);
    unsigned* cnt = (unsigned*)(F.ctl + CW_CNT); unsigned* list = (unsigned*)(F.ws + WS_LIST); int* tok = (int*)(F.ws + WS_TOK);
    if (F.tid < 64) lcnt[F.tid] = 0;
    const int per = T / F.G;
    const int t0 = F.vcu * per;
    {
        const int tg = F.wave >> 2, kq = F.wave & 3, r32 = F.lane & 31, hi = F.lane >> 5;
        const bf16_t* ap = x1b + (size_t)(t0 + 32 * tg + r32) * DM + 256 * kq + 8 * hi;
        const bf16_t* bp = Wt + (size_t)r32 * DM + 256 * kq + 8 * hi;
        f32x16 a0 = {}, a1 = {}, a2 = {}; float ss = 0.f;
#pragma unroll 4
        for (int s = 0; s < 16; ++s) {
            const bf16x8 a = *(const bf16x8*)(ap + 16 * s);
            const bf16x8 b0 = *(const bf16x8*)(bp + 16 * s), b1 = *(const bf16x8*)(bp + (size_t)32 * DM + 16 * s), b2 = *(const bf16x8*)(bp + (size_t)64 * DM + 16 * s);
            a0 = __builtin_amdgcn_mfma_f32_32x32x16_bf16(a, b0, a0, 0, 0, 0); a1 = __builtin_amdgcn_mfma_f32_32x32x16_bf16(a, b1, a1, 0, 0, 0); a2 = __builtin_amdgcn_mfma_f32_32x32x16_bf16(a, b2, a2, 0, 0, 0);
#pragma unroll
            for (int j = 0; j < 8; ++j) { const float v = bf2f((unsigned short)a[j]); ss += v * v; }
        }
        LAS float* pp = part + ((tg * 4 + kq) * 32) * 96 + r32;
#pragma unroll
        for (int r = 0; r < 16; ++r) { const int tk = (r & 3) + 8 * (r >> 2) + 4 * hi; pp[tk * 96] = a0[r]; pp[tk * 96 + 32] = a1[r]; pp[tk * 96 + 64] = a2[r]; }
        sspart[((tg * 4 + kq) * 2 + hi) * 32 + r32] = ss;
    }
    __syncthreads();
    if (F.tid < per) {
        const int lt = F.tid, tg = lt >> 5, tk = lt & 31, t = t0 + lt;
        float lg[36]; float ssq = 0.f;
#pragma unroll
        for (int o = 0; o < 36; ++o) lg[o] = 0.f;
#pragma unroll
        for (int kq = 0; kq < 4; ++kq) { const LAS float* pr = part + ((tg * 4 + kq) * 32 + tk) * 96;
#pragma unroll
            for (int o = 0; o < 32; ++o) lg[o] += pr[o] + pr[32 + o];
#pragma unroll
            for (int o = 0; o < 4; ++o) lg[32 + o] += pr[64 + o] + pr[68 + o];
            ssq += sspart[((tg * 4 + kq) * 2 + 0) * 32 + tk] + sspart[((tg * 4 + kq) * 2 + 1) * 32 + tk]; }
        const float rs = 1.0f / sqrtf(ssq * (1.0f / DM) + EPS);
#pragma unroll
        for (int o = 0; o < 36; ++o) lg[o] *= rs;
        const float* brg = FIN(I_B_RG); const float* bre = FIN(I_B_RE);
        lg[0] += brg[0]; lg[1] += brg[1]; lg[2] += brg[2]; lg[3] += brg[3];
        int gsel = 0; float gm = lg[0];
#pragma unroll
        for (int o = 1; o < 4; ++o) if (lg[o] > gm) { gm = lg[o]; gsel = o; }
        float den = 0.f;
#pragma unroll
        for (int o = 0; o < 4; ++o) den += __expf(lg[o] - gm);
        const float gwt = 1.0f / den;
        float el[8];
#pragma unroll
        for (int j = 0; j < 8; ++j) { float a = lg[4 + j];
#pragma unroll
            for (int gq = 1; gq < 4; ++gq) a = (gsel == gq) ? lg[4 + 8 * gq + j] : a;
            el[j] = a + bre[gsel * 8 + j]; }
        int i0 = 0; float v0 = el[0];
#pragma unroll
        for (int j = 1; j < 8; ++j) if (el[j] > v0) { v0 = el[j]; i0 = j; }
        int i1 = -1; float v1 = -3e38f;
#pragma unroll
        for (int j = 0; j < 8; ++j) if (j != i0 && el[j] > v1) { v1 = el[j]; i1 = j; }
        const float e1 = __expf(v1 - v0); const float w0 = gwt / (1.0f + e1), w1 = gwt * e1 / (1.0f + e1);
        const int e0 = gsel * 8 + i0, e1i = gsel * 8 + i1;
        const int lr0 = __hip_atomic_fetch_add(&lcnt[e0], 1, __ATOMIC_RELAXED, __HIP_MEMORY_SCOPE_WORKGROUP);
        const int lr1 = __hip_atomic_fetch_add(&lcnt[e1i], 1, __ATOMIC_RELAXED, __HIP_MEMORY_SCOPE_WORKGROUP);
        trec[lt * 8 + 0] = e0; trec[lt * 8 + 1] = e1i; trec[lt * 8 + 2] = lr0; trec[lt * 8 + 3] = lr1;
        trec[lt * 8 + 4] = __builtin_bit_cast(int, w0); trec[lt * 8 + 5] = __builtin_bit_cast(int, w1);
        r2[t] = rs;
    }
    __syncthreads();
    if (F.tid < 32) { const int c = lcnt[F.tid]; int base = 0; if (c > 0) base = (int)__hip_atomic_fetch_add(&cnt[F.tid], (unsigned)c, __ATOMIC_RELAXED, __HIP_MEMORY_SCOPE_AGENT); lcnt[32 + F.tid] = base; }
    __syncthreads();
    for (int lt = F.tid; lt < per; lt += NTHREADS) {
        const int t = t0 + lt; const int e0 = trec[lt * 8 + 0], e1 = trec[lt * 8 + 1];
        const int rk0 = lcnt[32 + e0] + trec[lt * 8 + 2], rk1 = lcnt[32 + e1] + trec[lt * 8 + 3];
        list[e0 * 16384 + rk0] = (unsigned)(t * 2); list[e1 * 16384 + rk1] = (unsigned)(t * 2 + 1);
        int* tr = tok + (size_t)t * 8; tr[0] = e0; tr[1] = e1; tr[2] = rk0; tr[3] = rk1; tr[4] = trec[lt * 8 + 4]; tr[5] = trec[lt * 8 + 5];
    }
    __syncthreads();
}

__device__ __forceinline__ void build_tile_table(Frame& F, LAS int* tb) {
    if (F.tid < 64) {
        const unsigned* cnt = (const unsigned*)(F.ctl + CW_CNT);
        const int nt = (F.lane < NEXP) ? (int)((__hip_atomic_load(&cnt[F.lane & 31], __ATOMIC_RELAXED, __HIP_MEMORY_SCOPE_AGENT) + 255u) >> 8) : 0;
        int inc = nt;
#pragma unroll
        for (int o = 1; o < 32; o <<= 1) { const int v = __shfl_up(inc, o); if ((F.lane & 31) >= o) inc += v; }
        if (F.lane < NEXP) { tb[F.lane] = inc - nt; if (F.lane == NEXP - 1) tb[NEXP] = inc; }
    }
    __syncthreads();
}

__device__ __forceinline__ void p7_combine(Frame& F) {
    const bf16_t* x1b = (const bf16_t*)(F.ws + WS_X1B); const bf16_t* Y = (const bf16_t*)(F.ws + WS_Y); bf16_t* x2b = (bf16_t*)(F.ws + WS_X2B); float* r3 = (float*)(F.ws + WS_R3); const int* tok = (const int*)(F.ws + WS_TOK);
    const int gw = F.vcu * NWAVES + F.wave, NGW = F.G * NWAVES;
    for (int t = gw; t < T; t += 2 * NGW) {
        const int tb_ = (t + NGW < T) ? t + NGW : t; const bool two = tb_ != t;
        const f32x2 wa = *(const f32x2*)(tok + (size_t)t * 8 + 4), wb = *(const f32x2*)(tok + (size_t)tb_ * 8 + 4);
        u32x2 xa[2][4], ya[2][4], yb[2][4];
#pragma unroll
        for (int k = 0; k < 2; ++k) { const int tt = k ? tb_ : t;
            const GAS u32x2* xr = (const GAS u32x2*)(x1b + (size_t)tt * DM) + F.lane;
            const GAS u32x2* y0 = (const GAS u32x2*)(Y + (size_t)(2 * tt) * DM) + F.lane; const GAS u32x2* y1 = (const GAS u32x2*)(Y + (size_t)(2 * tt + 1) * DM) + F.lane;
#pragma unroll
            for (int j = 0; j < 4; ++j) { xa[k][j] = xr[64 * j]; ya[k][j] = __builtin_nontemporal_load(y0 + 64 * j); yb[k][j] = __builtin_nontemporal_load(y1 + 64 * j); } }
#pragma unroll
        for (int k = 0; k < 2; ++k) { const int tt = k ? tb_ : t; const float w0 = k ? wb.x : wa.x, w1 = k ? wb.y : wa.y;
            GAS u32x2* ob = (GAS u32x2*)(x2b + (size_t)tt * DM) + F.lane; float s = 0.f;
#pragma unroll
            for (int j = 0; j < 4; ++j) { f32x4 v;
                v.x = bflo(xa[k][j].x) + (w0 * bflo(ya[k][j].x) + w1 * bflo(yb[k][j].x)); v.y = bfhi(xa[k][j].x) + (w0 * bfhi(ya[k][j].x) + w1 * bfhi(yb[k][j].x));
                v.z = bflo(xa[k][j].y) + (w0 * bflo(ya[k][j].y) + w1 * bflo(yb[k][j].y)); v.w = bfhi(xa[k][j].y) + (w0 * bfhi(ya[k][j].y) + w1 * bfhi(yb[k][j].y));
                u32x2 w; w.x = pk2(v.x, v.y); w.y = pk2(v.z, v.w); if (k == 0 || two) ob[64 * j] = w; s += (v.x * v.x + v.y * v.y) + (v.z * v.z + v.w * v.w); }
            s = wave_sum(s);
            if (F.lane == 0 && (k == 0 || two)) r3[tt] = 1.0f / sqrtf(s * (1.0f / DM) + EPS); }
    }
}

#define XB_TMO      128
#define XB_XCNT(j)  (256  + 64 * (j))
#define XB_XSUB(j)  (1280 + 64 * (j))
#define XB_XGEN(j)  (2304 + 64 * (j))
#define XB_TOP      3328
#define XB_TOPGEN   3392
#define XCD_BAR_WORDS 3456
#define XB_SPIN_CAP (1u << 18)
__device__ __forceinline__ unsigned xb_ld(unsigned* p)              { return __hip_atomic_load(p, __ATOMIC_RELAXED, __HIP_MEMORY_SCOPE_AGENT); }
__device__ __forceinline__ unsigned xb_add(unsigned* p, unsigned v) { return __hip_atomic_fetch_add(p, v, __ATOMIC_RELAXED, __HIP_MEMORY_SCOPE_AGENT); }
__device__ __forceinline__ unsigned xb_xcc_id() { return (unsigned)__builtin_amdgcn_s_getreg((3 << 11) | 20) & 0xFu; }
#define XB_SPIN(cond, bar) do { unsigned _sp = 0; while (cond) { __builtin_amdgcn_s_sleep(1); \
    if ((++_sp & 255u) == 0u) { if (xb_ld(&(bar)[XB_TMO])) break; if (_sp > XB_SPIN_CAP) { atomicAdd(&(bar)[XB_TMO], 1u); break; } } } } while (0)
struct XcdBarrier { unsigned* bar; unsigned x; volatile LAS unsigned* st; };
__device__ __forceinline__ XcdBarrier xcd_barrier_post(unsigned* bar, volatile LAS unsigned* st) {
    XcdBarrier b; b.bar = bar; b.x = xb_xcc_id(); b.st = st;
    if (threadIdx.x == 0) (void)xb_add(&bar[XB_XCNT(b.x)], 1u);
    return b;
}
__device__ __forceinline__ void xcd_barrier_complete(unsigned* bar, unsigned x, unsigned& nloc, unsigned& nx) {
    const unsigned G = gridDim.x * gridDim.y * gridDim.z;
    unsigned sum, cnt, mine, sp = 0u;
    for (;;) {
        sum = 0u; cnt = 0u; mine = 0u;
#pragma unroll
        for (unsigned j = 0; j < 16; ++j) { const unsigned c = xb_ld(&bar[XB_XCNT(j)]); sum += c; cnt += (c > 0u) ? 1u : 0u; mine = (j == x) ? c : mine; }
        if (sum == G) break;
        __builtin_amdgcn_s_sleep(1);
        if ((++sp & 255u) == 0u) { if (xb_ld(&bar[XB_TMO])) break; if (sp > XB_SPIN_CAP) { atomicAdd(&bar[XB_TMO], 1u); break; } }
    }
    nloc = mine > 0u ? mine : 1u; nx = cnt > 0u ? cnt : 1u;
}
__device__ __forceinline__ void xcd_barrier(const XcdBarrier& b) {
    asm volatile("s_waitcnt vmcnt(0)" ::: "memory");
    __syncthreads();
    if (threadIdx.x == 0) {
        unsigned* bar = b.bar;
        __builtin_amdgcn_s_waitcnt(0);
        unsigned nloc = b.st[0], nx = b.st[1];
        if (nloc == 0u) { xcd_barrier_complete(bar, b.x, nloc, nx); b.st[0] = nloc; b.st[1] = nx; }
        const unsigned old = xb_add(&bar[XB_XSUB(b.x)], 1u);
        const unsigned gen = old / nloc;
        if (old + 1u == (gen + 1u) * nloc) {
            __builtin_amdgcn_fence(__ATOMIC_RELEASE, "agent");
            asm volatile("s_waitcnt vmcnt(0)" ::: "memory");
            const unsigned og = xb_add(&bar[XB_TOP], 1u);
            const unsigned tg = og / nx;
            if (og + 1u == (tg + 1u) * nx) xb_add(&bar[XB_TOPGEN], 1u);
            else XB_SPIN(xb_ld(&bar[XB_TOPGEN]) == tg, bar);
            __builtin_amdgcn_fence(__ATOMIC_ACQUIRE, "agent");
            xb_add(&bar[XB_XGEN(b.x)], 1u);
            asm volatile("s_waitcnt vmcnt(0)" ::: "memory");
        } else {
            XB_SPIN(xb_ld(&bar[XB_XGEN(b.x)]) == gen, bar);
            __builtin_amdgcn_fence(__ATOMIC_ACQUIRE, "agent");
            asm volatile("s_waitcnt vmcnt(0)" ::: "memory");
        }
    }
    __syncthreads();
}

__global__ void __launch_bounds__(NTHREADS, 2) hymba_fwd(Args args) {
    extern __shared__ __attribute__((aligned(16))) unsigned char lds[];
    Frame F;
    F.lds = (LAS unsigned char*)lds; unsigned char* ws;
#define REFRESH_IDS() do { int t_ = threadIdx.x; asm volatile("" : "+v"(t_)); F.tid = t_; F.lane = t_ & 63; F.wave = __builtin_amdgcn_readfirstlane(t_ >> 6); \
        unsigned char* w_ = args.ws; const __attribute__((address_space(4))) char* k_ = (const __attribute__((address_space(4))) char*)__builtin_amdgcn_kernarg_segment_ptr(); float* o_ = args.out; asm volatile("" : "+s"(w_), "+s"(k_), "+s"(o_)); \
        F.ws = w_; F.ka = k_; F.out = o_; F.ctl = (GAS unsigned*)(w_ + WS_CTL); ws = w_; } while (0)
    REFRESH_IDS();
    F.G = gridDim.x; { const int bx = blockIdx.x; F.vcu = (F.G % 8 == 0) ? (bx % 8) * (F.G / 8) + bx / 8 : bx; }
    const int lo = args.ph_lo, hi = args.ph_hi;
#ifdef ONLY_PHASE
#define IN(k) ((k) == ONLY_PHASE && lo <= (k) && (k) < hi)
#else
#define IN(k) (lo <= (k) && (k) < hi)
#endif
    LAS int* tb = (LAS int*)(F.lds + MISC_OFF + 8192);
    LAS f32x2* rowtab = (LAS f32x2*)(F.lds + MISC_OFF + 4096);
    volatile LAS unsigned* bst = (volatile LAS unsigned*)(F.lds + MISC_OFF + 12288);
    if (F.tid < 2) bst[F.tid] = 0u;
    __syncthreads();
    XcdBarrier bar; bar.bar = (unsigned*)(F.ctl + CW_BAR); bar.x = 0; bar.st = bst;
    if (hi - lo > 1) bar = xcd_barrier_post((unsigned*)(F.ctl + CW_BAR), bst);
#define SEAM(k) do { if (IN(k) && IN((k) + 1)) xcd_barrier(bar); } while (0)

    for (int rep = 0; rep < 1 + ((REPEAT_MASK >> 0) & 1); ++rep) { if (rep) xcd_barrier(bar);
    if (IN(0)) { REFRESH_IDS(); p0_prologue(F); }
    }
    SEAM(0);
    for (int rep = 0; rep < 1 + ((REPEAT_MASK >> 1) & 1); ++rep) { if (rep) xcd_barrier(bar);
    if (IN(1)) {
        REFRESH_IDS();
        { pg8::DenseOrder S{(const char*)(ws + WS_XB), (const char*)(ws + WS_WIN), T / 256, INW / 256, DM, F.G, (int)blockIdx.x};
          EpiQKV E{(bf16_t*)(ws + WS_QKV), (const float*)(ws + WS_RS1), FIN(I_SWA_QN), FIN(I_SWA_KN), FIN(I_MOBA_QN), FIN(I_MOBA_KN), (float*)(ws + WS_KMP)};
          pg8::gemm_phase<EpiQKV, pg8::DenseOrder, true, false, false>(F.lds, DM, S, E); }
        { const int hg = F.G / 2; const bool second = (int)blockIdx.x >= hg;
          pg8::DenseOrder S{(const char*)(ws + WS_PB), (const char*)(ws + WS_WPP), T / 256, DM / 256, PLE, second ? hg : (1 << 30), second ? (int)blockIdx.x - hg : (1 << 30)};
          EpiProj E{(bf16_t*)(ws + WS_PRAW), (float*)(ws + WS_SSQP)};
          pg8::gemm_phase<EpiProj, pg8::DenseOrder, true, false, false>(F.lds, PLE, S, E); }
    }
    }
    SEAM(1);
    for (int rep = 0; rep < 1 + ((REPEAT_MASK >> 2) & 1); ++rep) { if (rep) xcd_barrier(bar);
    if (IN(2)) { REFRESH_IDS(); p2_attention(F); }
    }
    SEAM(2);
    for (int rep = 0; rep < 1 + ((REPEAT_MASK >> 3) & 1); ++rep) { if (rep) xcd_barrier(bar);
    if (IN(3)) {
        pg8::DenseOrder S{(const char*)(ws + WS_O), (const char*)(ws + WS_WOUT), T / 256, DM / 256, DM, F.G, (int)blockIdx.x};
        REFRESH_IDS();
        { pg8::Unit u0; if (S.next(0, u0) && F.tid < 256) {
              const f32x4* p = (const f32x4*)((const float*)(ws + WS_SSQ) + (size_t)(u0.pm * 256 + F.tid) * 16); const f32x4 a0 = p[0], a1 = p[1], b0 = p[2], b1 = p[3];
              const float qa = ((a0[0] + a0[1]) + (a0[2] + a0[3])) + ((a1[0] + a1[1]) + (a1[2] + a1[3])), qb = ((b0[0] + b0[1]) + (b0[2] + b0[3])) + ((b1[0] + b1[1]) + (b1[2] + b1[3]));
              rowtab[F.tid] = (f32x2){1.0f / sqrtf(qa * (1.0f / 512.f) + EPS), 1.0f / sqrtf(qb * (1.0f / 512.f) + EPS)}; }
          __syncthreads(); }
        EpiOut E{(bf16_t*)(ws + WS_X1B), (const LAS f32x2*)rowtab};
        pg8::gemm_phase<EpiOut, pg8::DenseOrder, false, false, true>(F.lds, DM, S, E);
    }
    }
    SEAM(3);
    if (IN(4)) { REFRESH_IDS(); p4_router(F); }
    SEAM(4);
    for (int rep = 0; rep < 1 + ((REPEAT_MASK >> 5) & 1); ++rep) { if (rep) xcd_barrier(bar);
    if (IN(5)) {
        REFRESH_IDS(); build_tile_table(F, tb);
        MoeOrder S{(const char*)(ws + WS_X1B), (const char*)(ws + WS_WGU), tb, (const unsigned*)(F.ctl + CW_CNT), (const unsigned*)(ws + WS_LIST), DM, (size_t)DM * DM * 2, (size_t)DM * 2, F.G, (int)blockIdx.x, true};
        EpiG1 E{(bf16_t*)(ws + WS_H), (const float*)(ws + WS_R2), (const unsigned*)(ws + WS_LIST)};
        pg8::gemm_phase<EpiG1, MoeOrder, true, true, false>(F.lds, DM, S, E);
        { REFRESH_IDS();
          const int nwg = tb[NEXP] * 4, G = F.G, c = (int)blockIdx.x;
          const int maxnu = (nwg + G - 1) / G, nu = (nwg - c + G - 1) / G;
          const int nfull = nwg - (maxnu - 1) * G;
          const bool all = (nfull >= G);
          const int W = all ? G : G - nfull, rank = all ? c : c - nfull;
          if (all || nu < maxnu) { LAS float* scr = (LAS float*)(F.lds + F.wave * 16384); tr_stream(F, scr, rank * NWAVES + F.wave, W * NWAVES, TI_DOWN, TI_DOWN_BASE); } }
    }
    }
    SEAM(5);
    for (int rep = 0; rep < 1 + ((REPEAT_MASK >> 6) & 1); ++rep) { if (rep) xcd_barrier(bar);
    if (IN(6)) {
        REFRESH_IDS(); build_tile_table(F, tb);
        MoeOrder S{(const char*)(ws + WS_H), (const char*)(ws + WS_WD), tb, (const unsigned*)(F.ctl + CW_CNT), (const unsigned*)(ws + WS_LIST), DEXP, (size_t)DM * DEXP * 2, (size_t)DEXP * 2, F.G, (int)blockIdx.x, false};
        EpiG2 E{(bf16_t*)(ws + WS_Y), (const unsigned*)(ws + WS_LIST)};
        pg8::gemm_phase<EpiG2, MoeOrder, true, false, false>(F.lds, DEXP, S, E);
    }
    }
    SEAM(6);
    if (IN(7)) { REFRESH_IDS(); p7_combine(F); }
    SEAM(7);
    if (IN(8)) {
        pg8::DenseOrder S{(const char*)(ws + WS_X2B), (const char*)(ws + WS_WPG), T / 256, DM / 256, DM, F.G, (int)blockIdx.x};
        REFRESH_IDS();
        { pg8::Unit u0; if (S.next(0, u0) && F.tid < 256) {
              const int row = u0.pm * 256 + F.tid; const f32x4* sp = (const f32x4*)((const float*)(ws + WS_SSQP) + (size_t)row * 16); const f32x4 s0 = sp[0], s1 = sp[1], s2 = sp[2], s3 = sp[3];
              const float q = (((s0[0] + s0[1]) + (s0[2] + s0[3])) + ((s1[0] + s1[1]) + (s1[2] + s1[3]))) + (((s2[0] + s2[1]) + (s2[2] + s2[3])) + ((s3[0] + s3[1]) + (s3[2] + s3[3])));
              rowtab[F.tid] = (f32x2){((const float*)(ws + WS_R3))[row], 1.0f / sqrtf(q * (1.0f / DM) + EPS)}; }
          __syncthreads(); }
        EpiFinal E{F.out, (const bf16_t*)(ws + WS_X2B), (const bf16_t*)(ws + WS_PRAW), FIN(I_PLE_ON), (const LAS f32x2*)rowtab};
        pg8::gemm_phase<EpiFinal, pg8::DenseOrder, false, false, false>(F.lds, DM, S, E);
    }
#undef IN
#undef SEAM
}

extern "C" void kernel_launch(void* const* d_in, const int* in_sizes, int n_in, void* d_out, int out_size, void* d_ws, size_t ws_size, hipStream_t stream) {
    static int grid = 0;
    if (grid == 0) {
        if (n_in != 25 || in_sizes[0] != T * DM || out_size != T * DM || ws_size < WS_END) { fprintf(stderr, "kernel_launch: unexpected shapes (n_in %d, in0 %d, out %d, ws %zu)\n", n_in, n_in > 0 ? in_sizes[0] : -1, out_size, ws_size); grid = -1; return; }
        int dev = 0, cus = 0, per_cu = 0;
        if (hipGetDevice(&dev) != hipSuccess || hipDeviceGetAttribute(&cus, hipDeviceAttributeMultiprocessorCount, dev) != hipSuccess) { grid = -1; return; }
        if (hipFuncSetAttribute((const void*)hymba_fwd, hipFuncAttributeMaxDynamicSharedMemorySize, LDS_BYTES) != hipSuccess) { fprintf(stderr, "kernel_launch: hipFuncSetAttribute failed\n"); grid = -1; return; }
        if (hipOccupancyMaxActiveBlocksPerMultiprocessor(&per_cu, (const void*)hymba_fwd, NTHREADS, LDS_BYTES) != hipSuccess || per_cu < 1) { fprintf(stderr, "kernel_launch: occupancy query says %d\n", per_cu); per_cu = 1; }
        (void)hipGetLastError();
        grid = cus;
        if (grid != 256) { fprintf(stderr, "kernel_launch: %d CUs; this kernel is built for 256 (one 256x256 tile per workgroup in the N=1024 GEMM phases)\n", grid); grid = -1; return; }
    }
    if (grid < 0) return;
    (void)hipMemsetAsync((char*)d_ws + WS_CTL, 0, CTL_ZERO_BYTES, stream);
    Args a{};
    for (int i = 0; i < 25; ++i) a.in[i] = (const float*)d_in[i];
    a.out = (float*)d_out; a.ws = (unsigned char*)d_ws;
    constexpr int NPH = 9;
    for (int li = 0; li < MK_N_LAUNCHES; ++li) {
        a.ph_lo = (MK_N_LAUNCHES == NPH) ? li : 0; a.ph_hi = (MK_N_LAUNCHES == NPH) ? li + 1 : NPH; a.li = li;
        hipLaunchKernelGGL(hymba_fwd, dim3(grid), dim3(NTHREADS), LDS_BYTES, stream, a);
    }
}
```
